# Optimizing an MI355X kernel written in HIP

```python
import math
import jax, jax.numpy as jnp
from jax import lax
import numpy as np

D_MODEL = 1024
BATCH = 16
SEQ = 2048
DEPTH = 2

GRID_W = 64
HEAD_DIM = 64
A_HEADS = 8
A_KV_HEADS = 2
B_HEADS = 8
B_KV_HEADS = 2
WINDOW = 128
C_HEADS = 8
C_NOPE_DIM = 64
C_ROPE_DIM = 32
C_V_DIM = 64
C_Q_LORA = 384
C_KV_LORA = 256
Q_BLOCK = 128
N_BUCKETS = 32
MAX_DISTANCE = 128
N_EXPERTS = 16
N_GROUPS = 4
EXPERTS_PER_GROUP = N_EXPERTS // N_GROUPS
TOP_K = 2
D_FF_EXPERT = 512
ROPE_THETA = 10000.0
NORM_EPS = 1e-6
NEG_INF = -1e30
DEEPNORM_ALPHA = (2 * DEPTH) ** 0.25
DEEPNORM_BETA = (8 * DEPTH) ** -0.25
A_Q_W = A_HEADS * HEAD_DIM
A_KV_W = A_KV_HEADS * HEAD_DIM
B_Q_W = B_HEADS * HEAD_DIM
B_KV_W = B_KV_HEADS * HEAD_DIM
IN_SPLITS = (A_Q_W, A_KV_W, A_KV_W, B_Q_W, B_KV_W, B_KV_W,
             C_Q_LORA, C_KV_LORA, C_ROPE_DIM, D_MODEL, D_MODEL, D_MODEL)
IN_COLS = sum(IN_SPLITS)
A_OUT_W = A_HEADS * HEAD_DIM
B_OUT_W = B_HEADS * HEAD_DIM
C_OUT_W = C_HEADS * C_V_DIM

kernel_name = 'hybrid_gated_grid_window_mla_grouped_moe_encoder'


def layer_norm(x, g, b):
    xf = x.astype(jnp.float32)
    mu = jnp.mean(xf, axis=-1, keepdims=True)
    var = jnp.mean(jnp.square(xf - mu), axis=-1, keepdims=True)
    y = (xf - mu) * lax.rsqrt(var + NORM_EPS) * g.astype(jnp.float32) + b.astype(jnp.float32)
    return y.astype(x.dtype)


def rms_norm(x, g):
    xf = x.astype(jnp.float32)
    y = xf * lax.rsqrt(jnp.mean(jnp.square(xf), axis=-1, keepdims=True) + NORM_EPS)
    return (y * g.astype(jnp.float32)).astype(x.dtype)


def rope_cos_sin(pos, dim):
    inv = ROPE_THETA ** (-(jnp.arange(0, dim, 2, dtype=jnp.float32) / dim))
    ang = pos.astype(jnp.float32)[:, None] * inv[None, :]
    return jnp.cos(ang), jnp.sin(ang)


def apply_rope(x, cos, sin):
    half = x.shape[-1] // 2
    x1, x2 = x[..., :half], x[..., half:]
    c = cos[:, None, :].astype(x.dtype)
    s = sin[:, None, :].astype(x.dtype)
    return jnp.concatenate([x1 * c - x2 * s, x2 * c + x1 * s], axis=-1)


def axial_rope(x, row_cs, col_cs):
    half = x.shape[-1] // 2
    return jnp.concatenate([apply_rope(x[..., :half], *row_cs),
                            apply_rope(x[..., half:], *col_cs)], axis=-1)


def t5_bucket(rel):
    nb = N_BUCKETS // 2
    ret = (rel > 0).astype(np.int32) * nb
    n = np.abs(rel)
    max_exact = nb // 2
    large = max_exact + (np.log(np.maximum(n, 1) / max_exact)
                         / math.log(MAX_DISTANCE / max_exact) * (nb - max_exact)).astype(np.int32)
    large = np.minimum(large, nb - 1)
    return (ret + np.where(n < max_exact, n, large)).astype(np.int32)


def band_relative_bias(rpb_table):
    span = Q_BLOCK + 2 * WINDOW
    rel = np.arange(span)[None, :] - WINDOW - np.arange(Q_BLOCK)[:, None]
    bias = rpb_table.astype(jnp.float32)[t5_bucket(rel)]
    bias = jnp.transpose(bias, (2, 0, 1))
    return bias.reshape(B_KV_HEADS, B_HEADS // B_KV_HEADS, Q_BLOCK, span)


def dense_block_attention(q, k, v, scale):
    b, s, kvh, g, dq = q.shape
    nb = s // Q_BLOCK
    qb = q.reshape(b, nb, Q_BLOCK, kvh, g, dq).transpose(1, 0, 2, 3, 4, 5)

    def one(qblk):
        logits = jnp.einsum('bqkgd,bskd->bkgqs', qblk, k,
                            preferred_element_type=jnp.float32) * scale
        p = jax.nn.softmax(logits, axis=-1).astype(v.dtype)
        return jnp.einsum('bkgqs,bskd->bqkgd', p, v)

    out = lax.map(one, qb)
    return out.transpose(1, 0, 2, 3, 4, 5).reshape(b, s, kvh, g, v.shape[-1])


def windowed_sink_attention(q, k, v, sink, bias, scale):
    b, s, kvh, g, d = q.shape
    nb = s // Q_BLOCK
    span = Q_BLOCK + 2 * WINDOW
    pad = ((0, 0), (WINDOW, WINDOW), (0, 0), (0, 0))
    kp = jnp.pad(k, pad)
    vp = jnp.pad(v, pad)
    qb = q.reshape(b, nb, Q_BLOCK, kvh, g, d).transpose(1, 0, 2, 3, 4, 5)
    rel = np.arange(span)[None, :] - WINDOW - np.arange(Q_BLOCK)[:, None]
    band = jnp.asarray(np.abs(rel) <= WINDOW)
    sink_f = sink.astype(jnp.float32)[None, :, :, None, None]

    def one(args):
        i, qblk = args
        start = i * Q_BLOCK
        kb = lax.dynamic_slice_in_dim(kp, start, span, axis=1)
        vb = lax.dynamic_slice_in_dim(vp, start, span, axis=1)
        key_pos = start - WINDOW + jnp.arange(span)
        valid = band & ((key_pos >= 0) & (key_pos < s))[None, :]
        logits = jnp.einsum('bqkgd,bskd->bkgqs', qblk, kb,
                            preferred_element_type=jnp.float32) * scale + bias[None]
        logits = jnp.where(valid, logits, NEG_INF)
        sink_col = jnp.broadcast_to(sink_f, logits.shape[:-1] + (1,))
        p = jax.nn.softmax(jnp.concatenate([logits, sink_col], axis=-1), axis=-1)
        p = p[..., :span].astype(v.dtype)
        return jnp.einsum('bkgqs,bskd->bqkgd', p, vb)

    out = lax.map(one, (jnp.arange(nb), qb))
    return out.transpose(1, 0, 2, 3, 4, 5).reshape(b, s, kvh, g, d)


def token_mixer(h, w_in, a_qn_g, a_kn_g, b_sink, rpb_bias, c_qn_g, c_kvn_g, c_w_uq, c_w_ukv,
                w_br_a, w_br_b, w_br_c, w_o, row_cs, col_cs, seq_cs):
    b, s, _ = h.shape
    proj = h @ w_in
    parts = []
    off = 0
    for width in IN_SPLITS:
        parts.append(proj[..., off:off + width])
        off += width
    qa, ka, va, qb, kb, vb, cq, ckv, kr, ga, gb, gc = parts

    qa = axial_rope(rms_norm(qa.reshape(b, s, A_HEADS, HEAD_DIM), a_qn_g), row_cs, col_cs)
    ka = axial_rope(rms_norm(ka.reshape(b, s, A_KV_HEADS, HEAD_DIM), a_kn_g), row_cs, col_cs)
    va = va.reshape(b, s, A_KV_HEADS, HEAD_DIM)
    qa = qa.reshape(b, s, A_KV_HEADS, A_HEADS // A_KV_HEADS, HEAD_DIM)
    out_a = dense_block_attention(qa, ka, va, HEAD_DIM ** -0.5).reshape(b, s, A_OUT_W)

    qb = qb.reshape(b, s, B_KV_HEADS, B_HEADS // B_KV_HEADS, HEAD_DIM)
    kb = kb.reshape(b, s, B_KV_HEADS, HEAD_DIM)
    vb = vb.reshape(b, s, B_KV_HEADS, HEAD_DIM)
    sink = b_sink.reshape(B_KV_HEADS, B_HEADS // B_KV_HEADS)
    out_b = windowed_sink_attention(qb, kb, vb, sink, rpb_bias,
                                    HEAD_DIM ** -0.5).reshape(b, s, B_OUT_W)

    q_c = (rms_norm(cq, c_qn_g) @ c_w_uq).reshape(b, s, C_HEADS, C_NOPE_DIM + C_ROPE_DIM)
    q_nope, q_pe = q_c[..., :C_NOPE_DIM], q_c[..., C_NOPE_DIM:]
    q_pe = apply_rope(q_pe, *seq_cs)
    kv_c = (rms_norm(ckv, c_kvn_g) @ c_w_ukv).reshape(b, s, C_HEADS, C_NOPE_DIM + C_V_DIM)
    k_nope, v_c = kv_c[..., :C_NOPE_DIM], kv_c[..., C_NOPE_DIM:]
    k_pe = apply_rope(kr.reshape(b, s, 1, C_ROPE_DIM), *seq_cs)
    k_c = jnp.concatenate([k_nope, jnp.broadcast_to(k_pe, (b, s, C_HEADS, C_ROPE_DIM))], axis=-1)
    q_c = jnp.concatenate([q_nope, q_pe], axis=-1)[:, :, :, None, :]
    out_c = dense_block_attention(q_c, k_c, v_c,
                                  (C_NOPE_DIM + C_ROPE_DIM) ** -0.5).reshape(b, s, C_OUT_W)

    merged = (jax.nn.sigmoid(ga) * (out_a @ w_br_a)
              + jax.nn.sigmoid(gb) * (out_b @ w_br_b)
              + jax.nn.sigmoid(gc) * (out_c @ w_br_c))
    return merged @ w_o


def grouped_moe(h, router_w, router_bias, w_gate, w_up, w_down):
    b, s, d = h.shape
    t = h.reshape(b * s, d)
    scores = jax.nn.sigmoid(jnp.dot(t, router_w, preferred_element_type=jnp.float32))
    biased = scores + router_bias.astype(jnp.float32)
    grouped = biased.reshape(-1, N_GROUPS, EXPERTS_PER_GROUP)
    group_score = jnp.sum(lax.top_k(grouped, TOP_K)[0], axis=-1)
    sel = jnp.argmax(group_score, axis=-1)
    in_group = jnp.take_along_axis(grouped, sel[:, None, None], axis=1)[:, 0]
    _, local = lax.top_k(in_group, TOP_K)
    idx = sel[:, None] * EXPERTS_PER_GROUP + local
    wts = jnp.take_along_axis(scores, idx, axis=1)
    wts = wts / jnp.sum(wts, axis=-1, keepdims=True)
    combine = jnp.sum(jax.nn.one_hot(idx, N_EXPERTS, dtype=jnp.float32) * wts[..., None],
                      axis=1).astype(h.dtype)
    out = jnp.zeros_like(t)
    for e in range(N_EXPERTS):
        hid = jax.nn.silu(t @ w_gate[e]) * (t @ w_up[e])
        out = out + combine[:, e:e + 1] * (hid @ w_down[e])
    return out.reshape(b, s, d)


def setup_inputs(seed: int = 0) -> dict:
    key = jax.random.key(seed)
    ks = jax.random.split(key, 26)
    f32 = jnp.float32

    def nrm(k, shape, scale):
        return jax.random.normal(k, shape, f32) * scale

    L = DEPTH
    return {
        'x': nrm(ks[0], (BATCH, SEQ, D_MODEL), 1.0),
        'ln_in_g': 1.0 + nrm(ks[1], (D_MODEL,), 0.02),
        'ln_in_b': nrm(ks[2], (D_MODEL,), 0.02),
        'w_in': nrm(ks[3], (L, D_MODEL, IN_COLS), D_MODEL ** -0.5),
        'a_q_norm_g': 1.0 + nrm(ks[4], (L, HEAD_DIM), 0.02),
        'a_k_norm_g': 1.0 + nrm(ks[5], (L, HEAD_DIM), 0.02),
        'b_sink': nrm(ks[6], (L, B_HEADS), 0.5),
        'rpb_table': nrm(ks[7], (N_BUCKETS, B_HEADS), 0.5),
        'c_q_norm_g': 1.0 + nrm(ks[8], (L, C_Q_LORA), 0.02),
        'c_kv_norm_g': 1.0 + nrm(ks[9], (L, C_KV_LORA), 0.02),
        'c_w_uq': nrm(ks[10], (L, C_Q_LORA, C_HEADS * (C_NOPE_DIM + C_ROPE_DIM)), C_Q_LORA ** -0.5),
        'c_w_ukv': nrm(ks[11], (L, C_KV_LORA, C_HEADS * (C_NOPE_DIM + C_V_DIM)), C_KV_LORA ** -0.5),
        'w_branch_a': nrm(ks[12], (L, A_OUT_W, D_MODEL), A_OUT_W ** -0.5),
        'w_branch_b': nrm(ks[13], (L, B_OUT_W, D_MODEL), B_OUT_W ** -0.5),
        'w_branch_c': nrm(ks[14], (L, C_OUT_W, D_MODEL), C_OUT_W ** -0.5),
        'w_o': nrm(ks[15], (L, D_MODEL, D_MODEL), D_MODEL ** -0.5 * DEEPNORM_BETA),
        'ln1_g': 1.0 + nrm(ks[16], (L, D_MODEL), 0.02),
        'ln1_b': nrm(ks[17], (L, D_MODEL), 0.02),
        'router_w': nrm(ks[18], (D_MODEL, N_EXPERTS), D_MODEL ** -0.5),
        'router_bias': nrm(ks[19], (N_EXPERTS,), 0.01),
        'w_gate': nrm(ks[20], (L, N_EXPERTS, D_MODEL, D_FF_EXPERT), D_MODEL ** -0.5),
        'w_up': nrm(ks[21], (L, N_EXPERTS, D_MODEL, D_FF_EXPERT), D_MODEL ** -0.5),
        'w_down': nrm(ks[22], (L, N_EXPERTS, D_FF_EXPERT, D_MODEL), D_FF_EXPERT ** -0.5 * DEEPNORM_BETA),
        'ln2_g': 1.0 + nrm(ks[23], (L, D_MODEL), 0.02),
        'ln2_b': nrm(ks[24], (L, D_MODEL), 0.02),
    }


def reference(x, ln_in_g, ln_in_b, w_in, a_q_norm_g, a_k_norm_g, b_sink, rpb_table,
              c_q_norm_g, c_kv_norm_g, c_w_uq, c_w_ukv, w_branch_a, w_branch_b, w_branch_c,
              w_o, ln1_g, ln1_b, router_w, router_bias, w_gate, w_up, w_down, ln2_g, ln2_b):
    b, s, _ = x.shape
    n_rows = s // GRID_W
    rows = jnp.repeat(jnp.arange(n_rows), GRID_W)
    cols = jnp.tile(jnp.arange(GRID_W), n_rows)
    row_cs = rope_cos_sin(rows, HEAD_DIM // 2)
    col_cs = rope_cos_sin(cols, HEAD_DIM // 2)
    seq_cs = rope_cos_sin(jnp.arange(s), C_ROPE_DIM)
    rpb_bias = band_relative_bias(rpb_table)

    x = layer_norm(x, ln_in_g, ln_in_b)
    for l in range(DEPTH):
        mix = token_mixer(x, w_in[l], a_q_norm_g[l], a_k_norm_g[l], b_sink[l], rpb_bias,
                          c_q_norm_g[l], c_kv_norm_g[l], c_w_uq[l], c_w_ukv[l],
                          w_branch_a[l], w_branch_b[l], w_branch_c[l], w_o[l],
                          row_cs, col_cs, seq_cs)
        x = layer_norm(DEEPNORM_ALPHA * x + mix, ln1_g[l], ln1_b[l])
        ffn = grouped_moe(x, router_w, router_bias, w_gate[l], w_up[l], w_down[l])
        x = layer_norm(DEEPNORM_ALPHA * x + ffn, ln2_g[l], ln2_b[l])
    return x
```

```cpp
#include <hip/hip_runtime.h>
#include <cstdio>
#include <cstdint>

#ifndef PHMASK
#define PHMASK 0xFFF
#endif
#define EN(k) (((PHMASK) >> (k)) & 1)
#ifndef ONE_LAUNCH
#define ONE_LAUNCH 0
#endif

#define GAS __attribute__((address_space(1)))
#define LAS __attribute__((address_space(3)))
typedef unsigned short bf16;
typedef short bf16x8 __attribute__((ext_vector_type(8)));
typedef float f32x4 __attribute__((ext_vector_type(4)));
typedef float f32x2 __attribute__((ext_vector_type(2)));
typedef unsigned u32x4 __attribute__((ext_vector_type(4)));
typedef unsigned u32x2 __attribute__((ext_vector_type(2)));
#define DI __device__ __forceinline__

constexpr int NTOK = 32768, DM = 1024, SEQ = 2048, NBATCH = 16, DEPTH = 2;
constexpr int P1W = 2304, GW = 3072, INW = 5376, QCW = 768, KVW = 1024, INCOLS = 5280;
constexpr int NEXP = 16, DFF = 512, SLOT_ROWS = 69632, LIST_CAP = 32768;
constexpr float EPS = 1e-6f, ALPHA = 1.4142135623730951f, LOG2E = 1.4426950408889634f;
constexpr float C2_64 = 0.125f * LOG2E;
constexpr float C2_96 = 0.10206207261596577f * LOG2E;
constexpr int C_QA = 0, C_KA = 512, C_VA = 640, C_QB = 768, C_KB = 1280, C_VB = 1408, C_CQ = 1536, C_CKV = 1920, C_KR = 2176;

constexpr size_t MiB = 1u << 20;
constexpr size_t WS_CTL = 0, CTL_ZERO_BYTES = 1 * MiB;
constexpr size_t WS_ROPE = 1 * MiB;
constexpr size_t WS_TB = WS_ROPE + 2048 * 16 * 8;
constexpr size_t WS_RSTDQ = WS_TB + 8 * 260 * 4 + 1728;
constexpr size_t WS_RSTDKV = WS_RSTDQ + NTOK * 4;
constexpr size_t WS_LIST = 2 * MiB;
constexpr size_t WS_ROUTE = 4 * MiB;
constexpr size_t WS_W = 8 * MiB;
constexpr size_t W_WIN = 0, W_WUQ = 11010048, W_WUKV = 11599872, W_WBR = 12124160, W_WO = 15269888, W_WGU = 17367040, W_WD = 50921472, W_END = 67698688;
constexpr size_t WS_XB = 74 * MiB;
constexpr size_t WS_P1 = 138 * MiB;
constexpr size_t WS_G = 282 * MiB;
constexpr size_t WS_END = 474 * MiB;
static_assert(WS_W + W_END <= WS_XB && WS_RSTDKV + NTOK * 4 <= WS_LIST, "ws map");
static_assert((size_t)SLOT_ROWS * 1024 * 2 <= WS_END - WS_G && (size_t)SLOT_ROWS * 512 * 2 <= WS_G - WS_P1, "ws map 2");
constexpr size_t DO_QC = 0, DO_KVC = 48 * MiB;
constexpr int CW_BAR = 4096;
constexpr int CW_GCNT = 16384;

constexpr int RING_BYTES = 131072, LDSCTL_OFF = RING_BYTES, LDS_BYTES = 147456;

DI float bf2f(unsigned short h) { return __builtin_bit_cast(float, (unsigned)h << 16); }
DI float bflo(unsigned w) { return __builtin_bit_cast(float, w << 16); }
DI float bfhi(unsigned w) { return __builtin_bit_cast(float, w & 0xffff0000u); }
DI unsigned f2bf(float f) { unsigned u = __builtin_bit_cast(unsigned, f); return (u + 0x7fffu + ((u >> 16) & 1u)) >> 16; }
DI unsigned pk2(float lo, float hi) { return f2bf(lo) | (f2bf(hi) << 16); }
DI unsigned cvt_pk_bf16(float lo, float hi) { unsigned r; asm volatile("v_cvt_pk_bf16_f32 %0, %1, %2" : "=v"(r) : "v"(lo), "v"(hi)); return r; }
DI float fsigmoid(float x) { return __builtin_amdgcn_rcpf(1.0f + __builtin_amdgcn_exp2f(-x * LOG2E)); }
DI float wave_sum(float v) {
#pragma unroll
    for (int o = 1; o < 64; o <<= 1) v += __shfl_xor(v, o);
    return v;
}
#define LDS_WAIT() asm volatile("s_waitcnt lgkmcnt(0)" ::: "memory")
#define VM_WAIT() asm volatile("s_waitcnt vmcnt(0)" ::: "memory")

namespace pg8 {
constexpr int BM = 256, BK = 64, HALF = 128, HTB = HALF * BK * 2, STAGE_BYTES = 8 * HTB, NXCD = 8, WGM = 8;
DI int lds_byte(int r, int c) { const int st = (r >> 4) * 2 + (c >> 5), rr = r & 15, cc = c & 31, ob = rr * 64 + cc * 2; return st * 1024 + (ob ^ (((ob >> 9) & 1) << 5)); }
DI void stage_rc(int b, int& R, int& C) { const int st = b / 1024, sb = b % 1024, swz = sb ^ (((sb >> 9) & 1) << 5); R = (st >> 1) * 16 + swz / 64; C = (st & 1) * 32 + (swz % 64) / 2; }
DI int perm32(int rho) { const int n = rho >> 4, i = rho & 15; return 8 * (i >> 2) + 4 * n + (i & 3); }

struct Unit { int pm, pn, e, aux; };
struct TileOrder {
    int nM, nN, nwg, G, c;
    DI void init(int nM_, int nN_, int G_, int c_) { nM = nM_; nN = nN_; nwg = nM * nN; G = G_; c = c_; }
    DI bool tile(int i, int& pm, int& pn) const {
        const long L = (long)i * G + c; if (L >= nwg) return false;
        int wgid = (int)L; { const int q = nwg / NXCD, r = nwg % NXCD, xcd = wgid % NXCD, off = wgid / NXCD; wgid = (xcd < r ? xcd * (q + 1) : r * (q + 1) + (xcd - r) * q) + off; }
        const int nig = WGM * nN, gid = wgid / nig, fm = gid * WGM, gsz = (nM - fm) < WGM ? (nM - fm) : WGM;
        pm = fm + ((wgid % nig) % gsz); pn = (wgid % nig) / gsz; return true;
    }
};

template <class Epi, class Sched, bool ALIGN_EPI>
DI void gemm_phase(LAS unsigned char* lds, const int tid, const int K, const unsigned ldb2, const Sched& S, const Epi& E) {
    const int wid = __builtin_amdgcn_readfirstlane(tid >> 6), lane = tid & 63, wr = wid >> 2, wc = wid & 3, fr = lane & 15, fq = lane >> 4;
    const int nt = K / BK;
    int Rr[2], Cc[2]; unsigned voffA[2], voffB[2];
    const unsigned lda2 = S.lda2;
#pragma unroll
    for (int i = 0; i < 2; ++i) { int R, C; stage_rc(tid * 16 + i * 8192, R, C); const int Rb = Epi::PERM ? ((R & ~31) + perm32(R & 31)) : R;
        Rr[i] = R; Cc[i] = C * 2; voffA[i] = (unsigned)R * lda2 + (unsigned)C * 2u; voffB[i] = (unsigned)Rb * ldb2 + (unsigned)C * 2u; }
    const size_t kstep = (size_t)(BK * 2);
    const size_t hstepB = (size_t)HALF * ldb2, hstepA = (size_t)HALF * lda2;
    const unsigned ldsw = (unsigned)wid * 1024u;
    const int aoff = lds_byte(wr * 64 + fr, fq * 8), boff = lds_byte(wc * 32 + fr, fq * 8);
#define PG8_SA(b, h) (((b) * 2 + (h)) * HTB)
#define PG8_SB(b, h) ((4 + (b) * 2 + (h)) * HTB)
#define PG8_STAGE(bufoff, gbase, voff) do { _Pragma("unroll") for (int _i = 0; _i < 2; ++_i) \
        __builtin_amdgcn_global_load_lds((const unsigned*)((const char*)(gbase) + (voff)[_i]), (LAS unsigned*)(lds + (bufoff) + ldsw + _i * 8192), 16, 0, 0); } while (0)
#define PG8_STAGE_A(bufoff, gbase, h, g0, g1) do { if constexpr (Sched::GATHER) { if ((h) == 0) PG8_STAGE(bufoff, gbase, g0); else PG8_STAGE(bufoff, gbase, g1); } \
        else { PG8_STAGE(bufoff, (gbase) + (h) * hstepA, voffA); } } while (0)
#define PG8_LDA(dst, b, h) do { _Pragma("unroll") for (int m = 0; m < 4; ++m) _Pragma("unroll") for (int k = 0; k < 2; ++k) dst[m][k] = *(const LAS bf16x8*)(lds + PG8_SA(b, h) + aoff + m * 2048 + k * 1024); } while (0)
#define PG8_LDB(dst, b, h) do { _Pragma("unroll") for (int n = 0; n < 2; ++n) _Pragma("unroll") for (int k = 0; k < 2; ++k) dst[n][k] = *(const LAS bf16x8*)(lds + PG8_SB(b, h) + boff + n * 2048 + k * 1024); } while (0)
#define PG8_MMA(ai, bj, At, Bt) do { __builtin_amdgcn_s_setprio(1); _Pragma("unroll") for (int m = 0; m < 4; ++m) _Pragma("unroll") for (int n = 0; n < 2; ++n) _Pragma("unroll") for (int k = 0; k < 2; ++k) \
        acc[ai][bj][m][n] = __builtin_amdgcn_mfma_f32_16x16x32_bf16(Bt[n][k], At[m][k], acc[ai][bj][m][n], 0, 0, 0); __builtin_amdgcn_s_setprio(0); } while (0)
#define PG8_WAIT_V(n) asm volatile("s_waitcnt vmcnt(" #n ")" ::: "memory")
#define PG8_WAIT_L(n) asm volatile("s_waitcnt lgkmcnt(" #n ")" ::: "memory")
#define PG8_BAR __builtin_amdgcn_s_barrier()
#define PG8_SCHED __builtin_amdgcn_sched_barrier(0)
    Unit cur, nxt; int ui = 0;
    if (!S.next(0, cur)) return;
    f32x4 acc[2][2][4][2];
    float zf = 0.f; asm volatile("" : "+v"(zf));
#pragma unroll
    for (int a = 0; a < 2; ++a)
#pragma unroll
        for (int b = 0; b < 2; ++b)
#pragma unroll
            for (int m = 0; m < 4; ++m)
#pragma unroll
                for (int n = 0; n < 2; ++n) acc[a][b][m][n] = (f32x4){zf, zf, zf, zf};
    bf16x8 At[4][2], B0[2][2], B1[2][2];
    unsigned ao0[2] = {0u, 0u}, ao1[2] = {0u, 0u}, no0[2] = {0u, 0u}, no1[2] = {0u, 0u};
    if constexpr (Sched::GATHER) {
#pragma unroll
        for (int i = 0; i < 2; ++i) { ao0[i] = S.a_off(cur, Rr[i]) + Cc[i]; ao1[i] = S.a_off(cur, HALF + Rr[i]) + Cc[i]; } }
    const char* cA = S.a_base(cur); const char* cB = S.b_base(cur);
    PG8_STAGE(PG8_SB(0, 0), cB, voffB); PG8_STAGE(PG8_SB(0, 1), cB + hstepB, voffB); PG8_STAGE_A(PG8_SA(0, 0), cA, 0, ao0, ao1); PG8_STAGE_A(PG8_SA(0, 1), cA, 1, ao0, ao1);
    if (wr == 1) PG8_BAR;
    PG8_WAIT_V(2); PG8_BAR;
    PG8_STAGE(PG8_SB(1, 0), cB + kstep, voffB); PG8_STAGE_A(PG8_SA(1, 0), cA + kstep, 0, ao0, ao1); PG8_STAGE(PG8_SB(1, 1), cB + hstepB + kstep, voffB);
    PG8_WAIT_V(6); PG8_BAR;
    for (;;) {
        const bool has_next = S.next(ui + 1, nxt);
        const char* nA = cA; const char* nB = cB;
        if constexpr (Sched::GATHER) {
#pragma unroll
            for (int i = 0; i < 2; ++i) { no0[i] = ao0[i]; no1[i] = ao1[i]; } }
        if (has_next) { nA = S.a_base(nxt); nB = S.b_base(nxt);
            if constexpr (Sched::GATHER) {
#pragma unroll
                for (int i = 0; i < 2; ++i) { no0[i] = S.a_off(nxt, Rr[i]) + Cc[i]; no1[i] = S.a_off(nxt, HALF + Rr[i]) + Cc[i]; } } }
#pragma unroll 1
        for (int t = 0; t < nt; t += 2) {
            const bool last = (t == nt - 2);
            const char* a1 = cA + (size_t)(t + 1) * kstep;
            const char* a2 = last ? nA : cA + (size_t)(t + 2) * kstep; const char* b2 = last ? nB : cB + (size_t)(t + 2) * kstep;
            const char* a3 = a2 + kstep; const char* b3 = b2 + kstep;
            unsigned x0[2] = {0u, 0u}, x1[2] = {0u, 0u};
            if constexpr (Sched::GATHER) {
#pragma unroll
                for (int i = 0; i < 2; ++i) { x0[i] = last ? no0[i] : ao0[i]; x1[i] = last ? no1[i] : ao1[i]; } }
            PG8_LDB(B0, 0, 0); PG8_LDB(B1, 0, 1); PG8_SCHED; PG8_LDA(At, 0, 0); PG8_STAGE_A(PG8_SA(1, 1), a1, 1, ao0, ao1);
            PG8_WAIT_V(8); PG8_WAIT_L(0); PG8_BAR; PG8_MMA(0, 0, At, B0); PG8_MMA(0, 1, At, B1); PG8_BAR; PG8_SCHED;
            PG8_LDA(At, 0, 1); PG8_STAGE(PG8_SB(0, 0), b2, voffB); PG8_STAGE(PG8_SB(0, 1), b2 + hstepB, voffB); PG8_STAGE_A(PG8_SA(0, 0), a2, 0, x0, x1);
            PG8_WAIT_V(8); PG8_WAIT_L(0); PG8_BAR; PG8_MMA(1, 0, At, B0); PG8_MMA(1, 1, At, B1); PG8_BAR; PG8_SCHED;
            PG8_LDB(B0, 1, 0); PG8_LDB(B1, 1, 1); PG8_SCHED; PG8_LDA(At, 1, 0); PG8_STAGE_A(PG8_SA(0, 1), a2, 1, x0, x1);
            PG8_WAIT_V(8); PG8_WAIT_L(0); PG8_BAR; PG8_MMA(0, 0, At, B0); PG8_MMA(0, 1, At, B1); PG8_BAR; PG8_SCHED;
            PG8_LDA(At, 1, 1); PG8_STAGE(PG8_SB(1, 0), b3, voffB); PG8_STAGE(PG8_SB(1, 1), b3 + hstepB, voffB); PG8_STAGE_A(PG8_SA(1, 0), a3, 0, x0, x1);
            PG8_WAIT_V(8); PG8_WAIT_L(0); PG8_BAR; PG8_MMA(1, 0, At, B0); PG8_MMA(1, 1, At, B1); PG8_BAR; PG8_SCHED;
        }
        if constexpr (ALIGN_EPI) { if (wr == 0) PG8_BAR; }
        E(acc, cur, wr, wc, fr, fq);
        if (!has_next) break;
#pragma unroll
        for (int a = 0; a < 2; ++a)
#pragma unroll
            for (int b = 0; b < 2; ++b)
#pragma unroll
                for (int m = 0; m < 4; ++m)
#pragma unroll
                    for (int n = 0; n < 2; ++n) acc[a][b][m][n] = (f32x4){zf, zf, zf, zf};
        cur = nxt; cA = nA; cB = nB; ++ui;
        if constexpr (Sched::GATHER) {
#pragma unroll
            for (int i = 0; i < 2; ++i) { ao0[i] = no0[i]; ao1[i] = no1[i]; } }
        if constexpr (ALIGN_EPI) { if (wr == 1) PG8_BAR; }
    }
    PG8_WAIT_V(0);
    if constexpr (!ALIGN_EPI) { if (wr == 0) PG8_BAR; }
    PG8_BAR;
#undef PG8_SA
#undef PG8_SB
#undef PG8_STAGE
#undef PG8_STAGE_A
#undef PG8_LDA
#undef PG8_LDB
#undef PG8_MMA
#undef PG8_WAIT_V
#undef PG8_WAIT_L
#undef PG8_BAR
#undef PG8_SCHED
}

struct SchedPlain {
    static constexpr bool GATHER = false;
    TileOrder o; const char* A; const char* Bt; unsigned lda2, ldb2;
    DI bool next(int i, Unit& u) const { u.e = 0; u.aux = 0; return o.tile(i, u.pm, u.pn); }
    DI const char* a_base(const Unit& u) const { return A + (size_t)u.pm * BM * lda2; }
    DI unsigned a_off(const Unit&, int) const { return 0u; }
    DI const char* b_base(const Unit& u) const { return Bt + (size_t)u.pn * BM * ldb2; }
};
struct SchedMerge {
    static constexpr bool GATHER = false;
    TileOrder o; const char* P1; const char* Wbr; unsigned lda2;
    DI bool next(int i, Unit& u) const { u.e = i % 3; u.aux = 0; return o.tile(i / 3, u.pm, u.pn); }
    DI const char* a_base(const Unit& u) const { return P1 + (size_t)u.e * (768 * 2) + (size_t)u.pm * BM * lda2; }
    DI unsigned a_off(const Unit&, int) const { return 0u; }
    DI const char* b_base(const Unit& u) const { return Wbr + (size_t)u.e * (1024 * 512 * 2) + (size_t)u.pn * BM * 1024; }
};
template <bool GATHER_> struct SchedMoe {
    static constexpr bool GATHER = GATHER_;
    int total_panels, G, c; const volatile LAS int* tab; const int* list; const char* A; const char* W; unsigned lda2; size_t wstride; unsigned ldb2;
    DI bool next(int i, Unit& u) const {
        const int L = i * G + c; if (L >= total_panels * 4) return false;
        const int panel = L >> 2; u.pn = L & 3; u.pm = panel; int e = 0;
#pragma unroll
        for (int j = 1; j < 16; ++j) e += (panel >= tab[j]) ? 1 : 0;
        u.e = e; u.aux = (panel - tab[e]) * BM; return true;
    }
    DI const char* a_base(const Unit& u) const { return GATHER ? A : A + (size_t)u.pm * BM * lda2; }
    DI unsigned a_off(const Unit& u, int r) const {
        int pos = u.aux + r; const int cnt = tab[32 + u.e]; pos = pos < cnt ? pos : cnt - 1; return (unsigned)list[u.e * LIST_CAP + pos] * lda2;
    }
    DI const char* b_base(const Unit& u) const { return W + (size_t)u.e * wstride + (size_t)u.pn * BM * ldb2; }
};

struct EpiInproj {
    static constexpr bool PERM = true;
    bf16* P1; bf16* G;
    DI void operator()(const f32x4 (&acc)[2][2][4][2], const Unit& u, int wr, int wc, int fr, int fq) const {
        const int row0 = u.pm * BM + wr * 64 + fr; const bool sig = u.pn >= 9;
        bf16* base = sig ? G : P1; const int ld = sig ? GW : P1W; const int col0 = (sig ? (u.pn - 9) : u.pn) * BM + wc * 32 + 8 * fq;
#pragma unroll
        for (int ai = 0; ai < 2; ++ai)
#pragma unroll
            for (int m = 0; m < 4; ++m) { bf16* rowp = base + (size_t)(row0 + ai * HALF + m * 16) * ld + col0;
#pragma unroll
                for (int bj = 0; bj < 2; ++bj) { f32x4 v0 = acc[ai][bj][m][0], v1 = acc[ai][bj][m][1];
                    if (sig) {
#pragma unroll
                        for (int j = 0; j < 4; ++j) { v0[j] = fsigmoid(v0[j]); v1[j] = fsigmoid(v1[j]); } }
                    u32x4 w; w.x = cvt_pk_bf16(v0[0], v0[1]); w.y = cvt_pk_bf16(v0[2], v0[3]); w.z = cvt_pk_bf16(v1[0], v1[1]); w.w = cvt_pk_bf16(v1[2], v1[3]);
                    *(u32x4*)(rowp + bj * HALF) = w; } }
    }
};
struct EpiBf16 {
    static constexpr bool PERM = true;
    bf16* O; int ldc; const float* rscale;
    DI void operator()(const f32x4 (&acc)[2][2][4][2], const Unit& u, int wr, int wc, int fr, int fq) const {
        const int row0 = u.pm * BM + wr * 64 + fr; const int col0 = u.pn * BM + wc * 32 + 8 * fq;
#pragma unroll
        for (int ai = 0; ai < 2; ++ai)
#pragma unroll
            for (int m = 0; m < 4; ++m) { const int row = row0 + ai * HALF + m * 16; bf16* rowp = O + (size_t)row * ldc + col0; const float s = rscale ? rscale[row] : 1.0f;
#pragma unroll
                for (int bj = 0; bj < 2; ++bj) { const f32x4 v0 = acc[ai][bj][m][0] * s, v1 = acc[ai][bj][m][1] * s;
                    u32x4 w; w.x = cvt_pk_bf16(v0[0], v0[1]); w.y = cvt_pk_bf16(v0[2], v0[3]); w.z = cvt_pk_bf16(v1[0], v1[1]); w.w = cvt_pk_bf16(v1[2], v1[3]);
                    *(u32x4*)(rowp + bj * HALF) = w; } }
    }
};
struct EpiMerge {
    static constexpr bool PERM = true;
    bf16* MG; const bf16* G;
    DI void operator()(const f32x4 (&acc)[2][2][4][2], const Unit& u, int wr, int wc, int fr, int fq) const {
        const int row0 = u.pm * BM + wr * 64 + fr; const int col0 = u.pn * BM + wc * 32 + 8 * fq;
#pragma unroll
        for (int ai = 0; ai < 2; ++ai)
#pragma unroll
            for (int m = 0; m < 4; ++m) { const int row = row0 + ai * HALF + m * 16; bf16* rowp = MG + (size_t)row * DM + col0; const bf16* gp = G + (size_t)row * GW + u.e * DM + col0;
#pragma unroll
                for (int bj = 0; bj < 2; ++bj) { const f32x4 a0 = acc[ai][bj][m][0], a1 = acc[ai][bj][m][1];
                    const u32x4 g = *(const u32x4*)(gp + bj * HALF); u32x4 p = (u32x4){0u, 0u, 0u, 0u}; if (u.e > 0) p = *(const u32x4*)(rowp + bj * HALF);
                    u32x4 w;
                    w.x = cvt_pk_bf16(bflo(p.x) + bflo(g.x) * a0[0], bfhi(p.x) + bfhi(g.x) * a0[1]); w.y = cvt_pk_bf16(bflo(p.y) + bflo(g.y) * a0[2], bfhi(p.y) + bfhi(g.y) * a0[3]);
                    w.z = cvt_pk_bf16(bflo(p.z) + bflo(g.z) * a1[0], bfhi(p.z) + bfhi(g.z) * a1[1]); w.w = cvt_pk_bf16(bflo(p.w) + bflo(g.w) * a1[2], bfhi(p.w) + bfhi(g.w) * a1[3]);
                    *(u32x4*)(rowp + bj * HALF) = w; } }
    }
};
struct EpiWo {
    static constexpr bool PERM = false;
    float* Y; const bf16* XB;
    DI void operator()(const f32x4 (&acc)[2][2][4][2], const Unit& u, int wr, int wc, int fr, int fq) const {
        const int row0 = u.pm * BM + wr * 64 + fr, col0 = u.pn * BM + wc * 32 + 4 * fq;
#pragma unroll
        for (int ai = 0; ai < 2; ++ai)
#pragma unroll
            for (int m = 0; m < 4; ++m) { const size_t off = (size_t)(row0 + ai * HALF + m * 16) * DM + col0;
#pragma unroll
                for (int bj = 0; bj < 2; ++bj)
#pragma unroll
                    for (int n = 0; n < 2; ++n) { const u32x2 xb = *(const u32x2*)(XB + off + bj * HALF + n * 16); f32x4 o = acc[ai][bj][m][n];
                        o[0] += ALPHA * bflo(xb.x); o[1] += ALPHA * bfhi(xb.x); o[2] += ALPHA * bflo(xb.y); o[3] += ALPHA * bfhi(xb.y);
                        *(f32x4*)(Y + off + bj * HALF + n * 16) = o; } }
    }
};
struct EpiMoeUp {
    static constexpr bool PERM = true;
    bf16* H;
    DI void operator()(const f32x4 (&acc)[2][2][4][2], const Unit& u, int wr, int wc, int fr, int fq) const {
        const int row0 = u.pm * BM + wr * 64 + fr; const int col0 = u.pn * HALF + wc * 32 + 8 * fq;
#pragma unroll
        for (int ai = 0; ai < 2; ++ai)
#pragma unroll
            for (int m = 0; m < 4; ++m) { bf16* rowp = H + (size_t)(row0 + ai * HALF + m * 16) * DFF + col0; float o[8];
#pragma unroll
                for (int n = 0; n < 2; ++n)
#pragma unroll
                    for (int j = 0; j < 4; ++j) { const float g = acc[ai][0][m][n][j], up = acc[ai][1][m][n][j]; o[n * 4 + j] = g * fsigmoid(g) * up; }
                u32x4 w; w.x = cvt_pk_bf16(o[0], o[1]); w.y = cvt_pk_bf16(o[2], o[3]); w.z = cvt_pk_bf16(o[4], o[5]); w.w = cvt_pk_bf16(o[6], o[7]);
                *(u32x4*)rowp = w; }
    }
};
}

#define XB_TMO      128
#define XB_XCNT(j)  (256  + 64 * (j))
#define XB_XSUB(j)  (1280 + 64 * (j))
#define XB_XGEN(j)  (2304 + 64 * (j))
#define XB_TOP      3328
#define XB_TOPGEN   3392
#define XCD_BAR_WORDS 3456
#define XB_SPIN_CAP (1u << 18)
DI unsigned xb_ld(unsigned* p)              { return __hip_atomic_load(p, __ATOMIC_RELAXED, __HIP_MEMORY_SCOPE_AGENT); }
DI unsigned xb_add(unsigned* p, unsigned v) { return __hip_atomic_fetch_add(p, v, __ATOMIC_RELAXED, __HIP_MEMORY_SCOPE_AGENT); }
DI unsigned xb_xcc_id() { return (unsigned)__builtin_amdgcn_s_getreg((3 << 11) | 20) & 0xFu; }
#define XB_SPIN(cond, bar) do { unsigned _sp = 0; while (cond) { __builtin_amdgcn_s_sleep(1); \
    if ((++_sp & 255u) == 0u) { if (xb_ld(&(bar)[XB_TMO])) break; if (_sp > XB_SPIN_CAP) { atomicAdd(&(bar)[XB_TMO], 1u); break; } } } } while (0)
struct XcdBarrier { unsigned* bar; unsigned x; volatile LAS unsigned* st; };
DI XcdBarrier xcd_barrier_post(unsigned* bar, volatile LAS unsigned* st) {
    XcdBarrier b; b.bar = bar; b.x = xb_xcc_id(); b.st = st;
    if (threadIdx.x == 0) (void)xb_add(&bar[XB_XCNT(b.x)], 1u);
    return b;
}
DI void xcd_barrier_complete(unsigned* bar, unsigned x, unsigned& nloc, unsigned& nx) {
    const unsigned G = gridDim.x * gridDim.y * gridDim.z;
    unsigned sum, cnt, mine, sp = 0u;
    for (;;) {
        sum = 0u; cnt = 0u; mine = 0u;
#pragma unroll
        for (unsigned j = 0; j < 16; ++j) { const unsigned c = xb_ld(&bar[XB_XCNT(j)]); sum += c; cnt += (c > 0u) ? 1u : 0u; mine = (j == x) ? c : mine; }
        if (sum == G) break;
        __builtin_amdgcn_s_sleep(1);
        if ((++sp & 255u) == 0u) { if (xb_ld(&bar[XB_TMO])) break; if (sp > XB_SPIN_CAP) { atomicAdd(&bar[XB_TMO], 1u); break; } }
    }
    nloc = mine > 0u ? mine : 1u; nx = cnt > 0u ? cnt : 1u;
}
DI void xcd_barrier(const XcdBarrier& b) {
    asm volatile("s_waitcnt vmcnt(0)" ::: "memory");
    __syncthreads();
    if (threadIdx.x == 0) {
        unsigned* bar = b.bar;
        __builtin_amdgcn_s_waitcnt(0);
        unsigned nloc = b.st[0], nx = b.st[1];
        if (nloc == 0u) { xcd_barrier_complete(bar, b.x, nloc, nx); b.st[0] = nloc; b.st[1] = nx; }
        const unsigned old = xb_add(&bar[XB_XSUB(b.x)], 1u);
        const unsigned gen = old / nloc;
        if (old + 1u == (gen + 1u) * nloc) {
            __builtin_amdgcn_fence(__ATOMIC_RELEASE, "agent");
            asm volatile("s_waitcnt vmcnt(0)" ::: "memory");
            const unsigned og = xb_add(&bar[XB_TOP], 1u);
            const unsigned tg = og / nx;
            if (og + 1u == (tg + 1u) * nx) xb_add(&bar[XB_TOPGEN], 1u);
            else XB_SPIN(xb_ld(&bar[XB_TOPGEN]) == tg, bar);
            __builtin_amdgcn_fence(__ATOMIC_ACQUIRE, "agent");
            xb_add(&bar[XB_XGEN(b.x)], 1u);
            asm volatile("s_waitcnt vmcnt(0)" ::: "memory");
        } else {
            XB_SPIN(xb_ld(&bar[XB_XGEN(b.x)]) == gen, bar);
            __builtin_amdgcn_fence(__ATOMIC_ACQUIRE, "agent");
            asm volatile("s_waitcnt vmcnt(0)" ::: "memory");
        }
    }
    __syncthreads();
}

DI float inv_freq16(int i) {
    const float t = (float)i * (-13.287712379549449f / 16.0f);
    return __builtin_amdgcn_exp2f(t);
}
DI void cos_sin(double a, float& c, float& s) {
    const double kq = __builtin_rint(a * 0.63661977236758134308);
    const double r = a - kq * 1.57079632679489661923;
    const double r2 = r * r;
    const double sp = r * (1.0 + r2 * (-1.0 / 6 + r2 * (1.0 / 120 + r2 * (-1.0 / 5040 + r2 * (1.0 / 362880 + r2 * (-1.0 / 39916800))))));
    const double cp = 1.0 + r2 * (-0.5 + r2 * (1.0 / 24 + r2 * (-1.0 / 720 + r2 * (1.0 / 40320 + r2 * (-1.0 / 3628800 + r2 * (1.0 / 479001600))))));
    const int q = (int)kq & 3;
    const double cc = (q == 0) ? cp : (q == 1) ? -sp : (q == 2) ? -cp : sp;
    const double ss = (q == 0) ? sp : (q == 1) ? cp : (q == 2) ? -sp : -cp;
    c = (float)cc; s = (float)ss;
}
DI int t5_bucket_n(int n) { return n < 8 ? n : n < 12 ? 8 : n < 16 ? 9 : n < 23 ? 10 : n < 32 ? 11 : n < 46 ? 12 : n < 64 ? 13 : n < 91 ? 14 : 15; }

DI void transpose_item(const float* W, int Nsrc, int k0, int n0, bf16* WT, int Kdst, int d0, const float* kscale, LAS float* scr, int lane) {
#pragma unroll 8
    for (int i = 0; i < 32; ++i) { const int kk = 2 * i + (lane >> 5); float v = W[(size_t)(k0 + kk) * Nsrc + n0 + (lane & 31)]; if (kscale) v *= kscale[k0 + kk]; scr[kk * 33 + (lane & 31)] = v; }
    LDS_WAIT(); asm volatile("" ::: "memory");
    const int c = lane & 7;
#pragma unroll
    for (int j = 0; j < 4; ++j) { const int n = (lane >> 3) + 8 * j; const LAS float* s = scr + (8 * c) * 33 + n;
        u32x4 o; o.x = pk2(s[0 * 33], s[1 * 33]); o.y = pk2(s[2 * 33], s[3 * 33]); o.z = pk2(s[4 * 33], s[5 * 33]); o.w = pk2(s[6 * 33], s[7 * 33]);
        *(GAS u32x4*)(WT + (size_t)(d0 + n) * Kdst + k0 + 8 * c) = o; }
    LDS_WAIT(); asm volatile("" ::: "memory");
}

struct Args { const float* in[25]; float* out; unsigned char* ws; int ph_lo, ph_hi; };

template <int TYPE>
DI void naive_attn_item(const Args& args, int l, int b, int h, int t) {
    constexpr int DQ = TYPE == 2 ? 96 : 64;
    unsigned char* ws = args.ws;
    bf16* P1 = (bf16*)(ws + WS_P1); bf16* QC = (bf16*)((unsigned char*)args.out + DO_QC); const bf16* KVC = (const bf16*)((unsigned char*)args.out + DO_KVC);
    const f32x2* ROPE = (const f32x2*)(ws + WS_ROPE);
    const size_t row = (size_t)b * SEQ + t;
    float q[DQ];
    const bf16* qsrc = TYPE == 0 ? P1 + row * P1W + C_QA + 64 * h : TYPE == 1 ? P1 + row * P1W + C_QB + 64 * h : QC + row * QCW + 96 * h;
#pragma unroll
    for (int c = 0; c < DQ / 8; ++c) { const u32x4 w = *(const u32x4*)(qsrc + 8 * c);
        q[8 * c + 0] = bflo(w.x); q[8 * c + 1] = bfhi(w.x); q[8 * c + 2] = bflo(w.y); q[8 * c + 3] = bfhi(w.y); q[8 * c + 4] = bflo(w.z); q[8 * c + 5] = bfhi(w.z); q[8 * c + 6] = bflo(w.w); q[8 * c + 7] = bfhi(w.w); }
    if (TYPE == 0) {
        float ss = 0.f;
#pragma unroll
        for (int d = 0; d < 64; ++d) ss += q[d] * q[d];
        const float r = 1.0f / sqrtf(ss * (1.0f / 64.0f) + EPS); const float* gq = args.in[4] + l * 64;
#pragma unroll
        for (int d = 0; d < 64; ++d) q[d] = q[d] * r * gq[d];
        const int gr = t >> 6, gc = t & 63;
#pragma unroll
        for (int i = 0; i < 16; ++i) { const f32x2 cr = ROPE[gr * 16 + i], cc = ROPE[gc * 16 + i];
            const float a1 = q[i], a2 = q[16 + i]; q[i] = a1 * cr.x - a2 * cr.y; q[16 + i] = a2 * cr.x + a1 * cr.y;
            const float b1 = q[32 + i], b2 = q[48 + i]; q[32 + i] = b1 * cc.x - b2 * cc.y; q[48 + i] = b2 * cc.x + b1 * cc.y; }
#pragma unroll
        for (int d = 0; d < 64; ++d) q[d] *= C2_64;
    } else if (TYPE == 1) {
#pragma unroll
        for (int d = 0; d < 64; ++d) q[d] *= C2_64;
    } else {
        const float rs = ((const float*)(ws + WS_RSTDQ))[row] * C2_96;
#pragma unroll
        for (int d = 0; d < 96; ++d) q[d] *= rs;
#pragma unroll
        for (int i = 0; i < 16; ++i) { const f32x2 cs = ROPE[t * 16 + i]; const float a1 = q[64 + i], a2 = q[80 + i]; q[64 + i] = a1 * cs.x - a2 * cs.y; q[80 + i] = a2 * cs.x + a1 * cs.y; }
    }
    float o[64];
#pragma unroll
    for (int d = 0; d < 64; ++d) o[d] = 0.f;
    float mx = -1e30f, lsum = 0.f;
    const int kvh = h >> 2;
    const int s_lo = TYPE == 1 ? (t - 128 < 0 ? 0 : t - 128) : 0, s_hi = TYPE == 1 ? (t + 128 > SEQ - 1 ? SEQ - 1 : t + 128) : SEQ - 1;
    const float* TB = (const float*)(ws + WS_TB) + h * 260;
    for (int s = s_lo; s <= s_hi; ++s) {
        const size_t krow = (size_t)b * SEQ + s;
        const bf16* kp = TYPE == 0 ? P1 + krow * P1W + C_KA + 64 * kvh : TYPE == 1 ? P1 + krow * P1W + C_KB + 64 * kvh : KVC + krow * KVW + 128 * h;
        const bf16* vp = TYPE == 0 ? P1 + krow * P1W + C_VA + 64 * kvh : TYPE == 1 ? P1 + krow * P1W + C_VB + 64 * kvh : KVC + krow * KVW + 128 * h + 64;
        float dot = 0.f;
#pragma unroll
        for (int c = 0; c < 8; ++c) { const u32x4 w = *(const u32x4*)(kp + 8 * c);
            dot += q[8 * c + 0] * bflo(w.x) + q[8 * c + 1] * bfhi(w.x) + q[8 * c + 2] * bflo(w.y) + q[8 * c + 3] * bfhi(w.y) + q[8 * c + 4] * bflo(w.z) + q[8 * c + 5] * bfhi(w.z) + q[8 * c + 6] * bflo(w.w) + q[8 * c + 7] * bfhi(w.w); }
        if (TYPE == 2) { const bf16* rp = P1 + krow * P1W + C_KR;
#pragma unroll
            for (int c = 0; c < 4; ++c) { const u32x4 w = *(const u32x4*)(rp + 8 * c);
                dot += q[64 + 8 * c + 0] * bflo(w.x) + q[64 + 8 * c + 1] * bfhi(w.x) + q[64 + 8 * c + 2] * bflo(w.y) + q[64 + 8 * c + 3] * bfhi(w.y) + q[64 + 8 * c + 4] * bflo(w.z) + q[64 + 8 * c + 5] * bfhi(w.z) + q[64 + 8 * c + 6] * bflo(w.w) + q[64 + 8 * c + 7] * bfhi(w.w); } }
        if (TYPE == 1) dot += TB[s - t + 128];
        const float mn = fmaxf(mx, dot), corr = __builtin_amdgcn_exp2f(mx - mn), p = __builtin_amdgcn_exp2f(dot - mn);
        lsum = lsum * corr + p; mx = mn;
#pragma unroll
        for (int c = 0; c < 8; ++c) { const u32x4 w = *(const u32x4*)(vp + 8 * c);
            o[8 * c + 0] = o[8 * c + 0] * corr + p * bflo(w.x); o[8 * c + 1] = o[8 * c + 1] * corr + p * bfhi(w.x); o[8 * c + 2] = o[8 * c + 2] * corr + p * bflo(w.y); o[8 * c + 3] = o[8 * c + 3] * corr + p * bfhi(w.y);
            o[8 * c + 4] = o[8 * c + 4] * corr + p * bflo(w.z); o[8 * c + 5] = o[8 * c + 5] * corr + p * bfhi(w.z); o[8 * c + 6] = o[8 * c + 6] * corr + p * bflo(w.w); o[8 * c + 7] = o[8 * c + 7] * corr + p * bfhi(w.w); }
    }
    if (TYPE == 1) { const float sk = args.in[6][l * 8 + h] * LOG2E; lsum += __builtin_amdgcn_exp2f(sk - mx); }
    const float inv = 1.0f / lsum;
    bf16* od = TYPE == 2 ? P1 + row * P1W + C_CQ + 64 * h : (bf16*)qsrc;
#pragma unroll
    for (int c = 0; c < 8; ++c) { u32x4 w; w.x = pk2(o[8 * c + 0] * inv, o[8 * c + 1] * inv); w.y = pk2(o[8 * c + 2] * inv, o[8 * c + 3] * inv); w.z = pk2(o[8 * c + 4] * inv, o[8 * c + 5] * inv); w.w = pk2(o[8 * c + 6] * inv, o[8 * c + 7] * inv);
        *(u32x4*)(od + 8 * c) = w; }
}

constexpr int NPH = 1 + 11 * DEPTH;
__global__ void __launch_bounds__(512, 2) fwd_kernel(Args args) {
    extern __shared__ __attribute__((aligned(16))) unsigned char lds_raw[];
    LAS unsigned char* lds = (LAS unsigned char*)lds_raw;
    volatile LAS unsigned* MISC = (volatile LAS unsigned*)(lds + LDSCTL_OFF);
    const int tid0 = threadIdx.x, wave = __builtin_amdgcn_readfirstlane(tid0 >> 6);
    const int G = gridDim.x, bx = blockIdx.x;
    const int gw = bx * 8 + wave, NGW = G * 8;
    unsigned char* const ws0 = args.ws; unsigned char* const out0 = (unsigned char*)args.out;
    for (int u = tid0; u < (LDS_BYTES - LDSCTL_OFF) / 4; u += 512) MISC[u] = 0u;
    __syncthreads();
    XcdBarrier bar; bar.bar = (unsigned*)(ws0 + WS_CTL) + CW_BAR; bar.x = 0; bar.st = nullptr;
#if ONE_LAUNCH
    bar = xcd_barrier_post((unsigned*)(ws0 + WS_CTL) + CW_BAR, MISC + 8);
#endif
    const int lo = args.ph_lo, hi = args.ph_hi;
#define IN(k) (lo <= (k) && (k) < hi)
#define SEAM(k) do { if (IN(k) && IN((k) + 1)) { if (ONE_LAUNCH) xcd_barrier(bar); } } while (0)

#define PHASE_BEGIN \
    int tid = tid0; asm volatile("" : "+v"(tid)); const int lane = tid & 63; \
    size_t zoff = 0; asm volatile("" : "+s"(zoff)); unsigned char* ws = ws0 + zoff; unsigned char* outb = out0 + zoff; \
    unsigned* ctl = (unsigned*)(ws + WS_CTL); (void)ctl; (void)lane; \
    bf16* XB = (bf16*)(ws + WS_XB); bf16* P1 = (bf16*)(ws + WS_P1); bf16* GB = (bf16*)(ws + WS_G); (void)XB; (void)P1; (void)GB; \
    bf16* QC = (bf16*)(outb + DO_QC); bf16* KVC = (bf16*)(outb + DO_KVC); bf16* MG = KVC; (void)QC; (void)KVC; (void)MG; \
    float* Y = (float*)(ws + WS_G); bf16* HID = (bf16*)(ws + WS_P1); bf16* PAIR = (bf16*)(ws + WS_G); (void)Y; (void)HID; (void)PAIR; \
    unsigned char* Wb = ws + WS_W; (void)Wb; \
    f32x2* ROPE = (f32x2*)(ws + WS_ROPE); float* TB = (float*)(ws + WS_TB); (void)ROPE; (void)TB; \
    float* RSTDQ = (float*)(ws + WS_RSTDQ); float* RSTDKV = (float*)(ws + WS_RSTDKV); (void)RSTDQ; (void)RSTDKV; \
    int* LIST = (int*)(ws + WS_LIST); unsigned* ROUTE = (unsigned*)(ws + WS_ROUTE); (void)LIST; (void)ROUTE;

    if (EN(11) && IN(0)) { PHASE_BEGIN
        for (int idx = bx * 512 + tid; idx < 2048 * 16; idx += G * 512) { const int pos = idx >> 4, i = idx & 15; float c, s; cos_sin((double)pos * (double)inv_freq16(i), c, s); ROPE[idx] = (f32x2){c, s}; }
        for (int idx = bx * 512 + tid; idx < 8 * 257; idx += G * 512) { const int h = idx / 257, r = idx % 257, rel = r - 128; const int n = rel < 0 ? -rel : rel;
            const int bk = t5_bucket_n(n) + (rel > 0 ? 16 : 0); TB[h * 260 + r] = args.in[7][bk * 8 + h] * LOG2E; }
        const float* g = args.in[1]; const float* bb = args.in[2];
        f32x4 gv[4], bv[4];
#pragma unroll
        for (int j = 0; j < 4; ++j) { gv[j] = *(const f32x4*)(g + 256 * j + 4 * lane); bv[j] = *(const f32x4*)(bb + 256 * j + 4 * lane); }
        for (int m = gw; m < NTOK; m += NGW) {
            const float* xr = args.in[0] + (size_t)m * DM; f32x4 v[4]; float s = 0.f;
#pragma unroll
            for (int j = 0; j < 4; ++j) { v[j] = *(const f32x4*)(xr + 256 * j + 4 * lane); s += (v[j].x + v[j].y) + (v[j].z + v[j].w); }
            const float mean = wave_sum(s) * (1.f / DM); float s2 = 0.f;
#pragma unroll
            for (int j = 0; j < 4; ++j) { v[j] = v[j] - mean; s2 += (v[j].x * v[j].x + v[j].y * v[j].y) + (v[j].z * v[j].z + v[j].w * v[j].w); }
            const float rstd = 1.f / sqrtf(wave_sum(s2) * (1.f / DM) + EPS);
#pragma unroll
            for (int j = 0; j < 4; ++j) { const f32x4 o = v[j] * rstd * gv[j] + bv[j]; *(u32x2*)(XB + (size_t)m * DM + 256 * j + 4 * lane) = (u32x2){pk2(o.x, o.y), pk2(o.z, o.w)}; }
        }
    }
    SEAM(0);

    for (int l = 0; l < DEPTH; ++l) {
        const int pb = 1 + 11 * l;
        if (EN(0) && IN(pb + 0)) { PHASE_BEGIN
            LAS float* scr = (LAS float*)(lds + wave * 16384);
            const float* w_in = args.in[3] + (size_t)l * DM * INCOLS;
            const float* w_uq = args.in[10] + (size_t)l * 384 * 768; const float* w_ukv = args.in[11] + (size_t)l * 256 * 1024;
            const float* w_o = args.in[15] + (size_t)l * 1024 * 1024;
            const float* w_gate = args.in[20] + (size_t)l * 16 * 1024 * 512; const float* w_up = args.in[21] + (size_t)l * 16 * 1024 * 512; const float* w_down = args.in[22] + (size_t)l * 16 * 512 * 1024;
            const float* g_cq = args.in[8] + l * 384; const float* g_ckv = args.in[9] + l * 256;
            constexpr int I0 = 16 * 165, I1 = 6 * 24, I2 = 4 * 32, I3 = 8 * 32, I6 = 16 * 32, I7 = 16 * 16 * 16, I9 = 16 * 8 * 32;
            constexpr int NIT = I0 + I1 + I2 + 3 * I3 + I6 + 2 * I7 + I9;
            for (int it = gw; it < NIT; it += NGW) {
                int r = it;
                if (r < I0) { const int kb = r / 165, nb = r % 165; transpose_item(w_in, INCOLS, 64 * kb, 32 * nb, (bf16*)(Wb + W_WIN), 1024, 32 * (nb < 69 ? nb : nb + 3), nullptr, scr, lane); continue; } r -= I0;
                if (r < I1) { const int kb = r / 24, nb = r % 24; transpose_item(w_uq, 768, 64 * kb, 32 * nb, (bf16*)(Wb + W_WUQ), 384, 32 * nb, g_cq, scr, lane); continue; } r -= I1;
                if (r < I2) { const int kb = r / 32, nb = r % 32; transpose_item(w_ukv, 1024, 64 * kb, 32 * nb, (bf16*)(Wb + W_WUKV), 256, 32 * nb, g_ckv, scr, lane); continue; } r -= I2;
                if (r < 3 * I3) { const int j = r / I3, q = r % I3, kb = q / 32, nb = q % 32; transpose_item((j == 0 ? args.in[12] : j == 1 ? args.in[13] : args.in[14]) + (size_t)l * 512 * 1024, 1024, 64 * kb, 32 * nb, (bf16*)(Wb + W_WBR) + (size_t)j * 1024 * 512, 512, 32 * nb, nullptr, scr, lane); continue; } r -= 3 * I3;
                if (r < I6) { const int kb = r / 32, nb = r % 32; transpose_item(w_o, 1024, 64 * kb, 32 * nb, (bf16*)(Wb + W_WO), 1024, 32 * nb, nullptr, scr, lane); continue; } r -= I6;
                if (r < 2 * I7) { const int up = r / I7, q = r % I7, e = q / 256, kb = (q % 256) / 16, nb = q % 16;
                    transpose_item((up ? w_up : w_gate) + (size_t)e * 1024 * 512, 512, 64 * kb, 32 * nb, (bf16*)(Wb + W_WGU) + (size_t)e * 1024 * 1024, 1024, 32 * ((nb >> 2) * 8 + up * 4 + (nb & 3)), nullptr, scr, lane); continue; } r -= 2 * I7;
                { const int e = r / 256, kb = (r % 256) / 32, nb = r % 32; transpose_item(w_down + (size_t)e * 512 * 1024, 1024, 64 * kb, 32 * nb, (bf16*)(Wb + W_WD) + (size_t)e * 1024 * 512, 512, 32 * nb, nullptr, scr, lane); }
            }
            { unsigned zu = 0u; asm volatile("" : "+v"(zu));
              for (int idx = bx * 512 + tid; idx < 96 * 1024 / 8; idx += G * 512) *(u32x4*)((bf16*)(Wb + W_WIN) + (size_t)2208 * 1024 + (size_t)idx * 8) = (u32x4){zu, zu, zu, zu}; }
        }
        SEAM(pb + 0);

        if (EN(1) && IN(pb + 1)) { PHASE_BEGIN
            pg8::SchedPlain S; S.o.init(NTOK / 256, INW / 256, G, bx); S.A = (const char*)XB; S.Bt = (const char*)(Wb + W_WIN); S.lda2 = 2048; S.ldb2 = 2048;
            pg8::EpiInproj E{P1, GB};
            pg8::gemm_phase<pg8::EpiInproj, pg8::SchedPlain, true>(lds, tid, 1024, 2048, S, E);
        }
        SEAM(pb + 1);

        if (EN(2) && IN(pb + 2)) { PHASE_BEGIN
            const float* gk = args.in[5] + l * 64;
            for (int m = gw; m < NTOK; m += NGW) {
                bf16* pr = P1 + (size_t)m * P1W; const int t = m & (SEQ - 1), gr = t >> 6, gc = t & 63;
                {
                    const int ll = lane & 31; const unsigned w = *(const unsigned*)(pr + C_KA + 2 * lane); float a = bflo(w), b = bfhi(w);
                    float ss = a * a + b * b;
#pragma unroll
                    for (int o = 1; o < 32; o <<= 1) ss += __shfl_xor(ss, o);
                    const float r = 1.0f / sqrtf(ss * (1.0f / 64.0f) + EPS); const int d = 2 * ll; a = a * r * gk[d]; b = b * r * gk[d + 1];
                    const float pa = __shfl_xor(a, 8), pbv = __shfl_xor(b, 8);
                    const int pos = ll < 16 ? gr : gc, i0 = d & 15; const f32x2 c0 = ROPE[pos * 16 + i0], c1 = ROPE[pos * 16 + i0 + 1];
                    const bool first = (ll & 8) == 0;
                    const float oa = first ? a * c0.x - pa * c0.y : a * c0.x + pa * c0.y, ob = first ? b * c1.x - pbv * c1.y : b * c1.x + pbv * c1.y;
                    *(unsigned*)(pr + C_KA + 2 * lane) = pk2(oa, ob);
                }
                {
                    const float v = lane < 32 ? bf2f(pr[C_KR + lane]) : 0.f; const float p = __shfl_xor(v, 16);
                    const f32x2 cs = ROPE[t * 16 + (lane & 15)]; const float o = (lane < 16) ? v * cs.x - p * cs.y : v * cs.x + p * cs.y;
                    if (lane < 32) pr[C_KR + lane] = (bf16)f2bf(o);
                }
                {
                    float sq = 0.f, sk = 0.f;
#pragma unroll
                    for (int j = 0; j < 3; ++j) { const unsigned w = *(const unsigned*)(pr + C_CQ + 128 * j + 2 * lane); sq += bflo(w) * bflo(w) + bfhi(w) * bfhi(w); }
#pragma unroll
                    for (int j = 0; j < 2; ++j) { const unsigned w = *(const unsigned*)(pr + C_CKV + 128 * j + 2 * lane); sk += bflo(w) * bflo(w) + bfhi(w) * bfhi(w); }
                    sq = wave_sum(sq); sk = wave_sum(sk);
                    if (lane == 0) { RSTDQ[m] = 1.0f / sqrtf(sq * (1.0f / 384.0f) + EPS); RSTDKV[m] = 1.0f / sqrtf(sk * (1.0f / 256.0f) + EPS); }
                }
            }
        }
        SEAM(pb + 2);

        if (EN(3) && IN(pb + 3)) { PHASE_BEGIN
            { pg8::SchedPlain S; S.o.init(NTOK / 256, QCW / 256, G, bx); S.A = (const char*)(P1 + C_CQ); S.Bt = (const char*)(Wb + W_WUQ); S.lda2 = P1W * 2; S.ldb2 = 768;
              pg8::EpiBf16 E{QC, QCW, nullptr};
              pg8::gemm_phase<pg8::EpiBf16, pg8::SchedPlain, true>(lds, tid, 384, 768, S, E); }
            { pg8::SchedPlain S; S.o.init(NTOK / 256, KVW / 256, G, bx); S.A = (const char*)(P1 + C_CKV); S.Bt = (const char*)(Wb + W_WUKV); S.lda2 = P1W * 2; S.ldb2 = 512;
              pg8::EpiBf16 E{KVC, KVW, RSTDKV};
              pg8::gemm_phase<pg8::EpiBf16, pg8::SchedPlain, true>(lds, tid, 256, 512, S, E); }
        }
        SEAM(pb + 3);

        if (EN(4) && IN(pb + 4)) { PHASE_BEGIN
            for (int it = bx * 512 + tid; it < 3 * NBATCH * 8 * SEQ; it += G * 512) {
                const int t = it & (SEQ - 1), h = (it >> 11) & 7, b = (it >> 14) & 15, ty = it >> 18;
                if (ty == 0) naive_attn_item<0>(args, l, b, h, t); else if (ty == 1) naive_attn_item<1>(args, l, b, h, t); else naive_attn_item<2>(args, l, b, h, t);
            }
        }
        SEAM(pb + 4);

        if (EN(5) && IN(pb + 5)) { PHASE_BEGIN
            pg8::SchedMerge S; S.o.init(NTOK / 256, DM / 256, G, bx); S.P1 = (const char*)P1; S.Wbr = (const char*)(Wb + W_WBR); S.lda2 = P1W * 2;
            pg8::EpiMerge E{MG, GB};
            pg8::gemm_phase<pg8::EpiMerge, pg8::SchedMerge, true>(lds, tid, 512, 1024, S, E);
        }
        SEAM(pb + 5);

        if (EN(6) && IN(pb + 6)) { PHASE_BEGIN
            pg8::SchedPlain S; S.o.init(NTOK / 256, DM / 256, G, bx); S.A = (const char*)MG; S.Bt = (const char*)(Wb + W_WO); S.lda2 = 2048; S.ldb2 = 2048;
            pg8::EpiWo E{Y, XB};
            pg8::gemm_phase<pg8::EpiWo, pg8::SchedPlain, true>(lds, tid, 1024, 2048, S, E);
        }
        SEAM(pb + 6);

        if (EN(7) && IN(pb + 7)) { PHASE_BEGIN
            LAS float* WrT = (LAS float*)lds;
            for (int idx = tid; idx < 16384; idx += 512) { const int k = idx >> 4, e = idx & 15; WrT[e * 1024 + k] = args.in[18][idx]; }
            if (tid < 16) MISC[16 + tid] = 0u;
            __syncthreads();
            const float* g = args.in[16] + l * DM; const float* bb = args.in[17] + l * DM; const float* rb = args.in[19];
            const int rpb = (NTOK + G - 1) / G;
            const int r_lo = bx * rpb, r_hi = (r_lo + rpb < NTOK) ? r_lo + rpb : NTOK;
            for (int m = r_lo + wave; m < r_hi; m += 8) {
                const float* yr = Y + (size_t)m * DM; f32x4 v[4]; float s = 0.f;
#pragma unroll
                for (int j = 0; j < 4; ++j) { v[j] = *(const f32x4*)(yr + 256 * j + 4 * lane); s += (v[j].x + v[j].y) + (v[j].z + v[j].w); }
                const float mean = wave_sum(s) * (1.f / DM); float s2 = 0.f;
#pragma unroll
                for (int j = 0; j < 4; ++j) { v[j] = v[j] - mean; s2 += (v[j].x * v[j].x + v[j].y * v[j].y) + (v[j].z * v[j].z + v[j].w * v[j].w); }
                const float rstd = 1.f / sqrtf(wave_sum(s2) * (1.f / DM) + EPS);
#pragma unroll
                for (int j = 0; j < 4; ++j) { v[j] = v[j] * rstd * *(const f32x4*)(g + 256 * j + 4 * lane) + *(const f32x4*)(bb + 256 * j + 4 * lane);
                    *(u32x2*)(XB + (size_t)m * DM + 256 * j + 4 * lane) = (u32x2){pk2(v[j].x, v[j].y), pk2(v[j].z, v[j].w)}; }
                float lg[16];
#pragma unroll
                for (int e = 0; e < 16; ++e) { float a = 0.f;
#pragma unroll
                    for (int j = 0; j < 4; ++j) { const f32x4 w = *(const LAS f32x4*)(WrT + e * 1024 + 256 * j + 4 * lane); a += (v[j].x * w.x + v[j].y * w.y) + (v[j].z * w.z + v[j].w * w.w); }
                    lg[e] = wave_sum(a); }
                float sc[16], bi[16];
#pragma unroll
                for (int e = 0; e < 16; ++e) { sc[e] = 1.0f / (1.0f + expf(-lg[e])); bi[e] = sc[e] + rb[e]; }
                float gs[4]; int i1g[4], i2g[4];
#pragma unroll
                for (int q = 0; q < 4; ++q) { const float a = bi[4 * q], b = bi[4 * q + 1], c = bi[4 * q + 2], d = bi[4 * q + 3];
                    float best = a; int i1 = 0; if (b > best) { best = b; i1 = 1; } if (c > best) { best = c; i1 = 2; } if (d > best) { best = d; i1 = 3; }
                    float b2 = -1e30f; int i2 = 0;
                    if (i1 != 0 && a > b2) { b2 = a; i2 = 0; } if (i1 != 1 && b > b2) { b2 = b; i2 = 1; } if (i1 != 2 && c > b2) { b2 = c; i2 = 2; } if (i1 != 3 && d > b2) { b2 = d; i2 = 3; }
                    gs[q] = best + b2; i1g[q] = i1; i2g[q] = i2; }
                int sel = 0; float bg = gs[0];
#pragma unroll
                for (int q = 1; q < 4; ++q) if (gs[q] > bg) { bg = gs[q]; sel = q; }
                int i1 = i1g[0], i2 = i2g[0];
#pragma unroll
                for (int q = 1; q < 4; ++q) if (sel == q) { i1 = i1g[q]; i2 = i2g[q]; }
                const int e0 = sel * 4 + i1, e1 = sel * 4 + i2; float s0 = 0.f, s1 = 0.f;
#pragma unroll
                for (int e = 0; e < 16; ++e) { s0 = (e == e0) ? sc[e] : s0; s1 = (e == e1) ? sc[e] : s1; }
                const float w0 = s0 / (s0 + s1), w1 = s1 / (s0 + s1);
                if (lane == 0) { const unsigned lp0 = atomicAdd((unsigned*)(MISC + 16 + e0), 1u), lp1 = atomicAdd((unsigned*)(MISC + 16 + e1), 1u);
                    volatile LAS unsigned* ri = MISC + 128 + (m - r_lo) * 8; ri[0] = (unsigned)e0; ri[1] = lp0; ri[2] = (unsigned)e1; ri[3] = lp1; ri[4] = __float_as_uint(w0); ri[5] = __float_as_uint(w1); }
            }
            __syncthreads();
            if (tid < 16) MISC[32 + tid] = __hip_atomic_fetch_add(ctl + CW_GCNT + (l * 16 + tid) * 64, MISC[16 + tid], __ATOMIC_RELAXED, __HIP_MEMORY_SCOPE_AGENT);
            __syncthreads();
            if (tid < r_hi - r_lo) { volatile LAS unsigned* ri = MISC + 128 + tid * 8; const int m = r_lo + tid;
                const unsigned e0 = ri[0], e1 = ri[2]; const unsigned p0 = MISC[32 + e0] + ri[1], p1 = MISC[32 + e1] + ri[3];
                LIST[e0 * LIST_CAP + p0] = m; LIST[e1 * LIST_CAP + p1] = m;
                *(u32x4*)(ROUTE + (size_t)m * 8) = (u32x4){e0, p0, e1, p1}; *(u32x2*)(ROUTE + (size_t)m * 8 + 4) = (u32x2){ri[4], ri[5]}; }
            __syncthreads();
        }
        SEAM(pb + 7);

        if (IN(pb + 8) || IN(pb + 9) || IN(pb + 10)) { PHASE_BEGIN
            if (tid == 0) { int ps = 0;
                for (int e = 0; e < 16; ++e) { const int c = (int)__hip_atomic_load(ctl + CW_GCNT + (l * 16 + e) * 64, __ATOMIC_RELAXED, __HIP_MEMORY_SCOPE_AGENT); MISC[64 + e] = (unsigned)ps; MISC[96 + e] = (unsigned)c; ps += (c + 255) >> 8; }
                MISC[80] = (unsigned)ps; }
            __syncthreads();
        }
        if (EN(8) && IN(pb + 8)) { PHASE_BEGIN
            pg8::SchedMoe<true> S; S.total_panels = (int)MISC[80]; S.G = G; S.c = bx; S.tab = (const volatile LAS int*)(MISC + 64); S.list = LIST; S.A = (const char*)XB; S.W = (const char*)(Wb + W_WGU);
            S.lda2 = 2048; S.wstride = (size_t)1024 * 1024 * 2; S.ldb2 = 2048;
            pg8::EpiMoeUp E{HID};
            pg8::gemm_phase<pg8::EpiMoeUp, pg8::SchedMoe<true>, true>(lds, tid, 1024, 2048, S, E);
        }
        SEAM(pb + 8);

        if (EN(9) && IN(pb + 9)) { PHASE_BEGIN
            pg8::SchedMoe<false> S; S.total_panels = (int)MISC[80]; S.G = G; S.c = bx; S.tab = (const volatile LAS int*)(MISC + 64); S.list = LIST; S.A = (const char*)HID; S.W = (const char*)(Wb + W_WD);
            S.lda2 = 1024; S.wstride = (size_t)1024 * 512 * 2; S.ldb2 = 1024;
            pg8::EpiBf16 E{PAIR, DM, nullptr};
            pg8::gemm_phase<pg8::EpiBf16, pg8::SchedMoe<false>, true>(lds, tid, 512, 1024, S, E);
        }
        SEAM(pb + 9);

        if (EN(10) && IN(pb + 10)) { PHASE_BEGIN
            const float* g = args.in[23] + l * DM; const float* bb = args.in[24] + l * DM;
            for (int m = gw; m < NTOK; m += NGW) {
                const u32x4 r4 = *(const u32x4*)(ROUTE + (size_t)m * 8); const u32x2 w2 = *(const u32x2*)(ROUTE + (size_t)m * 8 + 4);
                const size_t s0 = (size_t)MISC[64 + r4.x] * 256 + r4.y, s1 = (size_t)MISC[64 + r4.z] * 256 + r4.w; const float w0 = __uint_as_float(w2.x), w1 = __uint_as_float(w2.y);
                f32x4 v[4]; float s = 0.f;
#pragma unroll
                for (int j = 0; j < 4; ++j) { const u32x2 xw = *(const u32x2*)(XB + (size_t)m * DM + 256 * j + 4 * lane); const u32x2 pa = *(const u32x2*)(PAIR + s0 * DM + 256 * j + 4 * lane); const u32x2 pbv = *(const u32x2*)(PAIR + s1 * DM + 256 * j + 4 * lane);
                    v[j].x = ALPHA * bflo(xw.x) + w0 * bflo(pa.x) + w1 * bflo(pbv.x); v[j].y = ALPHA * bfhi(xw.x) + w0 * bfhi(pa.x) + w1 * bfhi(pbv.x);
                    v[j].z = ALPHA * bflo(xw.y) + w0 * bflo(pa.y) + w1 * bflo(pbv.y); v[j].w = ALPHA * bfhi(xw.y) + w0 * bfhi(pa.y) + w1 * bfhi(pbv.y);
                    s += (v[j].x + v[j].y) + (v[j].z + v[j].w); }
                const float mean = wave_sum(s) * (1.f / DM); float s2 = 0.f;
#pragma unroll
                for (int j = 0; j < 4; ++j) { v[j] = v[j] - mean; s2 += (v[j].x * v[j].x + v[j].y * v[j].y) + (v[j].z * v[j].z + v[j].w * v[j].w); }
                const float rstd = 1.f / sqrtf(wave_sum(s2) * (1.f / DM) + EPS);
#pragma unroll
                for (int j = 0; j < 4; ++j) { const f32x4 o = v[j] * rstd * *(const f32x4*)(g + 256 * j + 4 * lane) + *(const f32x4*)(bb + 256 * j + 4 * lane);
                    if (l == DEPTH - 1) *(f32x4*)((float*)outb + (size_t)m * DM + 256 * j + 4 * lane) = o;
                    else *(u32x2*)(XB + (size_t)m * DM + 256 * j + 4 * lane) = (u32x2){pk2(o.x, o.y), pk2(o.z, o.w)}; }
            }
        }
        SEAM(pb + 10);
    }
#undef IN
#undef SEAM
}

extern "C" void kernel_launch(void* const* d_in, const int* in_sizes, int n_in, void* d_out, int out_size, void* d_ws, size_t ws_size, hipStream_t stream) {
    static int grid = 0;
    if (grid == 0) {
        if (n_in != 25 || out_size != NTOK * DM || ws_size < WS_END) { fprintf(stderr, "kernel_launch: unexpected shapes (n_in %d, out %d, ws %zu)\n", n_in, out_size, ws_size); grid = -1; return; }
        int dev = 0, cus = 0, per_cu = 0;
        if (hipGetDevice(&dev) != hipSuccess || hipDeviceGetAttribute(&cus, hipDeviceAttributeMultiprocessorCount, dev) != hipSuccess) { grid = -1; return; }
        if (hipFuncSetAttribute((const void*)fwd_kernel, hipFuncAttributeMaxDynamicSharedMemorySize, LDS_BYTES) != hipSuccess) { fprintf(stderr, "kernel_launch: hipFuncSetAttribute failed\n"); grid = -1; return; }
        if (hipOccupancyMaxActiveBlocksPerMultiprocessor(&per_cu, (const void*)fwd_kernel, 512, LDS_BYTES) != hipSuccess || per_cu < 1) fprintf(stderr, "kernel_launch: occupancy query reports %d\n", per_cu);
        (void)hipGetLastError();
        grid = cus;
    }
    if (grid < 0) return;
    (void)hipMemsetAsync((char*)d_ws + WS_CTL, 0, CTL_ZERO_BYTES, stream);
    Args a{};
    for (int i = 0; i < 25; ++i) a.in[i] = (const float*)d_in[i];
    a.out = (float*)d_out; a.ws = (unsigned char*)d_ws;
#if ONE_LAUNCH
    a.ph_lo = 0; a.ph_hi = NPH;
    hipLaunchKernelGGL(fwd_kernel, dim3(grid), dim3(512), LDS_BYTES, stream, a);
#else
    for (int p = 0; p < NPH; ++p) { a.ph_lo = p; a.ph_hi = p + 1; hipLaunchKernelGGL(fwd_kernel, dim3(grid), dim3(512), LDS_BYTES, stream, a); }
#endif
}
```

```cpp
#include <hip/hip_runtime.h>
#include <cstdio>
#include <cstdint>

#ifndef PHMASK
#define PHMASK 0xFFF
#endif
#define EN(k) (((PHMASK) >> (k)) & 1)
#ifndef REPS_0
#define REPS_0 1
#endif
#ifndef REPS_1
#define REPS_1 1
#endif
#ifndef REPS_3
#define REPS_3 1
#endif
#ifndef REPS_4C
#define REPS_4C 1
#endif
#ifndef REPS_5
#define REPS_5 1
#endif
#ifndef REPS_6
#define REPS_6 1
#endif
#ifndef REPS_8
#define REPS_8 1
#endif
#ifndef REPS_9
#define REPS_9 1
#endif
#ifndef ATTN_FAST
#define ATTN_FAST 7
#endif
#ifndef ONE_LAUNCH
#define ONE_LAUNCH 1
#endif

#define GAS __attribute__((address_space(1)))
#define LAS __attribute__((address_space(3)))
typedef unsigned short bf16;
typedef short bf16x8 __attribute__((ext_vector_type(8)));
typedef float f32x4 __attribute__((ext_vector_type(4)));
typedef float f32x2 __attribute__((ext_vector_type(2)));
typedef unsigned u32x4 __attribute__((ext_vector_type(4)));
typedef unsigned u32x2 __attribute__((ext_vector_type(2)));
#define DI __device__ __forceinline__

constexpr int NTOK = 32768, DM = 1024, SEQ = 2048, NBATCH = 16, DEPTH = 2;
constexpr int P1W = 2304, GW = 3072, INW = 5376, QCW = 768, KVW = 1024, INCOLS = 5280;
constexpr int NEXP = 16, DFF = 512, SLOT_ROWS = 69632, LIST_CAP = 32768;
constexpr float EPS = 1e-6f, ALPHA = 1.4142135623730951f, LOG2E = 1.4426950408889634f;
constexpr float C2_64 = 0.125f * LOG2E;
constexpr float C2_96 = 0.10206207261596577f * LOG2E;
constexpr int C_QA = 0, C_KA = 512, C_VA = 640, C_QB = 768, C_KB = 1280, C_VB = 1408, C_CQ = 1536, C_CKV = 1920, C_KR = 2176;

constexpr size_t MiB = 1u << 20;
constexpr size_t WS_CTL = 0, CTL_ZERO_BYTES = 1 * MiB;
constexpr size_t WS_ROPE = 1 * MiB;
constexpr size_t WS_TB = WS_ROPE + 2048 * 16 * 8;
constexpr size_t WS_RSTDQ = WS_TB + 8 * 260 * 4 + 1728;
constexpr size_t WS_RSTDKV = WS_RSTDQ + NTOK * 4;
constexpr size_t WS_LIST = 2 * MiB;
constexpr size_t WS_ROUTE = 4 * MiB;
constexpr size_t WS_W = 8 * MiB;
constexpr size_t W_WIN = 0, W_WUQ = 11010048, W_WUKV = 11599872, W_WBR = 12124160, W_WO = 15269888, W_WGU = 17367040, W_WD = 50921472, W_WUP = 67698688, W_END = 71368704;
constexpr size_t WS_XB = 77 * MiB;
constexpr size_t WS_P1 = 141 * MiB;
constexpr size_t WS_G = 285 * MiB;
constexpr size_t WS_END = 477 * MiB;
static_assert(WS_W + W_END <= WS_XB && WS_RSTDKV + NTOK * 4 <= WS_LIST, "ws map");
static_assert((size_t)SLOT_ROWS * 1024 * 2 <= WS_END - WS_G && (size_t)SLOT_ROWS * 512 * 2 <= WS_G - WS_P1, "ws map 2");
constexpr size_t DO_QC = 0, DO_KVC = 48 * MiB;
constexpr int CW_BAR = 4096;
constexpr int CW_GCNT = 16384;

constexpr int RING_BYTES = 131072, LDSCTL_OFF = RING_BYTES, LDS_BYTES = 147456;

DI float bf2f(unsigned short h) { return __builtin_bit_cast(float, (unsigned)h << 16); }
DI float bflo(unsigned w) { return __builtin_bit_cast(float, w << 16); }
DI float bfhi(unsigned w) { return __builtin_bit_cast(float, w & 0xffff0000u); }
DI unsigned f2bf(float f) { unsigned u = __builtin_bit_cast(unsigned, f); return (u + 0x7fffu + ((u >> 16) & 1u)) >> 16; }
DI unsigned pk2(float lo, float hi) { return f2bf(lo) | (f2bf(hi) << 16); }
DI unsigned cvt_pk_bf16(float lo, float hi) { unsigned r; asm volatile("v_cvt_pk_bf16_f32 %0, %1, %2" : "=v"(r) : "v"(lo), "v"(hi)); return r; }
typedef __bf16 bf16x2_t __attribute__((ext_vector_type(2)));
DI unsigned cvtpk(float lo, float hi) { const f32x2 v = {lo, hi}; const bf16x2_t bb = __builtin_convertvector(v, bf16x2_t); return __builtin_bit_cast(unsigned, bb); }
DI float fsigmoid(float x) { return __builtin_amdgcn_rcpf(1.0f + __builtin_amdgcn_exp2f(-x * LOG2E)); }
template <int M> DI float swz_xor(float v) { return __builtin_bit_cast(float, __builtin_amdgcn_ds_swizzle(__builtin_bit_cast(int, v), (M << 10) | 0x1F)); }
DI float xhalf_sum(float v) { auto rr = __builtin_amdgcn_permlane32_swap(__float_as_uint(v), __float_as_uint(v), false, false); return __uint_as_float(rr[0]) + __uint_as_float(rr[1]); }
DI float sum32(float v) { v += swz_xor<1>(v); v += swz_xor<2>(v); v += swz_xor<4>(v); v += swz_xor<8>(v); v += swz_xor<16>(v); return v; }
DI float wave_sum(float v) { return xhalf_sum(sum32(v)); }
#define LDS_WAIT() asm volatile("s_waitcnt lgkmcnt(0)" ::: "memory")
#define VM_WAIT() asm volatile("s_waitcnt vmcnt(0)" ::: "memory")

namespace pg8 {
constexpr int BM = 256, BK = 64, HALF = 128, HTB = HALF * BK * 2, STAGE_BYTES = 8 * HTB, NXCD = 8, WGM = 8;
DI int lds_byte(int r, int c) { const int st = (r >> 4) * 2 + (c >> 5), rr = r & 15, cc = c & 31, ob = rr * 64 + cc * 2; return st * 1024 + (ob ^ (((ob >> 9) & 1) << 5)); }
DI void stage_rc(int b, int& R, int& C) { const int st = b / 1024, sb = b % 1024, swz = sb ^ (((sb >> 9) & 1) << 5); R = (st >> 1) * 16 + swz / 64; C = (st & 1) * 32 + (swz % 64) / 2; }
DI int perm32(int rho) { const int n = rho >> 4, i = rho & 15; return 8 * (i >> 2) + 4 * n + (i & 3); }

struct Unit { int pm, pn, e, aux; };
struct TileOrder {
    int nM, nN, nwg, G, c;
    DI void init(int nM_, int nN_, int G_, int c_) { nM = nM_; nN = nN_; nwg = nM * nN; G = G_; c = c_; }
    DI bool tile(int i, int& pm, int& pn) const {
        const long L = (long)i * G + c; if (L >= nwg) return false;
        int wgid = (int)L; { const int q = nwg / NXCD, r = nwg % NXCD, xcd = wgid % NXCD, off = wgid / NXCD; wgid = (xcd < r ? xcd * (q + 1) : r * (q + 1) + (xcd - r) * q) + off; }
        const int nig = WGM * nN, gid = wgid / nig, fm = gid * WGM, gsz = (nM - fm) < WGM ? (nM - fm) : WGM;
        pm = fm + ((wgid % nig) % gsz); pn = (wgid % nig) / gsz; return true;
    }
};

template <class Epi, class Sched, bool ALIGN_EPI>
DI void gemm_phase(LAS unsigned char* lds, const int tid, const int K, const unsigned ldb2, const Sched& S, const Epi& E) {
    const int wid = __builtin_amdgcn_readfirstlane(tid >> 6), lane = tid & 63, wr = wid >> 2, wc = wid & 3, fr = lane & 15, fq = lane >> 4;
    int nt = K / BK;
    int Rr[2], Cc[2]; unsigned voffA[2], voffB[2];
    const unsigned lda2 = S.lda2;
#pragma unroll
    for (int i = 0; i < 2; ++i) { int R, C; stage_rc(tid * 16 + i * 8192, R, C); const int Rb = Epi::PERM ? ((R & ~31) + perm32(R & 31)) : R;
        Rr[i] = R; Cc[i] = C * 2; voffA[i] = (unsigned)R * lda2 + (unsigned)C * 2u; voffB[i] = (unsigned)Rb * ldb2 + (unsigned)C * 2u; }
    const size_t kstep = (size_t)(BK * 2);
    const size_t hstepB = (size_t)HALF * ldb2, hstepA = (size_t)HALF * lda2;
    const unsigned ldsw = (unsigned)wid * 1024u;
    const int aoff = lds_byte(wr * 64 + fr, fq * 8), boff = lds_byte(wc * 32 + fr, fq * 8);
#define PG8_SA(b, h) (((b) * 2 + (h)) * HTB)
#define PG8_SB(b, h) ((4 + (b) * 2 + (h)) * HTB)
#define PG8_STAGE(bufoff, gbase, voff) do { _Pragma("unroll") for (int _i = 0; _i < 2; ++_i) \
        __builtin_amdgcn_global_load_lds((const unsigned*)((const char*)(gbase) + (voff)[_i]), (LAS unsigned*)(lds + (bufoff) + ldsw + _i * 8192), 16, 0, 0); } while (0)
#define PG8_STAGE_A(bufoff, gbase, h, g0, g1) do { if constexpr (Sched::GATHER) { if ((h) == 0) PG8_STAGE(bufoff, gbase, g0); else PG8_STAGE(bufoff, gbase, g1); } \
        else { PG8_STAGE(bufoff, (gbase) + (h) * hstepA, voffA); } } while (0)
#define PG8_LDA(dst, b, h) do { _Pragma("unroll") for (int m = 0; m < 4; ++m) _Pragma("unroll") for (int k = 0; k < 2; ++k) dst[m][k] = *(const LAS bf16x8*)(lds + PG8_SA(b, h) + aoff + m * 2048 + k * 1024); } while (0)
#define PG8_LDB(dst, b, h) do { _Pragma("unroll") for (int n = 0; n < 2; ++n) _Pragma("unroll") for (int k = 0; k < 2; ++k) dst[n][k] = *(const LAS bf16x8*)(lds + PG8_SB(b, h) + boff + n * 2048 + k * 1024); } while (0)
#define PG8_MMA(ai, bj, At, Bt) do { __builtin_amdgcn_s_setprio(1); _Pragma("unroll") for (int m = 0; m < 4; ++m) _Pragma("unroll") for (int n = 0; n < 2; ++n) _Pragma("unroll") for (int k = 0; k < 2; ++k) \
        acc[ai][bj][m][n] = __builtin_amdgcn_mfma_f32_16x16x32_bf16(Bt[n][k], At[m][k], acc[ai][bj][m][n], 0, 0, 0); __builtin_amdgcn_s_setprio(0); } while (0)
#define PG8_WAIT_V(n) asm volatile("s_waitcnt vmcnt(" #n ")" ::: "memory")
#define PG8_WAIT_L(n) asm volatile("s_waitcnt lgkmcnt(" #n ")" ::: "memory")
#define PG8_BAR __builtin_amdgcn_s_barrier()
#define PG8_SCHED __builtin_amdgcn_sched_barrier(0)
    Unit cur, nxt; int ui = 0;
    if (!S.next(0, cur)) return;
    f32x4 acc[2][2][4][2];
    float zf = 0.f; asm volatile("" : "+v"(zf));
#pragma unroll
    for (int a = 0; a < 2; ++a)
#pragma unroll
        for (int b = 0; b < 2; ++b)
#pragma unroll
            for (int m = 0; m < 4; ++m)
#pragma unroll
                for (int n = 0; n < 2; ++n) acc[a][b][m][n] = (f32x4){zf, zf, zf, zf};
    bf16x8 At[4][2], B0[2][2], B1[2][2];
    unsigned ao0[2] = {0u, 0u}, ao1[2] = {0u, 0u}, no0[2] = {0u, 0u}, no1[2] = {0u, 0u};
    if constexpr (Sched::GATHER) {
#pragma unroll
        for (int i = 0; i < 2; ++i) { ao0[i] = S.a_off(cur, Rr[i]) + Cc[i]; ao1[i] = S.a_off(cur, HALF + Rr[i]) + Cc[i]; } }
    const char* cA = S.a_base(cur); const char* cB = S.b_base(cur); nt = S.ktiles(cur, nt);
    PG8_STAGE(PG8_SB(0, 0), cB, voffB); PG8_STAGE(PG8_SB(0, 1), cB + hstepB, voffB); PG8_STAGE_A(PG8_SA(0, 0), cA, 0, ao0, ao1); PG8_STAGE_A(PG8_SA(0, 1), cA, 1, ao0, ao1);
    if (wr == 1) PG8_BAR;
    PG8_WAIT_V(2); PG8_BAR;
    PG8_STAGE(PG8_SB(1, 0), cB + kstep, voffB); PG8_STAGE_A(PG8_SA(1, 0), cA + kstep, 0, ao0, ao1); PG8_STAGE(PG8_SB(1, 1), cB + hstepB + kstep, voffB);
    PG8_WAIT_V(6); PG8_BAR;
    for (;;) {
        const bool has_next = S.next(ui + 1, nxt);
        const char* nA = cA; const char* nB = cB;
        if constexpr (Sched::GATHER) {
#pragma unroll
            for (int i = 0; i < 2; ++i) { no0[i] = ao0[i]; no1[i] = ao1[i]; } }
        if (has_next) { nA = S.a_base(nxt); nB = S.b_base(nxt);
            if constexpr (Sched::GATHER) {
#pragma unroll
                for (int i = 0; i < 2; ++i) { no0[i] = S.a_off(nxt, Rr[i]) + Cc[i]; no1[i] = S.a_off(nxt, HALF + Rr[i]) + Cc[i]; } } }
#pragma unroll 1
        for (int t = 0; t < nt; t += 2) {
            const bool last = (t == nt - 2);
            const char* a1 = cA + (size_t)(t + 1) * kstep;
            const char* a2 = last ? nA : cA + (size_t)(t + 2) * kstep; const char* b2 = last ? nB : cB + (size_t)(t + 2) * kstep;
            const char* a3 = a2 + kstep; const char* b3 = b2 + kstep;
            unsigned x0[2] = {0u, 0u}, x1[2] = {0u, 0u};
            if constexpr (Sched::GATHER) {
#pragma unroll
                for (int i = 0; i < 2; ++i) { x0[i] = last ? no0[i] : ao0[i]; x1[i] = last ? no1[i] : ao1[i]; } }
            PG8_LDB(B0, 0, 0); PG8_LDB(B1, 0, 1); PG8_SCHED; PG8_LDA(At, 0, 0); PG8_STAGE_A(PG8_SA(1, 1), a1, 1, ao0, ao1);
            PG8_WAIT_V(8); PG8_WAIT_L(0); PG8_BAR; PG8_MMA(0, 0, At, B0); PG8_MMA(0, 1, At, B1); PG8_BAR; PG8_SCHED;
            PG8_LDA(At, 0, 1); PG8_STAGE(PG8_SB(0, 0), b2, voffB); PG8_STAGE(PG8_SB(0, 1), b2 + hstepB, voffB); PG8_STAGE_A(PG8_SA(0, 0), a2, 0, x0, x1);
            PG8_WAIT_V(8); PG8_WAIT_L(0); PG8_BAR; PG8_MMA(1, 0, At, B0); PG8_MMA(1, 1, At, B1); PG8_BAR; PG8_SCHED;
            PG8_LDB(B0, 1, 0); PG8_LDB(B1, 1, 1); PG8_SCHED; PG8_LDA(At, 1, 0); PG8_STAGE_A(PG8_SA(0, 1), a2, 1, x0, x1);
            PG8_WAIT_V(8); PG8_WAIT_L(0); PG8_BAR; PG8_MMA(0, 0, At, B0); PG8_MMA(0, 1, At, B1); PG8_BAR; PG8_SCHED;
            PG8_LDA(At, 1, 1); PG8_STAGE(PG8_SB(1, 0), b3, voffB); PG8_STAGE(PG8_SB(1, 1), b3 + hstepB, voffB); PG8_STAGE_A(PG8_SA(1, 0), a3, 0, x0, x1);
            PG8_WAIT_V(8); PG8_WAIT_L(0); PG8_BAR; PG8_MMA(1, 0, At, B0); PG8_MMA(1, 1, At, B1); PG8_BAR; PG8_SCHED;
        }
        if constexpr (ALIGN_EPI) { if (wr == 0) PG8_BAR; }
        bool keep = false;
        if constexpr (Sched::KEEP) keep = S.keep_acc(cur);
        if constexpr (Sched::KEEP) { if (keep) E.mid(acc, cur, wr, wc, fr, fq); else E(acc, cur, wr, wc, fr, fq); } else { E(acc, cur, wr, wc, fr, fq); }
        if (!has_next) break;
        if (!keep) {
#pragma unroll
        for (int a = 0; a < 2; ++a)
#pragma unroll
            for (int b = 0; b < 2; ++b)
#pragma unroll
                for (int m = 0; m < 4; ++m)
#pragma unroll
                    for (int n = 0; n < 2; ++n) acc[a][b][m][n] = (f32x4){zf, zf, zf, zf};
        }
        cur = nxt; cA = nA; cB = nB; ++ui; nt = S.ktiles(cur, nt);
        if constexpr (Sched::GATHER) {
#pragma unroll
            for (int i = 0; i < 2; ++i) { ao0[i] = no0[i]; ao1[i] = no1[i]; } }
        if constexpr (ALIGN_EPI) { if (wr == 1) PG8_BAR; }
    }
    PG8_WAIT_V(0);
    if constexpr (!ALIGN_EPI) { if (wr == 0) PG8_BAR; }
    PG8_BAR;
#undef PG8_SA
#undef PG8_SB
#undef PG8_STAGE
#undef PG8_STAGE_A
#undef PG8_LDA
#undef PG8_LDB
#undef PG8_MMA
#undef PG8_WAIT_V
#undef PG8_WAIT_L
#undef PG8_BAR
#undef PG8_SCHED
}

struct SchedPlain {
    static constexpr bool GATHER = false, KEEP = false;
    TileOrder o; const char* A; const char* Bt; unsigned lda2, ldb2;
    DI bool next(int i, Unit& u) const { u.e = 0; u.aux = 0; return o.tile(i, u.pm, u.pn); }
    DI const char* a_base(const Unit& u) const { return A + (size_t)u.pm * BM * lda2; }
    DI unsigned a_off(const Unit&, int) const { return 0u; }
    DI int ktiles(const Unit&, int d) const { return d; }
    DI const char* b_base(const Unit& u) const { return Bt + (size_t)u.pn * BM * ldb2; }
};
struct SchedMerge {
    static constexpr bool GATHER = false, KEEP = true;
    TileOrder o; const char* P1; const char* Wbr; unsigned lda2;
    DI bool next(int i, Unit& u) const { u.e = i % 3; u.aux = 0; return o.tile(i / 3, u.pm, u.pn); }
    DI bool keep_acc(const Unit& u) const { return u.e < 2; }
    DI const char* a_base(const Unit& u) const { return P1 + (size_t)u.e * (768 * 2) + (size_t)u.pm * BM * lda2; }
    DI unsigned a_off(const Unit&, int) const { return 0u; }
    DI int ktiles(const Unit&, int d) const { return d; }
    DI const char* b_base(const Unit& u) const { return Wbr + (size_t)u.e * (1024 * 512 * 2) + (size_t)u.pn * BM * 1024; }
};
struct SchedUp {
    static constexpr bool GATHER = true, KEEP = false;
    int G, c; const char* wsb; unsigned lda2;
    DI void qunit(int i, Unit& u) const { u.e = 0; u.pm = i / 3; u.pn = i % 3; }
    DI void kvunit(int i, Unit& u) const { u.e = 1; u.pm = i >> 2; u.pn = 3 + (i & 3); }
    DI bool next(int i, Unit& u) const {
        u.aux = 0;
        if (G == 256) {
            if (c < 128) { if (i == 0) { u.e = 2; u.pm = c; u.pn = 7; return true; } if (i == 1) { qunit(c, u); return true; } if (i == 2) { kvunit(c, u); return true; } return false; }
            const int d = c - 128; if (i < 2) { qunit(128 + 2 * d + i, u); return true; } if (i < 5) { kvunit(128 + 3 * d + (i - 2), u); return true; } return false;
        }
        const int L = i * G + c; if (L >= 1024) return false;
        if (L < 128) { u.e = 2; u.pm = L; u.pn = 7; } else if (L < 512) qunit(L - 128, u); else kvunit(L - 512, u);
        return true;
    }
    DI const char* a_base(const Unit& u) const { const size_t off = u.e == 2 ? WS_XB + (size_t)u.pm * BM * 2048 : WS_P1 + (size_t)(u.e ? C_CKV * 2 : C_CQ * 2) + (size_t)u.pm * BM * (P1W * 2); return wsb + off; }
    DI unsigned a_off(const Unit& u, int r) const { return (unsigned)r * (u.e == 2 ? 2048u : (unsigned)(P1W * 2)); }
    DI int ktiles(const Unit& u, int) const { return u.e == 2 ? 16 : (u.e ? 4 : 6); }
    DI const char* b_base(const Unit& u) const { const size_t off = u.e == 2 ? WS_W + W_WIN + (size_t)5120 * 2048 : WS_W + W_WUP + (size_t)u.pn * BM * 2048; return wsb + off; }
};
template <bool GATHER_> struct SchedMoe {
    static constexpr bool GATHER = GATHER_, KEEP = false;
    int total_panels, G, c; const volatile LAS int* tab; const int* list; const char* A; const char* W; unsigned lda2; size_t wstride; unsigned ldb2;
    DI bool next(int i, Unit& u) const {
        const int L = i * G + c; if (L >= total_panels * 4) return false;
        const int panel = L >> 2; u.pn = L & 3; u.pm = panel; int e = 0;
#pragma unroll
        for (int j = 1; j < 16; ++j) e += (panel >= tab[j]) ? 1 : 0;
        u.e = e; u.aux = (panel - tab[e]) * BM; return true;
    }
    DI const char* a_base(const Unit& u) const { return GATHER ? A : A + (size_t)u.pm * BM * lda2; }
    DI unsigned a_off(const Unit& u, int r) const {
        int pos = u.aux + r; const int cnt = tab[32 + u.e]; pos = pos < cnt ? pos : cnt - 1; return (unsigned)list[u.e * LIST_CAP + pos] * lda2;
    }
    DI int ktiles(const Unit&, int d) const { return d; }
    DI const char* b_base(const Unit& u) const { return W + (size_t)u.e * wstride + (size_t)u.pn * BM * ldb2; }
};

struct EpiInproj {
    static constexpr bool PERM = true;
    bf16* P1; bf16* G;
    DI void operator()(const f32x4 (&acc)[2][2][4][2], const Unit& u, int wr, int wc, int fr, int fq) const {
        const int row0 = u.pm * BM + wr * 64 + fr; const bool sig = u.pn >= 9;
        bf16* base = sig ? G : P1; const int ld = sig ? GW : P1W; const int col0 = (sig ? (u.pn - 9) : u.pn) * BM + wc * 32 + 8 * fq;
#pragma unroll
        for (int ai = 0; ai < 2; ++ai)
#pragma unroll
            for (int m = 0; m < 4; ++m) { bf16* rowp = base + (size_t)(row0 + ai * HALF + m * 16) * ld + col0;
#pragma unroll
                for (int bj = 0; bj < 2; ++bj) { f32x4 v0 = acc[ai][bj][m][0], v1 = acc[ai][bj][m][1];
                    if (sig) {
#pragma unroll
                        for (int j = 0; j < 4; ++j) { v0[j] = fsigmoid(v0[j]); v1[j] = fsigmoid(v1[j]); } }
                    u32x4 w; w.x = cvt_pk_bf16(v0[0], v0[1]); w.y = cvt_pk_bf16(v0[2], v0[3]); w.z = cvt_pk_bf16(v1[0], v1[1]); w.w = cvt_pk_bf16(v1[2], v1[3]);
                    *(u32x4*)(rowp + bj * HALF) = w; } }
    }
};
struct EpiBf16 {
    static constexpr bool PERM = true;
    bf16* O; int ldc; const float* rscale;
    DI void operator()(const f32x4 (&acc)[2][2][4][2], const Unit& u, int wr, int wc, int fr, int fq) const {
        const int row0 = u.pm * BM + wr * 64 + fr; const int col0 = u.pn * BM + wc * 32 + 8 * fq;
#pragma unroll
        for (int ai = 0; ai < 2; ++ai)
#pragma unroll
            for (int m = 0; m < 4; ++m) { const int row = row0 + ai * HALF + m * 16; bf16* rowp = O + (size_t)row * ldc + col0; const float s = rscale ? rscale[row] : 1.0f;
#pragma unroll
                for (int bj = 0; bj < 2; ++bj) { const f32x4 v0 = acc[ai][bj][m][0] * s, v1 = acc[ai][bj][m][1] * s;
                    u32x4 w; w.x = cvt_pk_bf16(v0[0], v0[1]); w.y = cvt_pk_bf16(v0[2], v0[3]); w.z = cvt_pk_bf16(v1[0], v1[1]); w.w = cvt_pk_bf16(v1[2], v1[3]);
                    *(u32x4*)(rowp + bj * HALF) = w; } }
    }
};
struct EpiUp {
    static constexpr bool PERM = true;
    bf16* QC; bf16* KVC; const float* rscale; bf16* G;
    DI void operator()(const f32x4 (&acc)[2][2][4][2], const Unit& u, int wr, int wc, int fr, int fq) const {
        const int row0 = u.pm * BM + wr * 64 + fr; const bool kv = u.e == 1, gt = u.e == 2;
        const int ld = gt ? GW : (kv ? KVW : QCW); const int col0 = (gt ? 11 : (kv ? (u.pn - 3) : u.pn)) * BM + wc * 32 + 8 * fq;
        const unsigned long long qi_ = (unsigned long long)QC, ki_ = (unsigned long long)KVC, gi_ = (unsigned long long)G;
        const unsigned long long bsel = qi_ + (unsigned long long)(kv ? 1 : 0) * (ki_ - qi_) + (unsigned long long)(gt ? 1 : 0) * (gi_ - qi_);
#pragma unroll
        for (int ai = 0; ai < 2; ++ai)
#pragma unroll
            for (int m = 0; m < 4; ++m) { const int row = row0 + ai * HALF + m * 16; const size_t eo = (size_t)row * ld + col0; const float s = kv ? rscale[row] : 1.0f;
#pragma unroll
                for (int bj = 0; bj < 2; ++bj) { f32x4 v0 = acc[ai][bj][m][0] * s, v1 = acc[ai][bj][m][1] * s;
                    if (gt) {
#pragma unroll
                        for (int j = 0; j < 4; ++j) { v0[j] = fsigmoid(v0[j]); v1[j] = fsigmoid(v1[j]); } }
                    u32x4 w; w.x = cvt_pk_bf16(v0[0], v0[1]); w.y = cvt_pk_bf16(v0[2], v0[3]); w.z = cvt_pk_bf16(v1[0], v1[1]); w.w = cvt_pk_bf16(v1[2], v1[3]);
                    *(GAS u32x4*)(bsel + (eo + bj * HALF) * 2) = w; } }
    }
};
struct EpiMerge {
    static constexpr bool PERM = true;
    bf16* MG; const bf16* G;
    DI void mid(f32x4 (&acc)[2][2][4][2], const Unit& u, int wr, int wc, int fr, int fq) const {
        const int row0 = u.pm * BM + wr * 64 + fr; const int col0 = u.pn * BM + wc * 32 + 8 * fq;
#pragma unroll
        for (int ai = 0; ai < 2; ++ai) {
            u32x4 ga[4][2], gb[4][2];
#pragma unroll
            for (int m = 0; m < 4; ++m) { const bf16* gp = G + (size_t)(row0 + ai * HALF + m * 16) * GW + u.e * DM + col0;
#pragma unroll
                for (int bj = 0; bj < 2; ++bj) { ga[m][bj] = *(const u32x4*)(gp + bj * HALF); gb[m][bj] = *(const u32x4*)(gp + DM + bj * HALF); } }
#pragma unroll
            for (int m = 0; m < 4; ++m)
#pragma unroll
                for (int bj = 0; bj < 2; ++bj) { const u32x4 a = ga[m][bj], b = gb[m][bj]; f32x4& a0 = acc[ai][bj][m][0]; f32x4& a1 = acc[ai][bj][m][1];
                    a0[0] *= bflo(a.x) * __builtin_amdgcn_rcpf(fmaxf(bflo(b.x), 1e-30f)); a0[1] *= bfhi(a.x) * __builtin_amdgcn_rcpf(fmaxf(bfhi(b.x), 1e-30f));
                    a0[2] *= bflo(a.y) * __builtin_amdgcn_rcpf(fmaxf(bflo(b.y), 1e-30f)); a0[3] *= bfhi(a.y) * __builtin_amdgcn_rcpf(fmaxf(bfhi(b.y), 1e-30f));
                    a1[0] *= bflo(a.z) * __builtin_amdgcn_rcpf(fmaxf(bflo(b.z), 1e-30f)); a1[1] *= bfhi(a.z) * __builtin_amdgcn_rcpf(fmaxf(bfhi(b.z), 1e-30f));
                    a1[2] *= bflo(a.w) * __builtin_amdgcn_rcpf(fmaxf(bflo(b.w), 1e-30f)); a1[3] *= bfhi(a.w) * __builtin_amdgcn_rcpf(fmaxf(bfhi(b.w), 1e-30f)); }
        }
    }
    DI void operator()(const f32x4 (&acc)[2][2][4][2], const Unit& u, int wr, int wc, int fr, int fq) const {
        const int row0 = u.pm * BM + wr * 64 + fr; const int col0 = u.pn * BM + wc * 32 + 8 * fq;
#pragma unroll
        for (int ai = 0; ai < 2; ++ai) {
            u32x4 gq[4][2];
#pragma unroll
            for (int m = 0; m < 4; ++m) { const bf16* gp = G + (size_t)(row0 + ai * HALF + m * 16) * GW + 2 * DM + col0;
#pragma unroll
                for (int bj = 0; bj < 2; ++bj) gq[m][bj] = *(const u32x4*)(gp + bj * HALF); }
#pragma unroll
            for (int m = 0; m < 4; ++m) { bf16* rowp = MG + (size_t)(row0 + ai * HALF + m * 16) * DM + col0;
#pragma unroll
                for (int bj = 0; bj < 2; ++bj) { const f32x4 a0 = acc[ai][bj][m][0], a1 = acc[ai][bj][m][1]; const u32x4 g = gq[m][bj];
                    u32x4 w; w.x = cvt_pk_bf16(bflo(g.x) * a0[0], bfhi(g.x) * a0[1]); w.y = cvt_pk_bf16(bflo(g.y) * a0[2], bfhi(g.y) * a0[3]);
                    w.z = cvt_pk_bf16(bflo(g.z) * a1[0], bfhi(g.z) * a1[1]); w.w = cvt_pk_bf16(bflo(g.w) * a1[2], bfhi(g.w) * a1[3]);
                    *(u32x4*)(rowp + bj * HALF) = w; } }
        }
    }
};
struct EpiWo {
    static constexpr bool PERM = true;
    bf16* Y; const bf16* XB;
    DI void operator()(const f32x4 (&acc)[2][2][4][2], const Unit& u, int wr, int wc, int fr, int fq) const {
        const int row0 = u.pm * BM + wr * 64 + fr, col0 = u.pn * BM + wc * 32 + 8 * fq;
#pragma unroll
        for (int ai = 0; ai < 2; ++ai) {
            u32x4 xq[4][2];
#pragma unroll
            for (int m = 0; m < 4; ++m) { const size_t off = (size_t)(row0 + ai * HALF + m * 16) * DM + col0;
#pragma unroll
                for (int bj = 0; bj < 2; ++bj) xq[m][bj] = *(const u32x4*)(XB + off + bj * HALF); }
#pragma unroll
            for (int m = 0; m < 4; ++m) { const size_t off = (size_t)(row0 + ai * HALF + m * 16) * DM + col0;
#pragma unroll
                for (int bj = 0; bj < 2; ++bj) { const u32x4 xb = xq[m][bj]; const f32x4 a0 = acc[ai][bj][m][0], a1 = acc[ai][bj][m][1];
                    u32x4 w; w.x = cvt_pk_bf16(a0[0] + ALPHA * bflo(xb.x), a0[1] + ALPHA * bfhi(xb.x)); w.y = cvt_pk_bf16(a0[2] + ALPHA * bflo(xb.y), a0[3] + ALPHA * bfhi(xb.y));
                    w.z = cvt_pk_bf16(a1[0] + ALPHA * bflo(xb.z), a1[1] + ALPHA * bfhi(xb.z)); w.w = cvt_pk_bf16(a1[2] + ALPHA * bflo(xb.w), a1[3] + ALPHA * bfhi(xb.w));
                    *(u32x4*)(Y + off + bj * HALF) = w; } }
        }
    }
};
struct EpiMoeUp {
    static constexpr bool PERM = true;
    bf16* H;
    DI void operator()(const f32x4 (&acc)[2][2][4][2], const Unit& u, int wr, int wc, int fr, int fq) const {
        const int row0 = u.pm * BM + wr * 64 + fr; const int col0 = u.pn * HALF + wc * 32 + 8 * fq;
#pragma unroll
        for (int ai = 0; ai < 2; ++ai)
#pragma unroll
            for (int m = 0; m < 4; ++m) { bf16* rowp = H + (size_t)(row0 + ai * HALF + m * 16) * DFF + col0; float o[8];
#pragma unroll
                for (int n = 0; n < 2; ++n)
#pragma unroll
                    for (int j = 0; j < 4; ++j) { const float g = acc[ai][0][m][n][j], up = acc[ai][1][m][n][j]; o[n * 4 + j] = g * fsigmoid(g) * up; }
                u32x4 w; w.x = cvt_pk_bf16(o[0], o[1]); w.y = cvt_pk_bf16(o[2], o[3]); w.z = cvt_pk_bf16(o[4], o[5]); w.w = cvt_pk_bf16(o[6], o[7]);
                *(u32x4*)rowp = w; }
    }
};
}

#define XB_TMO      128
#define XB_XCNT(j)  (256  + 64 * (j))
#define XB_XSUB(j)  (1280 + 64 * (j))
#define XB_XGEN(j)  (2304 + 64 * (j))
#define XB_TOP      3328
#define XB_TOPGEN   3392
#define XCD_BAR_WORDS 3456
#define XB_SPIN_CAP (1u << 18)
DI unsigned xb_ld(unsigned* p)              { return __hip_atomic_load(p, __ATOMIC_RELAXED, __HIP_MEMORY_SCOPE_AGENT); }
DI unsigned xb_add(unsigned* p, unsigned v) { return __hip_atomic_fetch_add(p, v, __ATOMIC_RELAXED, __HIP_MEMORY_SCOPE_AGENT); }
DI unsigned xb_xcc_id() { return (unsigned)__builtin_amdgcn_s_getreg((3 << 11) | 20) & 0xFu; }
#define XB_SPIN(cond, bar) do { unsigned _sp = 0; while (cond) { __builtin_amdgcn_s_sleep(1); \
    if ((++_sp & 255u) == 0u) { if (xb_ld(&(bar)[XB_TMO])) break; if (_sp > XB_SPIN_CAP) { atomicAdd(&(bar)[XB_TMO], 1u); break; } } } } while (0)
struct XcdBarrier { unsigned* bar; unsigned x; volatile LAS unsigned* st; };
DI XcdBarrier xcd_barrier_post(unsigned* bar, volatile LAS unsigned* st) {
    XcdBarrier b; b.bar = bar; b.x = xb_xcc_id(); b.st = st;
    if (threadIdx.x == 0) (void)xb_add(&bar[XB_XCNT(b.x)], 1u);
    return b;
}
DI void xcd_barrier_complete(unsigned* bar, unsigned x, unsigned& nloc, unsigned& nx) {
    const unsigned G = gridDim.x * gridDim.y * gridDim.z;
    unsigned sum, cnt, mine, sp = 0u;
    for (;;) {
        sum = 0u; cnt = 0u; mine = 0u;
#pragma unroll
        for (unsigned j = 0; j < 16; ++j) { const unsigned c = xb_ld(&bar[XB_XCNT(j)]); sum += c; cnt += (c > 0u) ? 1u : 0u; mine = (j == x) ? c : mine; }
        if (sum == G) break;
        __builtin_amdgcn_s_sleep(1);
        if ((++sp & 255u) == 0u) { if (xb_ld(&bar[XB_TMO])) break; if (sp > XB_SPIN_CAP) { atomicAdd(&bar[XB_TMO], 1u); break; } }
    }
    nloc = mine > 0u ? mine : 1u; nx = cnt > 0u ? cnt : 1u;
}
DI void xcd_barrier(const XcdBarrier& b) {
    asm volatile("s_waitcnt vmcnt(0)" ::: "memory");
    __syncthreads();
    if (threadIdx.x == 0) {
        unsigned* bar = b.bar;
        __builtin_amdgcn_s_waitcnt(0);
        unsigned nloc = b.st[0], nx = b.st[1];
        if (nloc == 0u) { xcd_barrier_complete(bar, b.x, nloc, nx); b.st[0] = nloc; b.st[1] = nx; }
        const unsigned old = xb_add(&bar[XB_XSUB(b.x)], 1u);
        const unsigned gen = old / nloc;
        if (old + 1u == (gen + 1u) * nloc) {
            __builtin_amdgcn_fence(__ATOMIC_RELEASE, "agent");
            asm volatile("s_waitcnt vmcnt(0)" ::: "memory");
            const unsigned og = xb_add(&bar[XB_TOP], 1u);
            const unsigned tg = og / nx;
            if (og + 1u == (tg + 1u) * nx) xb_add(&bar[XB_TOPGEN], 1u);
            else XB_SPIN(xb_ld(&bar[XB_TOPGEN]) == tg, bar);
            __builtin_amdgcn_fence(__ATOMIC_ACQUIRE, "agent");
            xb_add(&bar[XB_XGEN(b.x)], 1u);
            asm volatile("s_waitcnt vmcnt(0)" ::: "memory");
        } else {
            XB_SPIN(xb_ld(&bar[XB_XGEN(b.x)]) == gen, bar);
            __builtin_amdgcn_fence(__ATOMIC_ACQUIRE, "agent");
            asm volatile("s_waitcnt vmcnt(0)" ::: "memory");
        }
    }
    __syncthreads();
}

DI float inv_freq16(int i) {
    const float t = (float)i * (-13.287712379549449f / 16.0f);
    return __builtin_amdgcn_exp2f(t);
}
DI void cos_sin(double a, float& c, float& s) {
    const double kq = __builtin_rint(a * 0.63661977236758134308);
    const double r = a - kq * 1.57079632679489661923;
    const double r2 = r * r;
    const double sp = r * (1.0 + r2 * (-1.0 / 6 + r2 * (1.0 / 120 + r2 * (-1.0 / 5040 + r2 * (1.0 / 362880 + r2 * (-1.0 / 39916800))))));
    const double cp = 1.0 + r2 * (-0.5 + r2 * (1.0 / 24 + r2 * (-1.0 / 720 + r2 * (1.0 / 40320 + r2 * (-1.0 / 3628800 + r2 * (1.0 / 479001600))))));
    const int q = (int)kq & 3;
    const double cc = (q == 0) ? cp : (q == 1) ? -sp : (q == 2) ? -cp : sp;
    const double ss = (q == 0) ? sp : (q == 1) ? cp : (q == 2) ? -sp : -cp;
    c = (float)cc; s = (float)ss;
}
DI int t5_bucket_n(int n) { return n < 8 ? n : n < 12 ? 8 : n < 16 ? 9 : n < 23 ? 10 : n < 32 ? 11 : n < 46 ? 12 : n < 64 ? 13 : n < 91 ? 14 : 15; }

DI void transpose_item(const float* W, int Nsrc, int k0, int n0, bf16* WT, int Kdst, int d0, const float* kscale, LAS float* scr, int lane) {
#pragma unroll
    for (int i = 0; i < 8; ++i) { const int kk = 8 * i + (lane >> 3); f32x4 v = *(const f32x4*)(W + (size_t)(k0 + kk) * Nsrc + n0 + 4 * (lane & 7)); if (kscale) v = v * kscale[k0 + kk];
        LAS float* d = scr + kk * 33 + 4 * (lane & 7); d[0] = v.x; d[1] = v.y; d[2] = v.z; d[3] = v.w; }
    LDS_WAIT(); asm volatile("" ::: "memory");
    const int c = lane & 7;
#pragma unroll
    for (int j = 0; j < 4; ++j) { const int n = (lane >> 3) + 8 * j; const LAS float* s = scr + (8 * c) * 33 + n;
        u32x4 o; o.x = pk2(s[0 * 33], s[1 * 33]); o.y = pk2(s[2 * 33], s[3 * 33]); o.z = pk2(s[4 * 33], s[5 * 33]); o.w = pk2(s[6 * 33], s[7 * 33]);
        *(GAS u32x4*)(WT + (size_t)(d0 + n) * Kdst + k0 + 8 * c) = o; }
    LDS_WAIT(); asm volatile("" ::: "memory");
}

struct Args { const float* in[25]; float* out; unsigned char* ws; int ph_lo, ph_hi; };

template <int TYPE>
DI void naive_attn_item(const Args& args, int l, int b, int h, int t) {
    constexpr int DQ = TYPE == 2 ? 96 : 64;
    unsigned char* ws = args.ws;
    bf16* P1 = (bf16*)(ws + WS_P1); bf16* QC = (bf16*)((unsigned char*)args.out + DO_QC); const bf16* KVC = (const bf16*)((unsigned char*)args.out + DO_KVC);
    const f32x2* ROPE = (const f32x2*)(ws + WS_ROPE);
    const size_t row = (size_t)b * SEQ + t;
    float q[DQ];
    const bf16* qsrc = TYPE == 0 ? P1 + row * P1W + C_QA + 64 * h : TYPE == 1 ? P1 + row * P1W + C_QB + 64 * h : QC + row * QCW + 96 * h;
#pragma unroll
    for (int c = 0; c < DQ / 8; ++c) { const u32x4 w = *(const u32x4*)(qsrc + 8 * c);
        q[8 * c + 0] = bflo(w.x); q[8 * c + 1] = bfhi(w.x); q[8 * c + 2] = bflo(w.y); q[8 * c + 3] = bfhi(w.y); q[8 * c + 4] = bflo(w.z); q[8 * c + 5] = bfhi(w.z); q[8 * c + 6] = bflo(w.w); q[8 * c + 7] = bfhi(w.w); }
    if (TYPE == 0) {
        float ss = 0.f;
#pragma unroll
        for (int d = 0; d < 64; ++d) ss += q[d] * q[d];
        const float r = 1.0f / sqrtf(ss * (1.0f / 64.0f) + EPS); const float* gq = args.in[4] + l * 64;
#pragma unroll
        for (int d = 0; d < 64; ++d) q[d] = q[d] * r * gq[d];
        const int gr = t >> 6, gc = t & 63;
#pragma unroll
        for (int i = 0; i < 16; ++i) { const f32x2 cr = ROPE[gr * 16 + i], cc = ROPE[gc * 16 + i];
            const float a1 = q[i], a2 = q[16 + i]; q[i] = a1 * cr.x - a2 * cr.y; q[16 + i] = a2 * cr.x + a1 * cr.y;
            const float b1 = q[32 + i], b2 = q[48 + i]; q[32 + i] = b1 * cc.x - b2 * cc.y; q[48 + i] = b2 * cc.x + b1 * cc.y; }
#pragma unroll
        for (int d = 0; d < 64; ++d) q[d] *= C2_64;
    } else if (TYPE == 1) {
#pragma unroll
        for (int d = 0; d < 64; ++d) q[d] *= C2_64;
    } else {
        const float rs = ((const float*)(ws + WS_RSTDQ))[row] * C2_96;
#pragma unroll
        for (int d = 0; d < 96; ++d) q[d] *= rs;
#pragma unroll
        for (int i = 0; i < 16; ++i) { const f32x2 cs = ROPE[t * 16 + i]; const float a1 = q[64 + i], a2 = q[80 + i]; q[64 + i] = a1 * cs.x - a2 * cs.y; q[80 + i] = a2 * cs.x + a1 * cs.y; }
    }
    float o[64];
#pragma unroll
    for (int d = 0; d < 64; ++d) o[d] = 0.f;
    float mx = -1e30f, lsum = 0.f;
    const int kvh = h >> 2;
    const int s_lo = TYPE == 1 ? (t - 128 < 0 ? 0 : t - 128) : 0, s_hi = TYPE == 1 ? (t + 128 > SEQ - 1 ? SEQ - 1 : t + 128) : SEQ - 1;
    const float* TB = (const float*)(ws + WS_TB) + h * 260;
    for (int s = s_lo; s <= s_hi; ++s) {
        const size_t krow = (size_t)b * SEQ + s;
        const bf16* kp = TYPE == 0 ? P1 + krow * P1W + C_KA + 64 * kvh : TYPE == 1 ? P1 + krow * P1W + C_KB + 64 * kvh : KVC + krow * KVW + 128 * h;
        const bf16* vp = TYPE == 0 ? P1 + krow * P1W + C_VA + 64 * kvh : TYPE == 1 ? P1 + krow * P1W + C_VB + 64 * kvh : KVC + krow * KVW + 128 * h + 64;
        float dot = 0.f;
#pragma unroll
        for (int c = 0; c < 8; ++c) { const u32x4 w = *(const u32x4*)(kp + 8 * c);
            dot += q[8 * c + 0] * bflo(w.x) + q[8 * c + 1] * bfhi(w.x) + q[8 * c + 2] * bflo(w.y) + q[8 * c + 3] * bfhi(w.y) + q[8 * c + 4] * bflo(w.z) + q[8 * c + 5] * bfhi(w.z) + q[8 * c + 6] * bflo(w.w) + q[8 * c + 7] * bfhi(w.w); }
        if (TYPE == 2) { const bf16* rp = P1 + krow * P1W + C_KR;
#pragma unroll
            for (int c = 0; c < 4; ++c) { const u32x4 w = *(const u32x4*)(rp + 8 * c);
                dot += q[64 + 8 * c + 0] * bflo(w.x) + q[64 + 8 * c + 1] * bfhi(w.x) + q[64 + 8 * c + 2] * bflo(w.y) + q[64 + 8 * c + 3] * bfhi(w.y) + q[64 + 8 * c + 4] * bflo(w.z) + q[64 + 8 * c + 5] * bfhi(w.z) + q[64 + 8 * c + 6] * bflo(w.w) + q[64 + 8 * c + 7] * bfhi(w.w); } }
        if (TYPE == 1) dot += TB[s - t + 128];
        const float mn = fmaxf(mx, dot), corr = __builtin_amdgcn_exp2f(mx - mn), p = __builtin_amdgcn_exp2f(dot - mn);
        lsum = lsum * corr + p; mx = mn;
#pragma unroll
        for (int c = 0; c < 8; ++c) { const u32x4 w = *(const u32x4*)(vp + 8 * c);
            o[8 * c + 0] = o[8 * c + 0] * corr + p * bflo(w.x); o[8 * c + 1] = o[8 * c + 1] * corr + p * bfhi(w.x); o[8 * c + 2] = o[8 * c + 2] * corr + p * bflo(w.y); o[8 * c + 3] = o[8 * c + 3] * corr + p * bfhi(w.y);
            o[8 * c + 4] = o[8 * c + 4] * corr + p * bflo(w.z); o[8 * c + 5] = o[8 * c + 5] * corr + p * bfhi(w.z); o[8 * c + 6] = o[8 * c + 6] * corr + p * bflo(w.w); o[8 * c + 7] = o[8 * c + 7] * corr + p * bfhi(w.w); }
    }
    if (TYPE == 1) { const float sk = args.in[6][l * 8 + h] * LOG2E; lsum += __builtin_amdgcn_exp2f(sk - mx); }
    const float inv = 1.0f / lsum;
    bf16* od = TYPE == 2 ? P1 + row * P1W + C_CQ + 64 * h : (bf16*)qsrc;
#pragma unroll
    for (int c = 0; c < 8; ++c) { u32x4 w; w.x = pk2(o[8 * c + 0] * inv, o[8 * c + 1] * inv); w.y = pk2(o[8 * c + 2] * inv, o[8 * c + 3] * inv); w.z = pk2(o[8 * c + 4] * inv, o[8 * c + 5] * inv); w.w = pk2(o[8 * c + 6] * inv, o[8 * c + 7] * inv);
        *(u32x4*)(od + 8 * c) = w; }
}


typedef float f32x16 __attribute__((ext_vector_type(16)));
typedef short s16x4 __attribute__((ext_vector_type(4)));
typedef short v4i16_t __attribute__((ext_vector_type(4)));
constexpr int ATT_TBL_OFF = 118784;
constexpr float ATT_NEG = -1.0e30f, ATT_THR = 6.0f;
DI s16x4 vtr(const LAS unsigned char* p) { return __builtin_bit_cast(s16x4, __builtin_amdgcn_ds_read_tr16_b64_v4i16((LAS v4i16_t*)p)); }
DI float max3f(float a, float b, float c) { float r; asm("v_max3_f32 %0, %1, %2, %3" : "=v"(r) : "v"(a), "v"(b), "v"(c)); return r; }
DI float half_max(float v) { auto rr = __builtin_amdgcn_permlane32_swap(__float_as_uint(v), __float_as_uint(v), false, false); return fmaxf(__uint_as_float(rr[0]), __uint_as_float(rr[1])); }
DI float half_sum(float v) { auto rr = __builtin_amdgcn_permlane32_swap(__float_as_uint(v), __float_as_uint(v), false, false); return __uint_as_float(rr[0]) + __uint_as_float(rr[1]); }
DI bf16x8 pack8(const float (&f)[8]) { u32x4 w; w.x = cvt_pk_bf16(f[0], f[1]); w.y = cvt_pk_bf16(f[2], f[3]); w.z = cvt_pk_bf16(f[4], f[5]); w.w = cvt_pk_bf16(f[6], f[7]); return __builtin_bit_cast(bf16x8, w); }
DI void unpack8(const u32x4 w, float (&f)[8]) { f[0] = bflo(w.x); f[1] = bfhi(w.x); f[2] = bflo(w.y); f[3] = bfhi(w.y); f[4] = bflo(w.z); f[5] = bfhi(w.z); f[6] = bflo(w.w); f[7] = bfhi(w.w); }

template <int TYPE>
DI void attn_unit(LAS unsigned char* lds, const int tid, const int l, const int b, const int hg, const int qt, bf16* P1, const bf16* QC, const bf16* KVC, const f32x2* ROPE, const float* RSTDQ, const float* gq, const float* sinkp) {
    constexpr int DQ = TYPE == 2 ? 96 : 64, NS = DQ / 16, KS = DQ * 2 + 16, VS = 192, KBUF = 64 * KS, VBUF = 64 * VS;
    const int lane = tid & 63, wave = __builtin_amdgcn_readfirstlane(tid >> 6), r = lane & 31, h = lane >> 5;
    const int head = TYPE == 2 ? hg : hg * 4 + (wave & 3);
    const int q0 = TYPE == 2 ? qt * 256 + wave * 32 : qt * 64 + (wave >> 2) * 32;
    const int tq = q0 + r;
    const size_t qrow = (size_t)b * SEQ + tq;
    bf16x8 qf[NS];
    {
        float q[NS][8];
        const bf16* qsrc = TYPE == 0 ? P1 + qrow * P1W + C_QA + 64 * head : TYPE == 1 ? P1 + qrow * P1W + C_QB + 64 * head : QC + qrow * QCW + 96 * head;
#pragma unroll
        for (int s = 0; s < NS; ++s) unpack8(*(const u32x4*)(qsrc + 16 * s + 8 * h), q[s]);
        if (TYPE == 0) {
            float ss = 0.f;
#pragma unroll
            for (int s = 0; s < 4; ++s)
#pragma unroll
                for (int j = 0; j < 8; ++j) ss += q[s][j] * q[s][j];
            ss = half_sum(ss);
            const float rn = 1.0f / sqrtf(ss * (1.0f / 64.0f) + EPS) * C2_64;
#pragma unroll
            for (int s = 0; s < 4; ++s)
#pragma unroll
                for (int j = 0; j < 8; ++j) q[s][j] *= rn * gq[16 * s + 8 * h + j];
            const int gr = tq >> 6, gc = tq & 63;
#pragma unroll
            for (int j = 0; j < 8; ++j) { const f32x2 cr = ROPE[gr * 16 + 8 * h + j], cc = ROPE[gc * 16 + 8 * h + j];
                const float a1 = q[0][j], a2 = q[1][j]; q[0][j] = a1 * cr.x - a2 * cr.y; q[1][j] = a2 * cr.x + a1 * cr.y;
                const float b1 = q[2][j], b2 = q[3][j]; q[2][j] = b1 * cc.x - b2 * cc.y; q[3][j] = b2 * cc.x + b1 * cc.y; }
        } else if (TYPE == 1) {
#pragma unroll
            for (int s = 0; s < 4; ++s)
#pragma unroll
                for (int j = 0; j < 8; ++j) q[s][j] *= C2_64;
        } else {
            const float rs = RSTDQ[qrow] * C2_96;
#pragma unroll
            for (int s = 0; s < NS; ++s)
#pragma unroll
                for (int j = 0; j < 8; ++j) q[s][j] *= rs;
#pragma unroll
            for (int j = 0; j < 8; ++j) { const f32x2 cs = ROPE[tq * 16 + 8 * h + j]; const float a1 = q[NS - 2][j], a2 = q[NS - 1][j]; q[NS - 2][j] = a1 * cs.x - a2 * cs.y; q[NS - 1][j] = a2 * cs.x + a1 * cs.y; }
        }
#pragma unroll
        for (int s = 0; s < NS; ++s) qf[s] = pack8(q[s]);
    }
    if (TYPE == 2) { *(LAS bf16x8*)(lds + 102400 + wave * 2048 + lane * 16) = qf[NS - 2]; *(LAS bf16x8*)(lds + 102400 + wave * 2048 + 1024 + lane * 16) = qf[NS - 1]; }
    const int kvh = TYPE == 2 ? 0 : hg;
    const bf16* Kg = TYPE == 0 ? P1 + C_KA + 64 * kvh : TYPE == 1 ? P1 + C_KB + 64 * kvh : KVC + 128 * head;
    const bf16* Vg = TYPE == 0 ? P1 + C_VA + 64 * kvh : TYPE == 1 ? P1 + C_VB + 64 * kvh : KVC + 128 * head + 64;
    const int kvp = TYPE == 2 ? KVW : P1W;
    const int kt_lo = TYPE == 1 ? (qt - 2 < 0 ? 0 : qt - 2) : 0, kt_hi = TYPE == 1 ? (qt + 2 > 31 ? 31 : qt + 2) : 31, nt = kt_hi - kt_lo + 1;
    const int lkey = tid >> 3, lch = tid & 7, pkey = (tid >> 2) & 63, pch = tid & 3;
    const size_t brow = (size_t)b * SEQ;
    u32x4 kreg, vreg, preg = (u32x4){0u, 0u, 0u, 0u};
    constexpr int SLOT = KBUF + VBUF;
#define ATT_LOAD(kt) do { const size_t kr_ = brow + (size_t)(kt) * 64 + lkey; kreg = *(const u32x4*)(Kg + kr_ * kvp + lch * 8); vreg = *(const u32x4*)(Vg + kr_ * kvp + lch * 8); \
        if (TYPE == 2 && tid < 256) preg = *(const u32x4*)(P1 + (brow + (size_t)(kt) * 64 + pkey) * P1W + C_KR + pch * 8); } while (0)
#define ATT_STORE(so) do { *(LAS u32x4*)(lds + (so) + lkey * KS + lch * 16) = kreg; *(LAS u32x4*)(lds + (so) + KBUF + lkey * VS + lch * 16) = vreg; \
        if (TYPE == 2 && tid < 256) *(LAS u32x4*)(lds + (so) + pkey * KS + 128 + pch * 16) = preg; } while (0)
    const int koff = r * KS + h * 16;
    const int voff = KBUF + (4 * h + ((lane & 15) >> 2)) * VS + ((lane >> 4) & 1) * 32 + (lane & 3) * 8;
    const int tboff = ATT_TBL_OFF + head * 1536 + (192 + 4 * h - tq) * 4;
    constexpr bool REL = true;
    f32x16 o0, o1, negm, zero16;
#pragma unroll
    for (int i = 0; i < 16; ++i) { o0[i] = 0.f; o1[i] = 0.f; negm[i] = 0.f; zero16[i] = 0.f; }
    float m_run = 0.f, l_run = 0.f;
    int s_cur = 0, s_nxt = SLOT, s_nn = 2 * SLOT, s_n3 = 3 * SLOT;
    bf16x8 kfr[2 * NS]; s16x4 vlo[8], vhi[8]; bf16x8 pf[4];
#define ATT_KREAD(so, S0, S1) do { int ko_ = koff; asm volatile("" : "+v"(ko_)); const LAS unsigned char* Kb_ = lds + (so) + ko_; \
        _Pragma("unroll") for (int s = S0; s < S1; ++s) { kfr[2 * s] = *(const LAS bf16x8*)(Kb_ + s * 32); kfr[2 * s + 1] = *(const LAS bf16x8*)(Kb_ + 32 * KS + s * 32); } } while (0)
#define ATT_VREAD(so, K0, K1) do { const LAS unsigned char* Vb_ = lds + (so) + voff; \
        _Pragma("unroll") for (int kk = K0; kk < K1; ++kk) { vlo[2 * kk] = vtr(Vb_ + kk * 16 * VS); vhi[2 * kk] = vtr(Vb_ + kk * 16 * VS + 8 * VS); vlo[2 * kk + 1] = vtr(Vb_ + kk * 16 * VS + 64); vhi[2 * kk + 1] = vtr(Vb_ + kk * 16 * VS + 8 * VS + 64); } } while (0)
#define ATT_VF(i) (bf16x8){vlo[i][0], vlo[i][1], vlo[i][2], vlo[i][3], vhi[i][0], vhi[i][1], vhi[i][2], vhi[i][3]}
#define ATT_QF(j) (((j) >> 1) < 4 ? qf[((j) >> 1) & 3] : *(const LAS bf16x8*)(lds + 102400 + wave * 2048 + (((j) >> 1) - 4) * 1024 + lane * 16))
#define ATT_QKM(N0, N1, j) do { if (((j) & 1) == 0) N0 = __builtin_amdgcn_mfma_f32_32x32x16_bf16(kfr[j], ATT_QF(j), ((j) >> 1) == 0 ? (REL ? negm : zero16) : N0, 0, 0, 0); \
        else N1 = __builtin_amdgcn_mfma_f32_32x32x16_bf16(kfr[j], ATT_QF(j), ((j) >> 1) == 0 ? (REL ? negm : zero16) : N1, 0, 0, 0); } while (0)
#define ATT_EXP4(C, c, PFW, wlo) do { const float sh_ = REL ? 0.f : m_run; const float e0 = __builtin_amdgcn_exp2f(C[4 * (c)] - sh_), e1 = __builtin_amdgcn_exp2f(C[4 * (c) + 1] - sh_), e2 = __builtin_amdgcn_exp2f(C[4 * (c) + 2] - sh_), e3 = __builtin_amdgcn_exp2f(C[4 * (c) + 3] - sh_); \
        lsa += e0; lsb += e1; lsa += e2; lsb += e3; if (wlo) { PFW.x = cvtpk(e0, e1); PFW.y = cvtpk(e2, e3); } else { PFW.z = cvtpk(e0, e1); PFW.w = cvtpk(e2, e3); } } while (0)
#define ATT_BIAS(N0, N1, tt) do { if (TYPE == 1) { const LAS float* tb = (const LAS float*)(lds + tboff + (kt_lo + (tt)) * 256); \
        _Pragma("unroll") for (int i = 0; i < 16; ++i) { N0[i] += tb[(i & 3) + 8 * (i >> 2)]; N1[i] += tb[32 + (i & 3) + 8 * (i >> 2)]; } } } while (0)
#define ATT_BIAS4(N0, N1, tt, c) do { if (TYPE == 1) { const volatile LAS float* tb = (const volatile LAS float*)(lds + tboff + (kt_lo + (tt)) * 256 + 32 * (c)); \
        _Pragma("unroll") for (int i = 0; i < 4; ++i) { N0[4 * (c) + i] += tb[i]; N1[4 * (c) + i] += tb[32 + i]; } } } while (0)
#define PIN2(a_, b_) asm volatile("" : "+v"(a_), "+v"(b_))
#define PIN3(a_, b_, c_) asm volatile("" : "+v"(a_), "+v"(b_), "+v"(c_))
#define PIN4(a_, b_, c_, d_) asm volatile("" : "+v"(a_), "+v"(b_), "+v"(c_), "+v"(d_))
#define ATT_MAX4(N0, N1, c, acc) do { if (TYPE == 1) { acc = fmaxf(acc, fmaxf(fmaxf(N0[4 * (c)], N0[4 * (c) + 1]), fmaxf(N0[4 * (c) + 2], N0[4 * (c) + 3]))); acc = fmaxf(acc, fmaxf(fmaxf(N1[4 * (c)], N1[4 * (c) + 1]), fmaxf(N1[4 * (c) + 2], N1[4 * (c) + 3]))); } \
        else { acc = max3f(acc, N0[4 * (c)], N0[4 * (c) + 1]); acc = max3f(acc, N0[4 * (c) + 2], N0[4 * (c) + 3]); acc = max3f(acc, N1[4 * (c)], N1[4 * (c) + 1]); acc = max3f(acc, N1[4 * (c) + 2], N1[4 * (c) + 3]); } } while (0)
    {
        u32x4 k0_, v0_, p0_ = (u32x4){0u, 0u, 0u, 0u}, k1_, v1_, p1_ = p0_;
        ATT_LOAD(kt_lo); k0_ = kreg; v0_ = vreg; p0_ = preg;
        ATT_LOAD(kt_lo + 1); k1_ = kreg; v1_ = vreg; p1_ = preg;
        ATT_LOAD(kt_lo + 2);
        { const u32x4 k2_ = kreg, v2_ = vreg, p2_ = preg;
          if (nt > 3) ATT_LOAD(kt_lo + 3);
          const u32x4 k3_ = kreg, v3_ = vreg, p3_ = preg;
          kreg = k0_; vreg = v0_; preg = p0_; ATT_STORE(0);
          kreg = k1_; vreg = v1_; preg = p1_; ATT_STORE(SLOT);
          kreg = k2_; vreg = v2_; preg = p2_; ATT_STORE(2 * SLOT);
          kreg = k3_; vreg = v3_; preg = p3_; }
    }
    __syncthreads();
    f32x16 sa0, sa1, sb0, sb1; float tmx;
    ATT_KREAD(0, 0, NS);
#pragma unroll
    for (int j = 0; j < 2 * NS; ++j) ATT_QKM(sa0, sa1, j);
    ATT_BIAS(sa0, sa1, 0);
    tmx = ATT_NEG;
#pragma unroll
    for (int c = 0; c < 4; ++c) tmx = fmaxf(tmx, fmaxf(fmaxf(fmaxf(sa0[4 * c], sa0[4 * c + 1]), fmaxf(sa0[4 * c + 2], sa0[4 * c + 3])), fmaxf(fmaxf(sa1[4 * c], sa1[4 * c + 1]), fmaxf(sa1[4 * c + 2], sa1[4 * c + 3]))));
    tmx = half_max(tmx);
    m_run = tmx;
    if (REL) {
#pragma unroll
        for (int i = 0; i < 16; ++i) { sa0[i] -= m_run; sa1[i] -= m_run; negm[i] = -m_run; }
        tmx = 0.f; }
    constexpr int KP = 0;
    if (KP > 0 && nt > 1) ATT_KREAD(SLOT, 0, KP);
#define ATT_STEP(C0, C1, N0, N1, t, FULL, PRE) do { \
        if (FULL) ATT_KREAD(s_nxt, KP, 2); \
        if (__any(tmx > (REL ? 0.f : m_run) + ATT_THR)) { const float dl = fmaxf(tmx - (REL ? 0.f : m_run), 0.f), al = __builtin_amdgcn_exp2f(-dl); m_run += dl; l_run *= al; \
            _Pragma("unroll") for (int i = 0; i < 16; ++i) { o0[i] *= al; o1[i] *= al; } \
            if (REL) { _Pragma("unroll") for (int i = 0; i < 16; ++i) { C0[i] -= dl; C1[i] -= dl; negm[i] = -m_run; } } } \
        float lsa = 0.f, lsb = 0.f; u32x4 w0_ = (u32x4){0u, 0u, 0u, 0u}, w1_ = w0_, w2_ = w0_, w3_ = w0_; \
        if (FULL) ATT_QKM(N0, N1, 0); ATT_EXP4(C0, 0, w0_, true);  if (FULL) { PIN4(N0, lsa, lsb, w0_); } else { PIN3(lsa, lsb, w0_); } \
        if (FULL) ATT_QKM(N0, N1, 1); ATT_EXP4(C0, 1, w0_, false); if (FULL) ATT_KREAD(s_nxt, 2, 4); if (FULL) { PIN4(N1, lsa, lsb, w0_); } else { PIN3(lsa, lsb, w0_); } \
        if (FULL) ATT_QKM(N0, N1, 2); ATT_EXP4(C0, 2, w1_, true);  if (FULL) { PIN4(N0, lsa, lsb, w1_); } else { PIN3(lsa, lsb, w1_); } \
        if (FULL) ATT_QKM(N0, N1, 3); ATT_EXP4(C0, 3, w1_, false); if (FULL && NS > 4) ATT_KREAD(s_nxt, 4, NS); ATT_VREAD(s_cur, 0, 2); if (FULL) { PIN4(N1, lsa, lsb, w1_); } else { PIN3(lsa, lsb, w1_); } \
        if (FULL) ATT_QKM(N0, N1, 4); ATT_EXP4(C1, 0, w2_, true);  if (FULL) { PIN4(N0, lsa, lsb, w2_); } else { PIN3(lsa, lsb, w2_); } \
        if (FULL) ATT_QKM(N0, N1, 5); ATT_EXP4(C1, 1, w2_, false); if (FULL) { PIN4(N1, lsa, lsb, w2_); } else { PIN3(lsa, lsb, w2_); } \
        if (FULL) ATT_QKM(N0, N1, 6); ATT_EXP4(C1, 2, w3_, true);  if (FULL) { PIN4(N0, lsa, lsb, w3_); } else { PIN3(lsa, lsb, w3_); } \
        if (FULL) ATT_QKM(N0, N1, 7); ATT_EXP4(C1, 3, w3_, false); if (FULL) { PIN4(N1, lsa, lsb, w3_); } else { PIN3(lsa, lsb, w3_); } \
        if (FULL && NS > 4) { ATT_QKM(N0, N1, 8); ATT_QKM(N0, N1, 9); ATT_QKM(N0, N1, 10); ATT_QKM(N0, N1, 11); } \
        ATT_VREAD(s_cur, 2, 4); \
        if ((t) + 3 < nt) ATT_STORE(s_n3); \
        if ((t) + 4 < nt) ATT_LOAD(kt_lo + (t) + 4); \
        l_run += lsa + lsb; \
        pf[0] = __builtin_bit_cast(bf16x8, w0_); pf[1] = __builtin_bit_cast(bf16x8, w1_); pf[2] = __builtin_bit_cast(bf16x8, w2_); pf[3] = __builtin_bit_cast(bf16x8, w3_); \
        tmx = ATT_NEG; \
        o0 = __builtin_amdgcn_mfma_f32_32x32x16_bf16(ATT_VF(0), pf[0], o0, 0, 0, 0); if (KP > 0 && PRE) ATT_KREAD(s_nn, 0, KP); PIN2(o0, tmx); \
        o1 = __builtin_amdgcn_mfma_f32_32x32x16_bf16(ATT_VF(1), pf[0], o1, 0, 0, 0); PIN2(o1, tmx); \
        o0 = __builtin_amdgcn_mfma_f32_32x32x16_bf16(ATT_VF(2), pf[1], o0, 0, 0, 0); PIN2(o0, tmx); \
        o1 = __builtin_amdgcn_mfma_f32_32x32x16_bf16(ATT_VF(3), pf[1], o1, 0, 0, 0); if (FULL) { ATT_BIAS4(N0, N1, (t) + 1, 0); ATT_MAX4(N0, N1, 0, tmx); } PIN2(o1, tmx); \
        o0 = __builtin_amdgcn_mfma_f32_32x32x16_bf16(ATT_VF(4), pf[2], o0, 0, 0, 0); if (FULL) { ATT_BIAS4(N0, N1, (t) + 1, 1); ATT_MAX4(N0, N1, 1, tmx); } PIN2(o0, tmx); \
        o1 = __builtin_amdgcn_mfma_f32_32x32x16_bf16(ATT_VF(5), pf[2], o1, 0, 0, 0); if (FULL) { ATT_BIAS4(N0, N1, (t) + 1, 2); ATT_MAX4(N0, N1, 2, tmx); } PIN2(o1, tmx); \
        o0 = __builtin_amdgcn_mfma_f32_32x32x16_bf16(ATT_VF(6), pf[3], o0, 0, 0, 0); if (FULL) { ATT_BIAS4(N0, N1, (t) + 1, 3); ATT_MAX4(N0, N1, 3, tmx); } PIN2(o0, tmx); \
        o1 = __builtin_amdgcn_mfma_f32_32x32x16_bf16(ATT_VF(7), pf[3], o1, 0, 0, 0); PIN2(o1, tmx); \
        if (FULL) tmx = half_max(tmx); \
        asm volatile("s_waitcnt lgkmcnt(0)\n\ts_barrier" ::: "memory");     \
        { const int tmp_ = s_cur; s_cur = s_nxt; s_nxt = s_nn; s_nn = s_n3; s_n3 = tmp_; } \
    } while (0)
    int t = 0;
    for (; t + 1 < nt; t += 2) { ATT_STEP(sa0, sa1, sb0, sb1, t, true, true); ATT_STEP(sb0, sb1, sa0, sa1, t + 1, true, true); }
    if (t < nt) { ATT_STEP(sa0, sa1, sb0, sb1, t, true, true); }
#undef ATT_STEP
#undef ATT_MAX4
#undef PIN2
#undef PIN3
#undef PIN4
#undef ATT_BIAS
#undef ATT_BIAS4
#undef ATT_EXP4
#undef ATT_QKM
#undef ATT_QF
#undef ATT_VF
#undef ATT_VREAD
#undef ATT_KREAD
#undef ATT_LOAD
#undef ATT_STORE
    float lt = half_sum(l_run);
    if (TYPE == 1) lt += __builtin_amdgcn_exp2f(sinkp[head] * LOG2E - m_run);
    const float inv = 1.0f / lt;
    bf16* od = P1 + qrow * P1W + (TYPE == 0 ? C_QA : TYPE == 1 ? C_QB : C_CQ) + 64 * head + 4 * h;
#pragma unroll
    for (int g = 0; g < 4; ++g) {
        *(u32x2*)(od + 8 * g) = (u32x2){cvt_pk_bf16(o0[4 * g] * inv, o0[4 * g + 1] * inv), cvt_pk_bf16(o0[4 * g + 2] * inv, o0[4 * g + 3] * inv)};
        *(u32x2*)(od + 32 + 8 * g) = (u32x2){cvt_pk_bf16(o1[4 * g] * inv, o1[4 * g + 1] * inv), cvt_pk_bf16(o1[4 * g + 2] * inv, o1[4 * g + 3] * inv)};
    }
}

constexpr int NPH = 1 + 11 * DEPTH;
__global__ void __launch_bounds__(512, 2) fwd_kernel(Args args) {
    extern __shared__ __attribute__((aligned(16))) unsigned char lds_raw[];
    LAS unsigned char* lds = (LAS unsigned char*)lds_raw;
    volatile LAS unsigned* MISC = (volatile LAS unsigned*)(lds + LDSCTL_OFF);
    const int tid0 = threadIdx.x, wave = __builtin_amdgcn_readfirstlane(tid0 >> 6);
    const int G = gridDim.x, bx = blockIdx.x;
    const int gw = bx * 8 + wave, NGW = G * 8;
    unsigned char* const ws0 = args.ws; unsigned char* const out0 = (unsigned char*)args.out;
    for (int u = tid0; u < (LDS_BYTES - LDSCTL_OFF) / 4; u += 512) MISC[u] = 0u;
    __syncthreads();
    XcdBarrier bar; bar.bar = (unsigned*)(ws0 + WS_CTL) + CW_BAR; bar.x = 0; bar.st = nullptr;
#if ONE_LAUNCH
    bar = xcd_barrier_post((unsigned*)(ws0 + WS_CTL) + CW_BAR, MISC + 8);
#endif
    const int lo = args.ph_lo, hi = args.ph_hi;
#define IN(k) (lo <= (k) && (k) < hi)
#define SEAM(k) do { if (IN(k) && IN((k) + 1)) { if (ONE_LAUNCH) xcd_barrier(bar); } } while (0)

#define PHASE_BEGIN \
    unsigned ones_ = ~0u; asm volatile("" : "+s"(ones_)); \
    int tid = wave * 64 + (int)__builtin_amdgcn_mbcnt_hi(ones_, __builtin_amdgcn_mbcnt_lo(ones_, 0u)); asm volatile("" : "+v"(tid)); const int lane = tid & 63; \
    size_t zoff = 0; asm volatile("" : "+s"(zoff)); unsigned char* ws = ws0 + zoff; unsigned char* outb = out0 + zoff; \
    unsigned* ctl = (unsigned*)(ws + WS_CTL); (void)ctl; (void)lane; \
    bf16* XB = (bf16*)(ws + WS_XB); bf16* P1 = (bf16*)(ws + WS_P1); bf16* GB = (bf16*)(ws + WS_G); (void)XB; (void)P1; (void)GB; \
    bf16* QC = (bf16*)(outb + DO_QC); bf16* KVC = (bf16*)(outb + DO_KVC); bf16* MG = KVC; (void)QC; (void)KVC; (void)MG; \
    bf16* Y = (bf16*)(ws + WS_G); bf16* HID = (bf16*)(ws + WS_P1); bf16* PAIR = (bf16*)(ws + WS_G); (void)Y; (void)HID; (void)PAIR; \
    unsigned char* Wb = ws + WS_W; (void)Wb; \
    f32x2* ROPE = (f32x2*)(ws + WS_ROPE); float* TB = (float*)(ws + WS_TB); (void)ROPE; (void)TB; \
    float* RSTDQ = (float*)(ws + WS_RSTDQ); float* RSTDKV = (float*)(ws + WS_RSTDKV); (void)RSTDQ; (void)RSTDKV; \
    int* LIST = (int*)(ws + WS_LIST); unsigned* ROUTE = (unsigned*)(ws + WS_ROUTE); (void)LIST; (void)ROUTE;

    if (EN(11) && IN(0)) { PHASE_BEGIN
        for (int idx = bx * 512 + tid; idx < 2048 * 16; idx += G * 512) { const int pos = idx >> 4, i = idx & 15; float c, s; cos_sin((double)pos * (double)inv_freq16(i), c, s); ROPE[idx] = (f32x2){c, s}; }
        for (int idx = bx * 512 + tid; idx < 8 * 257; idx += G * 512) { const int h = idx / 257, r = idx % 257, rel = r - 128; const int n = rel < 0 ? -rel : rel;
            const int bk = t5_bucket_n(n) + (rel > 0 ? 16 : 0); TB[h * 260 + r] = args.in[7][bk * 8 + h] * LOG2E; }
        const float* g = args.in[1]; const float* bb = args.in[2];
        f32x4 gv[4], bv[4];
#pragma unroll
        for (int j = 0; j < 4; ++j) { gv[j] = *(const f32x4*)(g + 256 * j + 4 * lane); bv[j] = *(const f32x4*)(bb + 256 * j + 4 * lane); }
        f32x4 xnx[4];
#pragma unroll
        for (int j = 0; j < 4; ++j) xnx[j] = *(const f32x4*)(args.in[0] + (size_t)(gw < NTOK ? gw : 0) * DM + 256 * j + 4 * lane);
        for (int m = gw; m < NTOK; m += NGW) {
            f32x4 v[4]; float s = 0.f;
#pragma unroll
            for (int j = 0; j < 4; ++j) { v[j] = xnx[j]; s += (v[j].x + v[j].y) + (v[j].z + v[j].w); }
            if (m + NGW < NTOK) {
#pragma unroll
                for (int j = 0; j < 4; ++j) xnx[j] = *(const f32x4*)(args.in[0] + (size_t)(m + NGW) * DM + 256 * j + 4 * lane); }
            const float mean = wave_sum(s) * (1.f / DM); float s2 = 0.f;
#pragma unroll
            for (int j = 0; j < 4; ++j) { v[j] = v[j] - mean; s2 += (v[j].x * v[j].x + v[j].y * v[j].y) + (v[j].z * v[j].z + v[j].w * v[j].w); }
            const float rstd = 1.f / sqrtf(wave_sum(s2) * (1.f / DM) + EPS);
#pragma unroll
            for (int j = 0; j < 4; ++j) { const f32x4 o = v[j] * rstd * gv[j] + bv[j]; *(u32x2*)(XB + (size_t)m * DM + 256 * j + 4 * lane) = (u32x2){pk2(o.x, o.y), pk2(o.z, o.w)}; }
        }
    }

    for (int l = 0; l < DEPTH; ++l) {
        const int pb = 1 + 11 * l;
        if (EN(0) && IN(pb + 0)) for (int rep_ = 0; rep_ < REPS_0; ++rep_) { PHASE_BEGIN
            LAS float* scr = (LAS float*)(lds + wave * 16384);
            const float* w_in = args.in[3] + (size_t)l * DM * INCOLS;
            const float* w_uq = args.in[10] + (size_t)l * 384 * 768; const float* w_ukv = args.in[11] + (size_t)l * 256 * 1024;
            const float* w_o = args.in[15] + (size_t)l * 1024 * 1024;
            const float* w_gate = args.in[20] + (size_t)l * 16 * 1024 * 512; const float* w_up = args.in[21] + (size_t)l * 16 * 1024 * 512; const float* w_down = args.in[22] + (size_t)l * 16 * 512 * 1024;
            const float* g_cq = args.in[8] + l * 384; const float* g_ckv = args.in[9] + l * 256;
            constexpr int I0 = 16 * 165, I1 = 6 * 24, I2 = 4 * 32, I3 = 8 * 32, I6 = 16 * 32, I7 = 16 * 16 * 16, I9 = 16 * 8 * 32;
            constexpr int NIT = I0 + I1 + I2 + 3 * I3 + I6 + 2 * I7 + I9;
            for (int it = gw; it < NIT; it += NGW) {
                int r = it;
                if (r < I0) { const int kb = r / 165, nb = r % 165; transpose_item(w_in, INCOLS, 64 * kb, 32 * nb, (bf16*)(Wb + W_WIN), 1024, 32 * (nb < 69 ? nb : nb + 3), nullptr, scr, lane); continue; } r -= I0;
                if (r < I1) { const int kb = r / 24, nb = r % 24; transpose_item(w_uq, 768, 64 * kb, 32 * nb, (bf16*)(Wb + W_WUP), 1024, 32 * nb, g_cq, scr, lane); continue; } r -= I1;
                if (r < I2) { const int kb = r / 32, nb = r % 32; transpose_item(w_ukv, 1024, 64 * kb, 32 * nb, (bf16*)(Wb + W_WUP), 1024, 768 + 32 * nb, g_ckv, scr, lane); continue; } r -= I2;
                if (r < 3 * I3) { const int j = r / I3, q = r % I3, kb = q / 32, nb = q % 32; transpose_item((j == 0 ? args.in[12] : j == 1 ? args.in[13] : args.in[14]) + (size_t)l * 512 * 1024, 1024, 64 * kb, 32 * nb, (bf16*)(Wb + W_WBR) + (size_t)j * 1024 * 512, 512, 32 * nb, nullptr, scr, lane); continue; } r -= 3 * I3;
                if (r < I6) { const int kb = r / 32, nb = r % 32; transpose_item(w_o, 1024, 64 * kb, 32 * nb, (bf16*)(Wb + W_WO), 1024, 32 * nb, nullptr, scr, lane); continue; } r -= I6;
                if (r < 2 * I7) { const int up = r / I7, q = r % I7, e = q / 256, kb = (q % 256) / 16, nb = q % 16;
                    transpose_item((up ? w_up : w_gate) + (size_t)e * 1024 * 512, 512, 64 * kb, 32 * nb, (bf16*)(Wb + W_WGU) + (size_t)e * 1024 * 1024, 1024, 32 * ((nb >> 2) * 8 + up * 4 + (nb & 3)), nullptr, scr, lane); continue; } r -= 2 * I7;
                { const int e = r / 256, kb = (r % 256) / 32, nb = r % 32; transpose_item(w_down + (size_t)e * 512 * 1024, 1024, 64 * kb, 32 * nb, (bf16*)(Wb + W_WD) + (size_t)e * 1024 * 512, 512, 32 * nb, nullptr, scr, lane); }
            }
            { unsigned zu = 0u; asm volatile("" : "+v"(zu));
              for (int idx = bx * 512 + tid; idx < 96 * 1024 / 8; idx += G * 512) *(u32x4*)((bf16*)(Wb + W_WIN) + (size_t)2208 * 1024 + (size_t)idx * 8) = (u32x4){zu, zu, zu, zu}; }
        }
        SEAM(pb + 0);

        if (EN(1) && IN(pb + 1)) for (int rep_ = 0; rep_ < REPS_1; ++rep_) { PHASE_BEGIN
            pg8::SchedPlain S; S.o.init(NTOK / 256, INW / 256 - 1, G, bx); S.A = (const char*)XB; S.Bt = (const char*)(Wb + W_WIN);
            S.lda2 = 2048; S.ldb2 = 2048;
            pg8::EpiInproj E{P1, GB};
            pg8::gemm_phase<pg8::EpiInproj, pg8::SchedPlain, true>(lds, tid, 1024, 2048, S, E);
        }
        SEAM(pb + 1);

        if (EN(2) && IN(pb + 2)) { PHASE_BEGIN
            const float* gk = args.in[5] + l * 64;
            const float gk0 = gk[2 * (lane & 31)], gk1 = gk[2 * (lane & 31) + 1];
            for (int m0 = gw; m0 < NTOK; m0 += 4 * NGW) {
                unsigned wka[4], wq[4][3], wk[4][2]; float vkr[4];
#pragma unroll
                for (int q = 0; q < 4; ++q) { const int m = m0 + q * NGW < NTOK ? m0 + q * NGW : m0; const bf16* pr = P1 + (size_t)m * P1W;
                    wka[q] = *(const unsigned*)(pr + C_KA + 2 * lane); vkr[q] = lane < 32 ? bf2f(pr[C_KR + lane]) : 0.f;
#pragma unroll
                    for (int j = 0; j < 3; ++j) wq[q][j] = *(const unsigned*)(pr + C_CQ + 128 * j + 2 * lane);
#pragma unroll
                    for (int j = 0; j < 2; ++j) wk[q][j] = *(const unsigned*)(pr + C_CKV + 128 * j + 2 * lane); }
#pragma unroll
                for (int q = 0; q < 4; ++q) { const int m = m0 + q * NGW; if (m < NTOK) {
                    bf16* pr = P1 + (size_t)m * P1W; const int t = m & (SEQ - 1), gr = t >> 6, gc = t & 63;
                    {
                        const int ll = lane & 31; float a = bflo(wka[q]), b = bfhi(wka[q]);
                        float ss = sum32(a * a + b * b);
                        const float r = 1.0f / sqrtf(ss * (1.0f / 64.0f) + EPS); const int d = 2 * ll; a = a * r * gk0; b = b * r * gk1;
                        const float pa = swz_xor<8>(a), pbv = swz_xor<8>(b);
                        const int pos = ll < 16 ? gr : gc, i0 = d & 15; const f32x2 c0 = ROPE[pos * 16 + i0], c1 = ROPE[pos * 16 + i0 + 1];
                        const bool first = (ll & 8) == 0;
                        const float oa = first ? a * c0.x - pa * c0.y : a * c0.x + pa * c0.y, ob = first ? b * c1.x - pbv * c1.y : b * c1.x + pbv * c1.y;
                        *(unsigned*)(pr + C_KA + 2 * lane) = pk2(oa, ob);
                    }
                    {
                        const float v = vkr[q]; const float p = swz_xor<16>(v);
                        const f32x2 cs = ROPE[t * 16 + (lane & 15)]; const float o = (lane < 16) ? v * cs.x - p * cs.y : v * cs.x + p * cs.y;
                        if (lane < 32) pr[C_KR + lane] = (bf16)f2bf(o);
                    }
                    {
                        float sq = 0.f, sk = 0.f;
#pragma unroll
                        for (int j = 0; j < 3; ++j) sq += bflo(wq[q][j]) * bflo(wq[q][j]) + bfhi(wq[q][j]) * bfhi(wq[q][j]);
#pragma unroll
                        for (int j = 0; j < 2; ++j) sk += bflo(wk[q][j]) * bflo(wk[q][j]) + bfhi(wk[q][j]) * bfhi(wk[q][j]);
                        sq = wave_sum(sq); sk = wave_sum(sk);
                        if (lane == 0) { RSTDQ[m] = 1.0f / sqrtf(sq * (1.0f / 384.0f) + EPS); RSTDKV[m] = 1.0f / sqrtf(sk * (1.0f / 256.0f) + EPS); }
                    } } }
            }
        }
        SEAM(pb + 2);

        if (EN(3) && IN(pb + 3)) for (int rep_ = 0; rep_ < REPS_3; ++rep_) { PHASE_BEGIN
            pg8::SchedUp S; S.G = G; S.c = bx; S.wsb = (const char*)ws; S.lda2 = P1W * 2;
            pg8::EpiUp E{QC, KVC, RSTDKV, GB};
            pg8::gemm_phase<pg8::EpiUp, pg8::SchedUp, true>(lds, tid, 384, 2048, S, E);
        }
        SEAM(pb + 3);

        if (EN(4) && IN(pb + 4)) { PHASE_BEGIN
#if ((ATTN_FAST & 7) != 7) && !defined(ATT_NO_NAIVE)
            for (int it = bx * 512 + tid; it < 3 * NBATCH * 8 * SEQ; it += G * 512) {
                const int t = it & (SEQ - 1), h = (it >> 11) & 7, b = (it >> 14) & 15, ty = it >> 18;
                if (ty == 0) { if (!(ATTN_FAST & 1)) naive_attn_item<0>(args, l, b, h, t); } else if (ty == 1) { if (!(ATTN_FAST & 2)) naive_attn_item<1>(args, l, b, h, t); } else { if (!(ATTN_FAST & 4)) naive_attn_item<2>(args, l, b, h, t); }
            }
            __syncthreads();
#endif
            const int xcd = bx & 7, idx = bx >> 3;
            const float* gq = args.in[4] + l * 64; const float* sinkp = args.in[6] + l * 8;
#if ATTN_FAST & 2
            for (int j = tid; j < 8 * 384; j += 512) { const int hh = j / 384, rel = j % 384 - 192; ((LAS float*)(lds + ATT_TBL_OFF))[j] = (rel >= -128 && rel <= 128) ? TB[hh * 260 + rel + 128] : ATT_NEG; }
            __syncthreads();
#endif
#if ATTN_FAST & 4
            for (int i = 0; ; ++i) { const int L = i * G + bx; if (L >= 1024 * REPS_4C) break;
                int u = L & 1023; if (G == 256) { const int rd = (L >> 8) & 3; u = (rd * 32 + xcd * 4 + (idx >> 3)) * 8 + (idx & 7); }
                attn_unit<2>(lds, tid, l, u >> 6, (u >> 3) & 7, u & 7, P1, QC, KVC, ROPE, RSTDQ, gq, sinkp); }
#endif
#if ATTN_FAST & 1
            for (int i = 0; ; ++i) { const int L = i * G + bx; if (L >= 1024) break;
                int u = L; if (G == 256) { const int rd = L >> 8; u = (rd * 8 + xcd) * 32 + idx; }
                attn_unit<0>(lds, tid, l, u >> 6, (u >> 5) & 1, u & 31, P1, QC, KVC, ROPE, RSTDQ, gq, sinkp); }
#endif
#if ATTN_FAST & 2
            for (int i = 0; ; ++i) { const int L = i * G + bx; if (L >= 1024) break;
                int u = L; if (G == 256) { const int rd = L >> 8; u = (rd * 8 + xcd) * 32 + idx; }
                attn_unit<1>(lds, tid, l, u >> 6, (u >> 5) & 1, u & 31, P1, QC, KVC, ROPE, RSTDQ, gq, sinkp); }
#endif
        }
        SEAM(pb + 4);

        if (EN(5) && IN(pb + 5)) for (int rep_ = 0; rep_ < REPS_5; ++rep_) { PHASE_BEGIN
            pg8::SchedMerge S; S.o.init(NTOK / 256, DM / 256, G, bx); S.P1 = (const char*)P1; S.Wbr = (const char*)(Wb + W_WBR); S.lda2 = P1W * 2;
            pg8::EpiMerge E{MG, GB};
            pg8::gemm_phase<pg8::EpiMerge, pg8::SchedMerge, true>(lds, tid, 512, 1024, S, E);
        }
        SEAM(pb + 5);

        if (EN(6) && IN(pb + 6)) for (int rep_ = 0; rep_ < REPS_6; ++rep_) { PHASE_BEGIN
            pg8::SchedPlain S; S.o.init(NTOK / 256, DM / 256, G, bx); S.A = (const char*)MG; S.Bt = (const char*)(Wb + W_WO); S.lda2 = 2048; S.ldb2 = 2048;
            pg8::EpiWo E{Y, XB};
            pg8::gemm_phase<pg8::EpiWo, pg8::SchedPlain, true>(lds, tid, 1024, 2048, S, E);
        }
        SEAM(pb + 6);

        if (EN(7) && IN(pb + 7)) { PHASE_BEGIN
            LAS float* WrT = (LAS float*)lds;
            LAS float* LG = (LAS float*)(lds + 65536);
            for (int idx = tid; idx < 16384; idx += 512) { const int k = idx >> 4, e = idx & 15; WrT[e * 1024 + k] = args.in[18][idx]; }
            if (tid < 16) MISC[16 + tid] = 0u;
            __syncthreads();
            const float* g = args.in[16] + l * DM; const float* bb = args.in[17] + l * DM; const float* rb = args.in[19];
            const int rpb = (NTOK + G - 1) / G;
            const int r_lo = bx * rpb, r_hi = (r_lo + rpb < NTOK) ? r_lo + rpb : NTOK;
            const int b2_ = (lane >> 2) & 1, b3_ = (lane >> 3) & 1, b4_ = (lane >> 4) & 1;
            u32x2 ynx[4];
#pragma unroll
            for (int j = 0; j < 4; ++j) ynx[j] = (u32x2){0u, 0u};
            if (r_lo + wave < r_hi) {
#pragma unroll
                for (int j = 0; j < 4; ++j) ynx[j] = *(const u32x2*)(Y + (size_t)(r_lo + wave) * DM + 256 * j + 4 * lane); }
            for (int m = r_lo + wave; m < r_hi; m += 8) {
                f32x4 v[4]; float s = 0.f;
#pragma unroll
                for (int j = 0; j < 4; ++j) { const u32x2 w = ynx[j]; v[j] = (f32x4){bflo(w.x), bfhi(w.x), bflo(w.y), bfhi(w.y)}; s += (v[j].x + v[j].y) + (v[j].z + v[j].w); }
                if (m + 8 < r_hi) {
#pragma unroll
                    for (int j = 0; j < 4; ++j) ynx[j] = *(const u32x2*)(Y + (size_t)(m + 8) * DM + 256 * j + 4 * lane); }
                const float mean = wave_sum(s) * (1.f / DM); float s2 = 0.f;
#pragma unroll
                for (int j = 0; j < 4; ++j) { v[j] = v[j] - mean; s2 += (v[j].x * v[j].x + v[j].y * v[j].y) + (v[j].z * v[j].z + v[j].w * v[j].w); }
                const float rstd = 1.f / sqrtf(wave_sum(s2) * (1.f / DM) + EPS);
#pragma unroll
                for (int j = 0; j < 4; ++j) { v[j] = v[j] * rstd * *(const f32x4*)(g + 256 * j + 4 * lane) + *(const f32x4*)(bb + 256 * j + 4 * lane);
                    *(u32x2*)(XB + (size_t)m * DM + 256 * j + 4 * lane) = (u32x2){pk2(v[j].x, v[j].y), pk2(v[j].z, v[j].w)}; }
                float pa[16];
#pragma unroll
                for (int e = 0; e < 16; ++e) { float a = 0.f;
#pragma unroll
                    for (int j = 0; j < 4; ++j) { const f32x4 w = *(const LAS f32x4*)(WrT + e * 1024 + 256 * j + 4 * lane); a += (v[j].x * w.x + v[j].y * w.y) + (v[j].z * w.z + v[j].w * w.w); }
                    pa[e] = a; }
                float pb8[8], pc4[4], pd2[2];
#pragma unroll
                for (int e = 0; e < 8; ++e) { auto rr = __builtin_amdgcn_permlane32_swap(__float_as_uint(pa[e]), __float_as_uint(pa[e + 8]), false, false); pb8[e] = __uint_as_float(rr[0]) + __uint_as_float(rr[1]); }
#pragma unroll
                for (int e = 0; e < 4; ++e) { const float snd = b4_ ? pb8[e] : pb8[e + 4], kp = b4_ ? pb8[e + 4] : pb8[e]; pc4[e] = kp + swz_xor<16>(snd); }
#pragma unroll
                for (int e = 0; e < 2; ++e) { const float snd = b3_ ? pc4[e] : pc4[e + 2], kp = b3_ ? pc4[e + 2] : pc4[e]; pd2[e] = kp + swz_xor<8>(snd); }
                float pf1; { const float snd = b2_ ? pd2[0] : pd2[1], kp = b2_ ? pd2[1] : pd2[0]; pf1 = kp + swz_xor<4>(snd); }
                pf1 += swz_xor<2>(pf1); pf1 += swz_xor<1>(pf1);
                if ((lane & 3) == 0) LG[(m - r_lo) * 16 + b2_ + 2 * b3_ + 4 * b4_ + 8 * (lane >> 5)] = pf1;
            }
            __syncthreads();
            if (tid < r_hi - r_lo) {
                float lg[16];
#pragma unroll
                for (int q = 0; q < 4; ++q) { const f32x4 t4 = *(const LAS f32x4*)(LG + tid * 16 + 4 * q); lg[4 * q] = t4.x; lg[4 * q + 1] = t4.y; lg[4 * q + 2] = t4.z; lg[4 * q + 3] = t4.w; }
                float sc[16], bi[16];
#pragma unroll
                for (int e = 0; e < 16; ++e) { sc[e] = 1.0f / (1.0f + expf(-lg[e])); bi[e] = sc[e] + rb[e]; }
                float gs[4]; int i1g[4], i2g[4];
#pragma unroll
                for (int q = 0; q < 4; ++q) { const float a = bi[4 * q], b = bi[4 * q + 1], c = bi[4 * q + 2], d = bi[4 * q + 3];
                    float best = a; int i1 = 0; if (b > best) { best = b; i1 = 1; } if (c > best) { best = c; i1 = 2; } if (d > best) { best = d; i1 = 3; }
                    float b2 = -1e30f; int i2 = 0;
                    if (i1 != 0 && a > b2) { b2 = a; i2 = 0; } if (i1 != 1 && b > b2) { b2 = b; i2 = 1; } if (i1 != 2 && c > b2) { b2 = c; i2 = 2; } if (i1 != 3 && d > b2) { b2 = d; i2 = 3; }
                    gs[q] = best + b2; i1g[q] = i1; i2g[q] = i2; }
                int sel = 0; float bg = gs[0];
#pragma unroll
                for (int q = 1; q < 4; ++q) if (gs[q] > bg) { bg = gs[q]; sel = q; }
                int i1 = i1g[0], i2 = i2g[0];
#pragma unroll
                for (int q = 1; q < 4; ++q) if (sel == q) { i1 = i1g[q]; i2 = i2g[q]; }
                const int e0 = sel * 4 + i1, e1 = sel * 4 + i2; float s0 = 0.f, s1 = 0.f;
#pragma unroll
                for (int e = 0; e < 16; ++e) { s0 = (e == e0) ? sc[e] : s0; s1 = (e == e1) ? sc[e] : s1; }
                const float w0 = s0 / (s0 + s1), w1 = s1 / (s0 + s1);
                const unsigned lp0 = atomicAdd((unsigned*)(MISC + 16 + e0), 1u), lp1 = atomicAdd((unsigned*)(MISC + 16 + e1), 1u);
                volatile LAS unsigned* ri = MISC + 128 + tid * 8; ri[0] = (unsigned)e0; ri[1] = lp0; ri[2] = (unsigned)e1; ri[3] = lp1; ri[4] = __float_as_uint(w0); ri[5] = __float_as_uint(w1);
            }
            __syncthreads();
            if (tid < 16) MISC[32 + tid] = __hip_atomic_fetch_add(ctl + CW_GCNT + (l * 16 + tid) * 64, MISC[16 + tid], __ATOMIC_RELAXED, __HIP_MEMORY_SCOPE_AGENT);
            __syncthreads();
            if (tid < r_hi - r_lo) { volatile LAS unsigned* ri = MISC + 128 + tid * 8; const int m = r_lo + tid;
                const unsigned e0 = ri[0], e1 = ri[2]; const unsigned p0 = MISC[32 + e0] + ri[1], p1 = MISC[32 + e1] + ri[3];
                LIST[e0 * LIST_CAP + p0] = m; LIST[e1 * LIST_CAP + p1] = m;
                *(u32x4*)(ROUTE + (size_t)m * 8) = (u32x4){e0, p0, e1, p1}; *(u32x2*)(ROUTE + (size_t)m * 8 + 4) = (u32x2){ri[4], ri[5]}; }
            __syncthreads();
        }
        SEAM(pb + 7);

        if (IN(pb + 8) || IN(pb + 9) || IN(pb + 10)) { PHASE_BEGIN
            if (tid == 0) { int ps = 0;
                for (int e = 0; e < 16; ++e) { const int c = (int)__hip_atomic_load(ctl + CW_GCNT + (l * 16 + e) * 64, __ATOMIC_RELAXED, __HIP_MEMORY_SCOPE_AGENT); MISC[64 + e] = (unsigned)ps; MISC[96 + e] = (unsigned)c; ps += (c + 255) >> 8; }
                MISC[80] = (unsigned)ps; }
            __syncthreads();
        }
        if (EN(8) && IN(pb + 8)) for (int rep_ = 0; rep_ < REPS_8; ++rep_) { PHASE_BEGIN
            pg8::SchedMoe<true> S; S.total_panels = (int)MISC[80]; S.G = G; S.c = bx; S.tab = (const volatile LAS int*)(MISC + 64); S.list = LIST; S.A = (const char*)XB; S.W = (const char*)(Wb + W_WGU);
            S.lda2 = 2048; S.wstride = (size_t)1024 * 1024 * 2; S.ldb2 = 2048;
            pg8::EpiMoeUp E{HID};
            pg8::gemm_phase<pg8::EpiMoeUp, pg8::SchedMoe<true>, true>(lds, tid, 1024, 2048, S, E);
        }
        SEAM(pb + 8);

        if (EN(9) && IN(pb + 9)) for (int rep_ = 0; rep_ < REPS_9; ++rep_) { PHASE_BEGIN
            pg8::SchedMoe<false> S; S.total_panels = (int)MISC[80]; S.G = G; S.c = bx; S.tab = (const volatile LAS int*)(MISC + 64); S.list = LIST; S.A = (const char*)HID; S.W = (const char*)(Wb + W_WD);
            S.lda2 = 1024; S.wstride = (size_t)1024 * 512 * 2; S.ldb2 = 1024;
            pg8::EpiBf16 E{PAIR, DM, nullptr};
            pg8::gemm_phase<pg8::EpiBf16, pg8::SchedMoe<false>, true>(lds, tid, 512, 1024, S, E);
        }
        SEAM(pb + 9);

        if (EN(10) && IN(pb + 10)) { PHASE_BEGIN
            const float* g = args.in[23] + l * DM; const float* bb = args.in[24] + l * DM;
            f32x4 gv[4], bv[4];
#pragma unroll
            for (int j = 0; j < 4; ++j) { gv[j] = *(const f32x4*)(g + 256 * j + 4 * lane); bv[j] = *(const f32x4*)(bb + 256 * j + 4 * lane); }
            for (int m0 = gw; m0 < NTOK; m0 += 4 * NGW) {
                u32x4 r4[4]; u32x2 w2[4];
#pragma unroll
                for (int q = 0; q < 4; ++q) { const int m = m0 + q * NGW < NTOK ? m0 + q * NGW : m0; r4[q] = *(const u32x4*)(ROUTE + (size_t)m * 8); w2[q] = *(const u32x2*)(ROUTE + (size_t)m * 8 + 4); }
                u32x2 xw[4][4], pa[4][4], pq[4][4];
#pragma unroll
                for (int q = 0; q < 4; ++q) { const int m = m0 + q * NGW < NTOK ? m0 + q * NGW : m0;
                    const size_t s0 = (size_t)MISC[64 + r4[q].x] * 256 + r4[q].y, s1 = (size_t)MISC[64 + r4[q].z] * 256 + r4[q].w;
#pragma unroll
                    for (int j = 0; j < 4; ++j) { xw[q][j] = *(const u32x2*)(XB + (size_t)m * DM + 256 * j + 4 * lane); pa[q][j] = *(const u32x2*)(PAIR + s0 * DM + 256 * j + 4 * lane); pq[q][j] = *(const u32x2*)(PAIR + s1 * DM + 256 * j + 4 * lane); } }
#pragma unroll
                for (int q = 0; q < 4; ++q) { const int m = m0 + q * NGW; if (m < NTOK) {
                    const float w0 = __uint_as_float(w2[q].x), w1 = __uint_as_float(w2[q].y);
                    f32x4 v[4]; float s = 0.f;
#pragma unroll
                    for (int j = 0; j < 4; ++j) {
                        v[j].x = ALPHA * bflo(xw[q][j].x) + w0 * bflo(pa[q][j].x) + w1 * bflo(pq[q][j].x); v[j].y = ALPHA * bfhi(xw[q][j].x) + w0 * bfhi(pa[q][j].x) + w1 * bfhi(pq[q][j].x);
                        v[j].z = ALPHA * bflo(xw[q][j].y) + w0 * bflo(pa[q][j].y) + w1 * bflo(pq[q][j].y); v[j].w = ALPHA * bfhi(xw[q][j].y) + w0 * bfhi(pa[q][j].y) + w1 * bfhi(pq[q][j].y);
                        s += (v[j].x + v[j].y) + (v[j].z + v[j].w); }
                    const float mean = wave_sum(s) * (1.f / DM); float s2 = 0.f;
#pragma unroll
                    for (int j = 0; j < 4; ++j) { v[j] = v[j] - mean; s2 += (v[j].x * v[j].x + v[j].y * v[j].y) + (v[j].z * v[j].z + v[j].w * v[j].w); }
                    const float rstd = 1.f / sqrtf(wave_sum(s2) * (1.f / DM) + EPS);
#pragma unroll
                    for (int j = 0; j < 4; ++j) { const f32x4 o = v[j] * rstd * gv[j] + bv[j];
                        if (l == DEPTH - 1) *(f32x4*)((float*)outb + (size_t)m * DM + 256 * j + 4 * lane) = o;
                        else *(u32x2*)(XB + (size_t)m * DM + 256 * j + 4 * lane) = (u32x2){pk2(o.x, o.y), pk2(o.z, o.w)}; } } }
            }
        }
        SEAM(pb + 10);
    }
#undef IN
#undef SEAM
}

extern "C" void kernel_launch(void* const* d_in, const int* in_sizes, int n_in, void* d_out, int out_size, void* d_ws, size_t ws_size, hipStream_t stream) {
    static int grid = 0;
    if (grid == 0) {
        if (n_in != 25 || out_size != NTOK * DM || ws_size < WS_END) { fprintf(stderr, "kernel_launch: unexpected shapes (n_in %d, out %d, ws %zu)\n", n_in, out_size, ws_size); grid = -1; return; }
        int dev = 0, cus = 0, per_cu = 0;
        if (hipGetDevice(&dev) != hipSuccess || hipDeviceGetAttribute(&cus, hipDeviceAttributeMultiprocessorCount, dev) != hipSuccess) { grid = -1; return; }
        if (hipFuncSetAttribute((const void*)fwd_kernel, hipFuncAttributeMaxDynamicSharedMemorySize, LDS_BYTES) != hipSuccess) { fprintf(stderr, "kernel_launch: hipFuncSetAttribute failed\n"); grid = -1; return; }
        if (hipOccupancyMaxActiveBlocksPerMultiprocessor(&per_cu, (const void*)fwd_kernel, 512, LDS_BYTES) != hipSuccess || per_cu < 1) fprintf(stderr, "kernel_launch: occupancy query reports %d\n", per_cu);
        (void)hipGetLastError();
        grid = cus;
    }
    if (grid < 0) return;
    (void)hipMemsetAsync((char*)d_ws + WS_CTL, 0, CTL_ZERO_BYTES, stream);
    Args a{};
    for (int i = 0; i < 25; ++i) a.in[i] = (const float*)d_in[i];
    a.out = (float*)d_out; a.ws = (unsigned char*)d_ws;
#if ONE_LAUNCH
    a.ph_lo = 0; a.ph_hi = NPH;
    hipLaunchKernelGGL(fwd_kernel, dim3(grid), dim3(512), LDS_BYTES, stream, a);
#else
    for (int p = 0; p < NPH; ++p) { a.ph_lo = p; a.ph_hi = p + 1; hipLaunchKernelGGL(fwd_kernel, dim3(grid), dim3(512), LDS_BYTES, stream, a); }
#endif
}
```

```cpp
#include <hip/hip_runtime.h>
#include <cstdio>
#include <cstdint>

#ifndef PHMASK
#define PHMASK 0xFFF
#endif
#define EN(k) (((PHMASK) >> (k)) & 1)
#ifndef REPS_0
#define REPS_0 1
#endif
#ifndef REPS_1
#define REPS_1 1
#endif
#ifndef REPS_3
#define REPS_3 1
#endif
#ifndef REPS_4C
#define REPS_4C 1
#endif
#ifndef REPS_5
#define REPS_5 1
#endif
#ifndef REPS_6
#define REPS_6 1
#endif
#ifndef REPS_8
#define REPS_8 1
#endif
#ifndef REPS_9
#define REPS_9 1
#endif
#ifndef ATTN_FAST
#define ATTN_FAST 7
#endif
#ifndef ONE_LAUNCH
#define ONE_LAUNCH 1
#endif

#define GAS __attribute__((address_space(1)))
#define LAS __attribute__((address_space(3)))
typedef unsigned short bf16;
typedef short bf16x8 __attribute__((ext_vector_type(8)));
typedef float f32x4 __attribute__((ext_vector_type(4)));
typedef float f32x2 __attribute__((ext_vector_type(2)));
typedef unsigned u32x4 __attribute__((ext_vector_type(4)));
typedef unsigned u32x2 __attribute__((ext_vector_type(2)));
#define DI __device__ __forceinline__

constexpr int NTOK = 32768, DM = 1024, SEQ = 2048, NBATCH = 16, DEPTH = 2;
constexpr int P1W = 2304, GW = 3072, INW = 5376, QCW = 768, KVW = 1024, INCOLS = 5280;
constexpr int NEXP = 16, DFF = 512, SLOT_ROWS = 69632, LIST_CAP = 32768;
constexpr float EPS = 1e-6f, ALPHA = 1.4142135623730951f, LOG2E = 1.4426950408889634f;
constexpr float C2_64 = 0.125f * LOG2E;
constexpr float C2_96 = 0.10206207261596577f * LOG2E;
constexpr int C_QA = 0, C_KA = 512, C_VA = 640, C_QB = 768, C_KB = 1280, C_VB = 1408, C_CQ = 1536, C_CKV = 1920, C_KR = 2176;

constexpr size_t MiB = 1u << 20;
constexpr size_t WS_CTL = 0, CTL_ZERO_BYTES = 1 * MiB;
constexpr size_t WS_ROPE = 1 * MiB;
constexpr size_t WS_TB = WS_ROPE + 2048 * 16 * 8;
constexpr size_t WS_RSTDQ = WS_TB + 8 * 260 * 4 + 1728;
constexpr size_t WS_RSTDKV = WS_RSTDQ + NTOK * 4;
constexpr size_t WS_LIST = 2 * MiB;
constexpr size_t WS_ROUTE = 4 * MiB;
constexpr size_t WS_W = 8 * MiB;
constexpr size_t W_WIN = 0, W_WUQ = 11010048, W_WUKV = 11599872, W_WBR = 12124160, W_WO = 15269888, W_WGU = 17367040, W_WD = 50921472, W_WUP = 67698688, W_END = 71368704;
constexpr size_t WS_XB = 77 * MiB;
constexpr size_t WS_P1 = 141 * MiB;
constexpr size_t WS_G = 285 * MiB;
constexpr size_t WS_END = 477 * MiB;
static_assert(WS_W + W_END <= WS_XB && WS_RSTDKV + NTOK * 4 <= WS_LIST, "ws map");
static_assert((size_t)SLOT_ROWS * 1024 * 2 <= WS_END - WS_G && (size_t)SLOT_ROWS * 512 * 2 <= WS_G - WS_P1, "ws map 2");
constexpr size_t DO_QC = 0, DO_KVC = 48 * MiB;
constexpr int CW_BAR = 4096;
constexpr int CW_GCNT = 16384;

constexpr int RING_BYTES = 131072, LDSCTL_OFF = RING_BYTES, LDS_BYTES = 147456;

DI float bf2f(unsigned short h) { return __builtin_bit_cast(float, (unsigned)h << 16); }
DI float bflo(unsigned w) { return __builtin_bit_cast(float, w << 16); }
DI float bfhi(unsigned w) { return __builtin_bit_cast(float, w & 0xffff0000u); }
DI unsigned f2bf(float f) { unsigned u = __builtin_bit_cast(unsigned, f); return (u + 0x7fffu + ((u >> 16) & 1u)) >> 16; }
DI unsigned pk2(float lo, float hi) { return f2bf(lo) | (f2bf(hi) << 16); }
DI unsigned cvt_pk_bf16(float lo, float hi) { unsigned r; asm volatile("v_cvt_pk_bf16_f32 %0, %1, %2" : "=v"(r) : "v"(lo), "v"(hi)); return r; }
typedef __bf16 bf16x2_t __attribute__((ext_vector_type(2)));
DI unsigned cvtpk(float lo, float hi) { const f32x2 v = {lo, hi}; const bf16x2_t bb = __builtin_convertvector(v, bf16x2_t); return __builtin_bit_cast(unsigned, bb); }
DI float fsigmoid(float x) { return __builtin_amdgcn_rcpf(1.0f + __builtin_amdgcn_exp2f(-x * LOG2E)); }
template <int M> DI float swz_xor(float v) { return __builtin_bit_cast(float, __builtin_amdgcn_ds_swizzle(__builtin_bit_cast(int, v), (M << 10) | 0x1F)); }
DI float xhalf_sum(float v) { auto rr = __builtin_amdgcn_permlane32_swap(__float_as_uint(v), __float_as_uint(v), false, false); return __uint_as_float(rr[0]) + __uint_as_float(rr[1]); }
DI float sum32(float v) { v += swz_xor<1>(v); v += swz_xor<2>(v); v += swz_xor<4>(v); v += swz_xor<8>(v); v += swz_xor<16>(v); return v; }
DI float wave_sum(float v) { return xhalf_sum(sum32(v)); }
#define LDS_WAIT() asm volatile("s_waitcnt lgkmcnt(0)" ::: "memory")
#define VM_WAIT() asm volatile("s_waitcnt vmcnt(0)" ::: "memory")

namespace pg8 {
constexpr int BM = 256, BK = 64, HALF = 128, HTB = HALF * BK * 2, STAGE_BYTES = 8 * HTB, NXCD = 8, WGM = 8;
DI int lds_byte(int r, int c) { const int st = (r >> 4) * 2 + (c >> 5), rr = r & 15, cc = c & 31, ob = rr * 64 + cc * 2; return st * 1024 + (ob ^ (((ob >> 9) & 1) << 5)); }
DI void stage_rc(int b, int& R, int& C) { const int st = b / 1024, sb = b % 1024, swz = sb ^ (((sb >> 9) & 1) << 5); R = (st >> 1) * 16 + swz / 64; C = (st & 1) * 32 + (swz % 64) / 2; }
DI int perm32(int rho) { const int n = rho >> 4, i = rho & 15; return 8 * (i >> 2) + 4 * n + (i & 3); }

struct Unit { int pm, pn, e, aux; };
struct TileOrder {
    int nM, nN, nwg, G, c;
    DI void init(int nM_, int nN_, int G_, int c_) { nM = nM_; nN = nN_; nwg = nM * nN; G = G_; c = c_; }
    DI bool tile(int i, int& pm, int& pn) const {
        const long L = (long)i * G + c; if (L >= nwg) return false;
        int wgid = (int)L; { const int q = nwg / NXCD, r = nwg % NXCD, xcd = wgid % NXCD, off = wgid / NXCD; wgid = (xcd < r ? xcd * (q + 1) : r * (q + 1) + (xcd - r) * q) + off; }
        const int nig = WGM * nN, gid = wgid / nig, fm = gid * WGM, gsz = (nM - fm) < WGM ? (nM - fm) : WGM;
        pm = fm + ((wgid % nig) % gsz); pn = (wgid % nig) / gsz; return true;
    }
};

template <class Epi, class Sched, bool ALIGN_EPI>
DI void gemm_phase(LAS unsigned char* lds, const int tid, const int K, const unsigned ldb2, const Sched& S, const Epi& E) {
    const int wid = __builtin_amdgcn_readfirstlane(tid >> 6), lane = tid & 63, wr = wid >> 2, wc = wid & 3, fr = lane & 15, fq = lane >> 4;
    int nt = K / BK;
    int Rr[2], Cc[2]; unsigned voffA[2], voffB[2];
    const unsigned lda2 = S.lda2;
#pragma unroll
    for (int i = 0; i < 2; ++i) { int R, C; stage_rc(tid * 16 + i * 8192, R, C); const int Rb = Epi::PERM ? ((R & ~31) + perm32(R & 31)) : R;
        Rr[i] = R; Cc[i] = C * 2; voffA[i] = (unsigned)R * lda2 + (unsigned)C * 2u; voffB[i] = (unsigned)Rb * ldb2 + (unsigned)C * 2u; }
    const size_t kstep = (size_t)(BK * 2);
    const size_t hstepB = (size_t)HALF * ldb2, hstepA = (size_t)HALF * lda2;
    const unsigned ldsw = (unsigned)wid * 1024u;
    const int aoff = lds_byte(wr * 64 + fr, fq * 8), boff = lds_byte(wc * 32 + fr, fq * 8);
#define PG8_SA(b, h) (((b) * 2 + (h)) * HTB)
#define PG8_SB(b, h) ((4 + (b) * 2 + (h)) * HTB)
#define PG8_STAGE(bufoff, gbase, voff) do { _Pragma("unroll") for (int _i = 0; _i < 2; ++_i) \
        __builtin_amdgcn_global_load_lds((const unsigned*)((const char*)(gbase) + (voff)[_i]), (LAS unsigned*)(lds + (bufoff) + ldsw + _i * 8192), 16, 0, 0); } while (0)
#define PG8_STAGE_A(bufoff, gbase, h, g0, g1) do { if constexpr (Sched::GATHER) { if ((h) == 0) PG8_STAGE(bufoff, gbase, g0); else PG8_STAGE(bufoff, gbase, g1); } \
        else { PG8_STAGE(bufoff, (gbase) + (h) * hstepA, voffA); } } while (0)
#define PG8_LDA(dst, b, h) do { _Pragma("unroll") for (int m = 0; m < 4; ++m) _Pragma("unroll") for (int k = 0; k < 2; ++k) dst[m][k] = *(const LAS bf16x8*)(lds + PG8_SA(b, h) + aoff + m * 2048 + k * 1024); } while (0)
#define PG8_LDB(dst, b, h) do { _Pragma("unroll") for (int n = 0; n < 2; ++n) _Pragma("unroll") for (int k = 0; k < 2; ++k) dst[n][k] = *(const LAS bf16x8*)(lds + PG8_SB(b, h) + boff + n * 2048 + k * 1024); } while (0)
#define PG8_MMA(ai, bj, At, Bt) do { __builtin_amdgcn_s_setprio(1); _Pragma("unroll") for (int m = 0; m < 4; ++m) _Pragma("unroll") for (int n = 0; n < 2; ++n) _Pragma("unroll") for (int k = 0; k < 2; ++k) \
        acc[ai][bj][m][n] = __builtin_amdgcn_mfma_f32_16x16x32_bf16(Bt[n][k], At[m][k], acc[ai][bj][m][n], 0, 0, 0); __builtin_amdgcn_s_setprio(0); } while (0)
#define PG8_WAIT_V(n) asm volatile("s_waitcnt vmcnt(" #n ")" ::: "memory")
#define PG8_WAIT_L(n) asm volatile("s_waitcnt lgkmcnt(" #n ")" ::: "memory")
#define PG8_BAR __builtin_amdgcn_s_barrier()
#define PG8_SCHED __builtin_amdgcn_sched_barrier(0)
    Unit cur, nxt; int ui = 0;
    if (!S.next(0, cur)) return;
    f32x4 acc[2][2][4][2];
    float zf = 0.f; asm volatile("" : "+v"(zf));
#pragma unroll
    for (int a = 0; a < 2; ++a)
#pragma unroll
        for (int b = 0; b < 2; ++b)
#pragma unroll
            for (int m = 0; m < 4; ++m)
#pragma unroll
                for (int n = 0; n < 2; ++n) acc[a][b][m][n] = (f32x4){zf, zf, zf, zf};
    bf16x8 At[4][2], B0[2][2], B1[2][2];
    unsigned ao0[2] = {0u, 0u}, ao1[2] = {0u, 0u}, no0[2] = {0u, 0u}, no1[2] = {0u, 0u};
    if constexpr (Sched::GATHER) {
#pragma unroll
        for (int i = 0; i < 2; ++i) { ao0[i] = S.a_off(cur, Rr[i]) + Cc[i]; ao1[i] = S.a_off(cur, HALF + Rr[i]) + Cc[i]; } }
    const char* cA = S.a_base(cur); const char* cB = S.b_base(cur); nt = S.ktiles(cur, nt);
    PG8_STAGE(PG8_SB(0, 0), cB, voffB); PG8_STAGE(PG8_SB(0, 1), cB + hstepB, voffB); PG8_STAGE_A(PG8_SA(0, 0), cA, 0, ao0, ao1); PG8_STAGE_A(PG8_SA(0, 1), cA, 1, ao0, ao1);
    if (wr == 1) PG8_BAR;
    PG8_WAIT_V(2); PG8_BAR;
    PG8_STAGE(PG8_SB(1, 0), cB + kstep, voffB); PG8_STAGE_A(PG8_SA(1, 0), cA + kstep, 0, ao0, ao1); PG8_STAGE(PG8_SB(1, 1), cB + hstepB + kstep, voffB);
    PG8_WAIT_V(6); PG8_BAR;
    for (;;) {
        const bool has_next = S.next(ui + 1, nxt);
        const char* nA = cA; const char* nB = cB;
        if constexpr (Sched::GATHER) {
#pragma unroll
            for (int i = 0; i < 2; ++i) { no0[i] = ao0[i]; no1[i] = ao1[i]; } }
        if (has_next) { nA = S.a_base(nxt); nB = S.b_base(nxt);
            if constexpr (Sched::GATHER) {
#pragma unroll
                for (int i = 0; i < 2; ++i) { no0[i] = S.a_off(nxt, Rr[i]) + Cc[i]; no1[i] = S.a_off(nxt, HALF + Rr[i]) + Cc[i]; } } }
#pragma unroll 1
        for (int t = 0; t < nt; t += 2) {
            const bool last = (t == nt - 2);
            const char* a1 = cA + (size_t)(t + 1) * kstep;
            const char* a2 = last ? nA : cA + (size_t)(t + 2) * kstep; const char* b2 = last ? nB : cB + (size_t)(t + 2) * kstep;
            const char* a3 = a2 + kstep; const char* b3 = b2 + kstep;
            unsigned x0[2] = {0u, 0u}, x1[2] = {0u, 0u};
            if constexpr (Sched::GATHER) {
#pragma unroll
                for (int i = 0; i < 2; ++i) { x0[i] = last ? no0[i] : ao0[i]; x1[i] = last ? no1[i] : ao1[i]; } }
            PG8_LDB(B0, 0, 0); PG8_LDB(B1, 0, 1); PG8_SCHED; PG8_LDA(At, 0, 0); PG8_STAGE_A(PG8_SA(1, 1), a1, 1, ao0, ao1);
            PG8_WAIT_V(8); PG8_WAIT_L(0); PG8_BAR; PG8_MMA(0, 0, At, B0); PG8_MMA(0, 1, At, B1); PG8_BAR; PG8_SCHED;
            PG8_LDA(At, 0, 1); PG8_STAGE(PG8_SB(0, 0), b2, voffB); PG8_STAGE(PG8_SB(0, 1), b2 + hstepB, voffB); PG8_STAGE_A(PG8_SA(0, 0), a2, 0, x0, x1);
            PG8_WAIT_V(8); PG8_WAIT_L(0); PG8_BAR; PG8_MMA(1, 0, At, B0); PG8_MMA(1, 1, At, B1); PG8_BAR; PG8_SCHED;
            PG8_LDB(B0, 1, 0); PG8_LDB(B1, 1, 1); PG8_SCHED; PG8_LDA(At, 1, 0); PG8_STAGE_A(PG8_SA(0, 1), a2, 1, x0, x1);
            PG8_WAIT_V(8); PG8_WAIT_L(0); PG8_BAR; PG8_MMA(0, 0, At, B0); PG8_MMA(0, 1, At, B1); PG8_BAR; PG8_SCHED;
            PG8_LDA(At, 1, 1); PG8_STAGE(PG8_SB(1, 0), b3, voffB); PG8_STAGE(PG8_SB(1, 1), b3 + hstepB, voffB); PG8_STAGE_A(PG8_SA(1, 0), a3, 0, x0, x1);
            PG8_WAIT_V(8); PG8_WAIT_L(0); PG8_BAR; PG8_MMA(1, 0, At, B0); PG8_MMA(1, 1, At, B1); PG8_BAR; PG8_SCHED;
        }
        if constexpr (ALIGN_EPI) { if (wr == 0) PG8_BAR; }
        bool keep = false;
        if constexpr (Sched::KEEP) keep = S.keep_acc(cur);
        if constexpr (Sched::KEEP) { if (keep) E.mid(acc, cur, wr, wc, fr, fq); else E(acc, cur, wr, wc, fr, fq); } else { E(acc, cur, wr, wc, fr, fq); }
        if (!has_next) break;
        if (!keep) {
#pragma unroll
        for (int a = 0; a < 2; ++a)
#pragma unroll
            for (int b = 0; b < 2; ++b)
#pragma unroll
                for (int m = 0; m < 4; ++m)
#pragma unroll
                    for (int n = 0; n < 2; ++n) acc[a][b][m][n] = (f32x4){zf, zf, zf, zf};
        }
        cur = nxt; cA = nA; cB = nB; ++ui; nt = S.ktiles(cur, nt);
        if constexpr (Sched::GATHER) {
#pragma unroll
            for (int i = 0; i < 2; ++i) { ao0[i] = no0[i]; ao1[i] = no1[i]; } }
        if constexpr (ALIGN_EPI) { if (wr == 1) PG8_BAR; }
    }
    PG8_WAIT_V(0);
    if constexpr (!ALIGN_EPI) { if (wr == 0) PG8_BAR; }
    PG8_BAR;
#undef PG8_SA
#undef PG8_SB
#undef PG8_STAGE
#undef PG8_STAGE_A
#undef PG8_LDA
#undef PG8_LDB
#undef PG8_MMA
#undef PG8_WAIT_V
#undef PG8_WAIT_L
#undef PG8_BAR
#undef PG8_SCHED
}

struct SchedPlain {
    static constexpr bool GATHER = false, KEEP = false;
    TileOrder o; const char* A; const char* Bt; unsigned lda2, ldb2;
    DI bool next(int i, Unit& u) const { u.e = 0; u.aux = 0; return o.tile(i, u.pm, u.pn); }
    DI const char* a_base(const Unit& u) const { return A + (size_t)u.pm * BM * lda2; }
    DI unsigned a_off(const Unit&, int) const { return 0u; }
    DI int ktiles(const Unit&, int d) const { return d; }
    DI const char* b_base(const Unit& u) const { return Bt + (size_t)u.pn * BM * ldb2; }
};
struct SchedMerge {
    static constexpr bool GATHER = false, KEEP = true;
    TileOrder o; const char* P1; const char* Wbr; unsigned lda2;
    DI bool next(int i, Unit& u) const { u.e = i % 3; u.aux = 0; return o.tile(i / 3, u.pm, u.pn); }
    DI bool keep_acc(const Unit& u) const { return u.e < 2; }
    DI const char* a_base(const Unit& u) const { return P1 + (size_t)u.e * (768 * 2) + (size_t)u.pm * BM * lda2; }
    DI unsigned a_off(const Unit&, int) const { return 0u; }
    DI int ktiles(const Unit&, int d) const { return d; }
    DI const char* b_base(const Unit& u) const { return Wbr + (size_t)u.e * (1024 * 512 * 2) + (size_t)u.pn * BM * 1024; }
};
struct SchedUp {
    static constexpr bool GATHER = true, KEEP = false;
    int G, c; const char* wsb; unsigned lda2;
    DI void qunit(int i, Unit& u) const { u.e = 0; u.pm = i / 3; u.pn = i % 3; }
    DI void kvunit(int i, Unit& u) const { u.e = 1; u.pm = i >> 2; u.pn = 3 + (i & 3); }
    DI bool next(int i, Unit& u) const {
        u.aux = 0;
        if (G == 256) {
            if (c < 128) { if (i == 0) { u.e = 2; u.pm = c; u.pn = 7; return true; } if (i == 1) { qunit(c, u); return true; } if (i == 2) { kvunit(c, u); return true; } return false; }
            const int d = c - 128; if (i < 2) { qunit(128 + 2 * d + i, u); return true; } if (i < 5) { kvunit(128 + 3 * d + (i - 2), u); return true; } return false;
        }
        const int L = i * G + c; if (L >= 1024) return false;
        if (L < 128) { u.e = 2; u.pm = L; u.pn = 7; } else if (L < 512) qunit(L - 128, u); else kvunit(L - 512, u);
        return true;
    }
    DI const char* a_base(const Unit& u) const { const size_t off = u.e == 2 ? WS_XB + (size_t)u.pm * BM * 2048 : WS_P1 + (size_t)(u.e ? C_CKV * 2 : C_CQ * 2) + (size_t)u.pm * BM * (P1W * 2); return wsb + off; }
    DI unsigned a_off(const Unit& u, int r) const { return (unsigned)r * (u.e == 2 ? 2048u : (unsigned)(P1W * 2)); }
    DI int ktiles(const Unit& u, int) const { return u.e == 2 ? 16 : (u.e ? 4 : 6); }
    DI const char* b_base(const Unit& u) const { const size_t off = u.e == 2 ? WS_W + W_WIN + (size_t)5120 * 2048 : WS_W + W_WUP + (size_t)u.pn * BM * 2048; return wsb + off; }
};
template <bool GATHER_> struct SchedMoe {
    static constexpr bool GATHER = GATHER_, KEEP = false;
    int total_panels, G, c; const volatile LAS int* tab; const int* list; const char* A; const char* W; unsigned lda2; size_t wstride; unsigned ldb2;
    DI bool next(int i, Unit& u) const {
        const int L = i * G + c; if (L >= total_panels * 4) return false;
        const int panel = L >> 2; u.pn = L & 3; u.pm = panel; int e = 0;
#pragma unroll
        for (int j = 1; j < 16; ++j) e += (panel >= tab[j]) ? 1 : 0;
        u.e = e; u.aux = (panel - tab[e]) * BM; return true;
    }
    DI const char* a_base(const Unit& u) const { return GATHER ? A : A + (size_t)u.pm * BM * lda2; }
    DI unsigned a_off(const Unit& u, int r) const {
        int pos = u.aux + r; const int cnt = tab[32 + u.e]; pos = pos < cnt ? pos : cnt - 1; return (unsigned)list[u.e * LIST_CAP + pos] * lda2;
    }
    DI int ktiles(const Unit&, int d) const { return d; }
    DI const char* b_base(const Unit& u) const { return W + (size_t)u.e * wstride + (size_t)u.pn * BM * ldb2; }
};

struct EpiInproj {
    static constexpr bool PERM = true;
    bf16* P1; bf16* G;
    DI void operator()(const f32x4 (&acc)[2][2][4][2], const Unit& u, int wr, int wc, int fr, int fq) const {
        const int row0 = u.pm * BM + wr * 64 + fr; const bool sig = u.pn >= 9;
        bf16* base = sig ? G : P1; const int ld = sig ? GW : P1W; const int col0 = (sig ? (u.pn - 9) : u.pn) * BM + wc * 32 + 8 * fq;
#pragma unroll
        for (int ai = 0; ai < 2; ++ai)
#pragma unroll
            for (int m = 0; m < 4; ++m) { bf16* rowp = base + (size_t)(row0 + ai * HALF + m * 16) * ld + col0;
#pragma unroll
                for (int bj = 0; bj < 2; ++bj) { f32x4 v0 = acc[ai][bj][m][0], v1 = acc[ai][bj][m][1];
                    if (sig) {
#pragma unroll
                        for (int j = 0; j < 4; ++j) { v0[j] = fsigmoid(v0[j]); v1[j] = fsigmoid(v1[j]); } }
                    u32x4 w; w.x = cvt_pk_bf16(v0[0], v0[1]); w.y = cvt_pk_bf16(v0[2], v0[3]); w.z = cvt_pk_bf16(v1[0], v1[1]); w.w = cvt_pk_bf16(v1[2], v1[3]);
                    *(u32x4*)(rowp + bj * HALF) = w; } }
    }
};
struct EpiBf16 {
    static constexpr bool PERM = true;
    bf16* O; int ldc; const float* rscale;
    DI void operator()(const f32x4 (&acc)[2][2][4][2], const Unit& u, int wr, int wc, int fr, int fq) const {
        const int row0 = u.pm * BM + wr * 64 + fr; const int col0 = u.pn * BM + wc * 32 + 8 * fq;
#pragma unroll
        for (int ai = 0; ai < 2; ++ai)
#pragma unroll
            for (int m = 0; m < 4; ++m) { const int row = row0 + ai * HALF + m * 16; bf16* rowp = O + (size_t)row * ldc + col0; const float s = rscale ? rscale[row] : 1.0f;
#pragma unroll
                for (int bj = 0; bj < 2; ++bj) { const f32x4 v0 = acc[ai][bj][m][0] * s, v1 = acc[ai][bj][m][1] * s;
                    u32x4 w; w.x = cvt_pk_bf16(v0[0], v0[1]); w.y = cvt_pk_bf16(v0[2], v0[3]); w.z = cvt_pk_bf16(v1[0], v1[1]); w.w = cvt_pk_bf16(v1[2], v1[3]);
                    *(u32x4*)(rowp + bj * HALF) = w; } }
    }
};
struct EpiUp {
    static constexpr bool PERM = true;
    bf16* QC; bf16* KVC; const float* rscale; bf16* G;
    DI void operator()(const f32x4 (&acc)[2][2][4][2], const Unit& u, int wr, int wc, int fr, int fq) const {
        const int row0 = u.pm * BM + wr * 64 + fr; const bool kv = u.e == 1, gt = u.e == 2;
        const int ld = gt ? GW : (kv ? KVW : QCW); const int col0 = (gt ? 11 : (kv ? (u.pn - 3) : u.pn)) * BM + wc * 32 + 8 * fq;
        const unsigned long long qi_ = (unsigned long long)QC, ki_ = (unsigned long long)KVC, gi_ = (unsigned long long)G;
        const unsigned long long bsel = qi_ + (unsigned long long)(kv ? 1 : 0) * (ki_ - qi_) + (unsigned long long)(gt ? 1 : 0) * (gi_ - qi_);
#pragma unroll
        for (int ai = 0; ai < 2; ++ai)
#pragma unroll
            for (int m = 0; m < 4; ++m) { const int row = row0 + ai * HALF + m * 16; const size_t eo = (size_t)row * ld + col0; const float s = kv ? rscale[row] : 1.0f;
#pragma unroll
                for (int bj = 0; bj < 2; ++bj) { f32x4 v0 = acc[ai][bj][m][0] * s, v1 = acc[ai][bj][m][1] * s;
                    if (gt) {
#pragma unroll
                        for (int j = 0; j < 4; ++j) { v0[j] = fsigmoid(v0[j]); v1[j] = fsigmoid(v1[j]); } }
                    u32x4 w; w.x = cvt_pk_bf16(v0[0], v0[1]); w.y = cvt_pk_bf16(v0[2], v0[3]); w.z = cvt_pk_bf16(v1[0], v1[1]); w.w = cvt_pk_bf16(v1[2], v1[3]);
                    *(GAS u32x4*)(bsel + (eo + bj * HALF) * 2) = w; } }
    }
};
struct EpiMerge {
    static constexpr bool PERM = true;
    bf16* MG; const bf16* G;
    DI void mid(f32x4 (&acc)[2][2][4][2], const Unit& u, int wr, int wc, int fr, int fq) const {
        const int row0 = u.pm * BM + wr * 64 + fr; const int col0 = u.pn * BM + wc * 32 + 8 * fq;
#pragma unroll
        for (int ai = 0; ai < 2; ++ai) {
            u32x4 ga[4][2], gb[4][2];
#pragma unroll
            for (int m = 0; m < 4; ++m) { const bf16* gp = G + (size_t)(row0 + ai * HALF + m * 16) * GW + u.e * DM + col0;
#pragma unroll
                for (int bj = 0; bj < 2; ++bj) { ga[m][bj] = *(const u32x4*)(gp + bj * HALF); gb[m][bj] = *(const u32x4*)(gp + DM + bj * HALF); } }
#pragma unroll
            for (int m = 0; m < 4; ++m)
#pragma unroll
                for (int bj = 0; bj < 2; ++bj) { const u32x4 a = ga[m][bj], b = gb[m][bj]; f32x4& a0 = acc[ai][bj][m][0]; f32x4& a1 = acc[ai][bj][m][1];
                    a0[0] *= bflo(a.x) * __builtin_amdgcn_rcpf(fmaxf(bflo(b.x), 1e-30f)); a0[1] *= bfhi(a.x) * __builtin_amdgcn_rcpf(fmaxf(bfhi(b.x), 1e-30f));
                    a0[2] *= bflo(a.y) * __builtin_amdgcn_rcpf(fmaxf(bflo(b.y), 1e-30f)); a0[3] *= bfhi(a.y) * __builtin_amdgcn_rcpf(fmaxf(bfhi(b.y), 1e-30f));
                    a1[0] *= bflo(a.z) * __builtin_amdgcn_rcpf(fmaxf(bflo(b.z), 1e-30f)); a1[1] *= bfhi(a.z) * __builtin_amdgcn_rcpf(fmaxf(bfhi(b.z), 1e-30f));
                    a1[2] *= bflo(a.w) * __builtin_amdgcn_rcpf(fmaxf(bflo(b.w), 1e-30f)); a1[3] *= bfhi(a.w) * __builtin_amdgcn_rcpf(fmaxf(bfhi(b.w), 1e-30f)); }
        }
    }
    DI void operator()(const f32x4 (&acc)[2][2][4][2], const Unit& u, int wr, int wc, int fr, int fq) const {
        const int row0 = u.pm * BM + wr * 64 + fr; const int col0 = u.pn * BM + wc * 32 + 8 * fq;
#pragma unroll
        for (int ai = 0; ai < 2; ++ai) {
            u32x4 gq[4][2];
#pragma unroll
            for (int m = 0; m < 4; ++m) { const bf16* gp = G + (size_t)(row0 + ai * HALF + m * 16) * GW + 2 * DM + col0;
#pragma unroll
                for (int bj = 0; bj < 2; ++bj) gq[m][bj] = *(const u32x4*)(gp + bj * HALF); }
#pragma unroll
            for (int m = 0; m < 4; ++m) { bf16* rowp = MG + (size_t)(row0 + ai * HALF + m * 16) * DM + col0;
#pragma unroll
                for (int bj = 0; bj < 2; ++bj) { const f32x4 a0 = acc[ai][bj][m][0], a1 = acc[ai][bj][m][1]; const u32x4 g = gq[m][bj];
                    u32x4 w; w.x = cvt_pk_bf16(bflo(g.x) * a0[0], bfhi(g.x) * a0[1]); w.y = cvt_pk_bf16(bflo(g.y) * a0[2], bfhi(g.y) * a0[3]);
                    w.z = cvt_pk_bf16(bflo(g.z) * a1[0], bfhi(g.z) * a1[1]); w.w = cvt_pk_bf16(bflo(g.w) * a1[2], bfhi(g.w) * a1[3]);
                    *(u32x4*)(rowp + bj * HALF) = w; } }
        }
    }
};
struct EpiWo {
    static constexpr bool PERM = true;
    bf16* Y; const bf16* XB;
    DI void operator()(const f32x4 (&acc)[2][2][4][2], const Unit& u, int wr, int wc, int fr, int fq) const {
        const int row0 = u.pm * BM + wr * 64 + fr, col0 = u.pn * BM + wc * 32 + 8 * fq;
#pragma unroll
        for (int ai = 0; ai < 2; ++ai) {
            u32x4 xq[4][2];
#pragma unroll
            for (int m = 0; m < 4; ++m) { const size_t off = (size_t)(row0 + ai * HALF + m * 16) * DM + col0;
#pragma unroll
                for (int bj = 0; bj < 2; ++bj) xq[m][bj] = *(const u32x4*)(XB + off + bj * HALF); }
#pragma unroll
            for (int m = 0; m < 4; ++m) { const size_t off = (size_t)(row0 + ai * HALF + m * 16) * DM + col0;
#pragma unroll
                for (int bj = 0; bj < 2; ++bj) { const u32x4 xb = xq[m][bj]; const f32x4 a0 = acc[ai][bj][m][0], a1 = acc[ai][bj][m][1];
                    u32x4 w; w.x = cvt_pk_bf16(a0[0] + ALPHA * bflo(xb.x), a0[1] + ALPHA * bfhi(xb.x)); w.y = cvt_pk_bf16(a0[2] + ALPHA * bflo(xb.y), a0[3] + ALPHA * bfhi(xb.y));
                    w.z = cvt_pk_bf16(a1[0] + ALPHA * bflo(xb.z), a1[1] + ALPHA * bfhi(xb.z)); w.w = cvt_pk_bf16(a1[2] + ALPHA * bflo(xb.w), a1[3] + ALPHA * bfhi(xb.w));
                    *(u32x4*)(Y + off + bj * HALF) = w; } }
        }
    }
};
struct EpiMoeUp {
    static constexpr bool PERM = true;
    bf16* H;
    DI void operator()(const f32x4 (&acc)[2][2][4][2], const Unit& u, int wr, int wc, int fr, int fq) const {
        const int row0 = u.pm * BM + wr * 64 + fr; const int col0 = u.pn * HALF + wc * 32 + 8 * fq;
#pragma unroll
        for (int ai = 0; ai < 2; ++ai)
#pragma unroll
            for (int m = 0; m < 4; ++m) { bf16* rowp = H + (size_t)(row0 + ai * HALF + m * 16) * DFF + col0; float o[8];
#pragma unroll
                for (int n = 0; n < 2; ++n)
#pragma unroll
                    for (int j = 0; j < 4; ++j) { const float g = acc[ai][0][m][n][j], up = acc[ai][1][m][n][j]; o[n * 4 + j] = g * fsigmoid(g) * up; }
                u32x4 w; w.x = cvt_pk_bf16(o[0], o[1]); w.y = cvt_pk_bf16(o[2], o[3]); w.z = cvt_pk_bf16(o[4], o[5]); w.w = cvt_pk_bf16(o[6], o[7]);
                *(u32x4*)rowp = w; }
    }
};
}

#define XB_TMO      128
#define XB_XCNT(j)  (256  + 64 * (j))
#define XB_XSUB(j)  (1280 + 64 * (j))
#define XB_XGEN(j)  (2304 + 64 * (j))
#define XB_TOP      3328
#define XB_TOPGEN   3392
#define XCD_BAR_WORDS 3456
#define XB_SPIN_CAP (1u << 18)
DI unsigned xb_ld(unsigned* p)              { return __hip_atomic_load(p, __ATOMIC_RELAXED, __HIP_MEMORY_SCOPE_AGENT); }
DI unsigned xb_add(unsigned* p, unsigned v) { return __hip_atomic_fetch_add(p, v, __ATOMIC_RELAXED, __HIP_MEMORY_SCOPE_AGENT); }
DI unsigned xb_xcc_id() { return (unsigned)__builtin_amdgcn_s_getreg((3 << 11) | 20) & 0xFu; }
#define XB_SPIN(cond, bar) do { unsigned _sp = 0; while (cond) { __builtin_amdgcn_s_sleep(1); \
    if ((++_sp & 255u) == 0u) { if (xb_ld(&(bar)[XB_TMO])) break; if (_sp > XB_SPIN_CAP) { atomicAdd(&(bar)[XB_TMO], 1u); break; } } } } while (0)
struct XcdBarrier { unsigned* bar; unsigned x; volatile LAS unsigned* st; };
DI XcdBarrier xcd_barrier_post(unsigned* bar, volatile LAS unsigned* st) {
    XcdBarrier b; b.bar = bar; b.x = xb_xcc_id(); b.st = st;
    if (threadIdx.x == 0) (void)xb_add(&bar[XB_XCNT(b.x)], 1u);
    return b;
}
DI void xcd_barrier_complete(unsigned* bar, unsigned x, unsigned& nloc, unsigned& nx) {
    const unsigned G = gridDim.x * gridDim.y * gridDim.z;
    unsigned sum, cnt, mine, sp = 0u;
    for (;;) {
        sum = 0u; cnt = 0u; mine = 0u;
#pragma unroll
        for (unsigned j = 0; j < 16; ++j) { const unsigned c = xb_ld(&bar[XB_XCNT(j)]); sum += c; cnt += (c > 0u) ? 1u : 0u; mine = (j == x) ? c : mine; }
        if (sum == G) break;
        __builtin_amdgcn_s_sleep(1);
        if ((++sp & 255u) == 0u) { if (xb_ld(&bar[XB_TMO])) break; if (sp > XB_SPIN_CAP) { atomicAdd(&bar[XB_TMO], 1u); break; } }
    }
    nloc = mine > 0u ? mine : 1u; nx = cnt > 0u ? cnt : 1u;
}
DI void xcd_barrier(const XcdBarrier& b) {
    asm volatile("s_waitcnt vmcnt(0)" ::: "memory");
    __syncthreads();
    if (threadIdx.x == 0) {
        unsigned* bar = b.bar;
        __builtin_amdgcn_s_waitcnt(0);
        unsigned nloc = b.st[0], nx = b.st[1];
        if (nloc == 0u) { xcd_barrier_complete(bar, b.x, nloc, nx); b.st[0] = nloc; b.st[1] = nx; }
        const unsigned old = xb_add(&bar[XB_XSUB(b.x)], 1u);
        const unsigned gen = old / nloc;
        if (old + 1u == (gen + 1u) * nloc) {
            __builtin_amdgcn_fence(__ATOMIC_RELEASE, "agent");
            asm volatile("s_waitcnt vmcnt(0)" ::: "memory");
            const unsigned og = xb_add(&bar[XB_TOP], 1u);
            const unsigned tg = og / nx;
            if (og + 1u == (tg + 1u) * nx) xb_add(&bar[XB_TOPGEN], 1u);
            else XB_SPIN(xb_ld(&bar[XB_TOPGEN]) == tg, bar);
            __builtin_amdgcn_fence(__ATOMIC_ACQUIRE, "agent");
            xb_add(&bar[XB_XGEN(b.x)], 1u);
            asm volatile("s_waitcnt vmcnt(0)" ::: "memory");
        } else {
            XB_SPIN(xb_ld(&bar[XB_XGEN(b.x)]) == gen, bar);
            __builtin_amdgcn_fence(__ATOMIC_ACQUIRE, "agent");
            asm volatile("s_waitcnt vmcnt(0)" ::: "memory");
        }
    }
    __syncthreads();
}

DI float inv_freq16(int i) {
    const float t = (float)i * (-13.287712379549449f / 16.0f);
    return __builtin_amdgcn_exp2f(t);
}
DI void cos_sin(double a, float& c, float& s) {
    const double kq = __builtin_rint(a * 0.63661977236758134308);
    const double r = a - kq * 1.57079632679489661923;
    const double r2 = r * r;
    const double sp = r * (1.0 + r2 * (-1.0 / 6 + r2 * (1.0 / 120 + r2 * (-1.0 / 5040 + r2 * (1.0 / 362880 + r2 * (-1.0 / 39916800))))));
    const double cp = 1.0 + r2 * (-0.5 + r2 * (1.0 / 24 + r2 * (-1.0 / 720 + r2 * (1.0 / 40320 + r2 * (-1.0 / 3628800 + r2 * (1.0 / 479001600))))));
    const int q = (int)kq & 3;
    const double cc = (q == 0) ? cp : (q == 1) ? -sp : (q == 2) ? -cp : sp;
    const double ss = (q == 0) ? sp : (q == 1) ? cp : (q == 2) ? -sp : -cp;
    c = (float)cc; s = (float)ss;
}
DI int t5_bucket_n(int n) { return n < 8 ? n : n < 12 ? 8 : n < 16 ? 9 : n < 23 ? 10 : n < 32 ? 11 : n < 46 ? 12 : n < 64 ? 13 : n < 91 ? 14 : 15; }

DI void transpose_item(const float* W, int Nsrc, int k0, int n0, bf16* WT, int Kdst, int d0, const float* kscale, LAS float* scr, int lane) {
#pragma unroll
    for (int i = 0; i < 8; ++i) { const int kk = 8 * i + (lane >> 3); f32x4 v = *(const f32x4*)(W + (size_t)(k0 + kk) * Nsrc + n0 + 4 * (lane & 7)); if (kscale) v = v * kscale[k0 + kk];
        LAS float* d = scr + kk * 33 + 4 * (lane & 7); d[0] = v.x; d[1] = v.y; d[2] = v.z; d[3] = v.w; }
    LDS_WAIT(); asm volatile("" ::: "memory");
    const int c = lane & 7;
#pragma unroll
    for (int j = 0; j < 4; ++j) { const int n = (lane >> 3) + 8 * j; const LAS float* s = scr + (8 * c) * 33 + n;
        u32x4 o; o.x = pk2(s[0 * 33], s[1 * 33]); o.y = pk2(s[2 * 33], s[3 * 33]); o.z = pk2(s[4 * 33], s[5 * 33]); o.w = pk2(s[6 * 33], s[7 * 33]);
        *(GAS u32x4*)(WT + (size_t)(d0 + n) * Kdst + k0 + 8 * c) = o; }
    LDS_WAIT(); asm volatile("" ::: "memory");
}

struct Args { const float* in[25]; float* out; unsigned char* ws; int ph_lo, ph_hi; };

template <int TYPE>
DI void naive_attn_item(const Args& args, int l, int b, int h, int t) {
    constexpr int DQ = TYPE == 2 ? 96 : 64;
    unsigned char* ws = args.ws;
    bf16* P1 = (bf16*)(ws + WS_P1); bf16* QC = (bf16*)((unsigned char*)args.out + DO_QC); const bf16* KVC = (const bf16*)((unsigned char*)args.out + DO_KVC);
    const f32x2* ROPE = (const f32x2*)(ws + WS_ROPE);
    const size_t row = (size_t)b * SEQ + t;
    float q[DQ];
    const bf16* qsrc = TYPE == 0 ? P1 + row * P1W + C_QA + 64 * h : TYPE == 1 ? P1 + row * P1W + C_QB + 64 * h : QC + row * QCW + 96 * h;
#pragma unroll
    for (int c = 0; c < DQ / 8; ++c) { const u32x4 w = *(const u32x4*)(qsrc + 8 * c);
        q[8 * c + 0] = bflo(w.x); q[8 * c + 1] = bfhi(w.x); q[8 * c + 2] = bflo(w.y); q[8 * c + 3] = bfhi(w.y); q[8 * c + 4] = bflo(w.z); q[8 * c + 5] = bfhi(w.z); q[8 * c + 6] = bflo(w.w); q[8 * c + 7] = bfhi(w.w); }
    if (TYPE == 0) {
        float ss = 0.f;
#pragma unroll
        for (int d = 0; d < 64; ++d) ss += q[d] * q[d];
        const float r = 1.0f / sqrtf(ss * (1.0f / 64.0f) + EPS); const float* gq = args.in[4] + l * 64;
#pragma unroll
        for (int d = 0; d < 64; ++d) q[d] = q[d] * r * gq[d];
        const int gr = t >> 6, gc = t & 63;
#pragma unroll
        for (int i = 0; i < 16; ++i) { const f32x2 cr = ROPE[gr * 16 + i], cc = ROPE[gc * 16 + i];
            const float a1 = q[i], a2 = q[16 + i]; q[i] = a1 * cr.x - a2 * cr.y; q[16 + i] = a2 * cr.x + a1 * cr.y;
            const float b1 = q[32 + i], b2 = q[48 + i]; q[32 + i] = b1 * cc.x - b2 * cc.y; q[48 + i] = b2 * cc.x + b1 * cc.y; }
#pragma unroll
        for (int d = 0; d < 64; ++d) q[d] *= C2_64;
    } else if (TYPE == 1) {
#pragma unroll
        for (int d = 0; d < 64; ++d) q[d] *= C2_64;
    } else {
        const float rs = ((const float*)(ws + WS_RSTDQ))[row] * C2_96;
#pragma unroll
        for (int d = 0; d < 96; ++d) q[d] *= rs;
#pragma unroll
        for (int i = 0; i < 16; ++i) { const f32x2 cs = ROPE[t * 16 + i]; const float a1 = q[64 + i], a2 = q[80 + i]; q[64 + i] = a1 * cs.x - a2 * cs.y; q[80 + i] = a2 * cs.x + a1 * cs.y; }
    }
    float o[64];
#pragma unroll
    for (int d = 0; d < 64; ++d) o[d] = 0.f;
    float mx = -1e30f, lsum = 0.f;
    const int kvh = h >> 2;
    const int s_lo = TYPE == 1 ? (t - 128 < 0 ? 0 : t - 128) : 0, s_hi = TYPE == 1 ? (t + 128 > SEQ - 1 ? SEQ - 1 : t + 128) : SEQ - 1;
    const float* TB = (const float*)(ws + WS_TB) + h * 260;
    for (int s = s_lo; s <= s_hi; ++s) {
        const size_t krow = (size_t)b * SEQ + s;
        const bf16* kp = TYPE == 0 ? P1 + krow * P1W + C_KA + 64 * kvh : TYPE == 1 ? P1 + krow * P1W + C_KB + 64 * kvh : KVC + krow * KVW + 128 * h;
        const bf16* vp = TYPE == 0 ? P1 + krow * P1W + C_VA + 64 * kvh : TYPE == 1 ? P1 + krow * P1W + C_VB + 64 * kvh : KVC + krow * KVW + 128 * h + 64;
        float dot = 0.f;
#pragma unroll
        for (int c = 0; c < 8; ++c) { const u32x4 w = *(const u32x4*)(kp + 8 * c);
            dot += q[8 * c + 0] * bflo(w.x) + q[8 * c + 1] * bfhi(w.x) + q[8 * c + 2] * bflo(w.y) + q[8 * c + 3] * bfhi(w.y) + q[8 * c + 4] * bflo(w.z) + q[8 * c + 5] * bfhi(w.z) + q[8 * c + 6] * bflo(w.w) + q[8 * c + 7] * bfhi(w.w); }
        if (TYPE == 2) { const bf16* rp = P1 + krow * P1W + C_KR;
#pragma unroll
            for (int c = 0; c < 4; ++c) { const u32x4 w = *(const u32x4*)(rp + 8 * c);
                dot += q[64 + 8 * c + 0] * bflo(w.x) + q[64 + 8 * c + 1] * bfhi(w.x) + q[64 + 8 * c + 2] * bflo(w.y) + q[64 + 8 * c + 3] * bfhi(w.y) + q[64 + 8 * c + 4] * bflo(w.z) + q[64 + 8 * c + 5] * bfhi(w.z) + q[64 + 8 * c + 6] * bflo(w.w) + q[64 + 8 * c + 7] * bfhi(w.w); } }
        if (TYPE == 1) dot += TB[s - t + 128];
        const float mn = fmaxf(mx, dot), corr = __builtin_amdgcn_exp2f(mx - mn), p = __builtin_amdgcn_exp2f(dot - mn);
        lsum = lsum * corr + p; mx = mn;
#pragma unroll
        for (int c = 0; c < 8; ++c) { const u32x4 w = *(const u32x4*)(vp + 8 * c);
            o[8 * c + 0] = o[8 * c + 0] * corr + p * bflo(w.x); o[8 * c + 1] = o[8 * c + 1] * corr + p * bfhi(w.x); o[8 * c + 2] = o[8 * c + 2] * corr + p * bflo(w.y); o[8 * c + 3] = o[8 * c + 3] * corr + p * bfhi(w.y);
            o[8 * c + 4] = o[8 * c + 4] * corr + p * bflo(w.z); o[8 * c + 5] = o[8 * c + 5] * corr + p * bfhi(w.z); o[8 * c + 6] = o[8 * c + 6] * corr + p * bflo(w.w); o[8 * c + 7] = o[8 * c + 7] * corr + p * bfhi(w.w); }
    }
    if (TYPE == 1) { const float sk = args.in[6][l * 8 + h] * LOG2E; lsum += __builtin_amdgcn_exp2f(sk - mx); }
    const float inv = 1.0f / lsum;
    bf16* od = TYPE == 2 ? P1 + row * P1W + C_CQ + 64 * h : (bf16*)qsrc;
#pragma unroll
    for (int c = 0; c < 8; ++c) { u32x4 w; w.x = pk2(o[8 * c + 0] * inv, o[8 * c + 1] * inv); w.y = pk2(o[8 * c + 2] * inv, o[8 * c + 3] * inv); w.z = pk2(o[8 * c + 4] * inv, o[8 * c + 5] * inv); w.w = pk2(o[8 * c + 6] * inv, o[8 * c + 7] * inv);
        *(u32x4*)(od + 8 * c) = w; }
}


typedef float f32x16 __attribute__((ext_vector_type(16)));
typedef short s16x4 __attribute__((ext_vector_type(4)));
typedef short v4i16_t __attribute__((ext_vector_type(4)));
constexpr int ATT_TBL_OFF = 104448;
constexpr float ATT_NEG = -1.0e30f, ATT_THR = 6.0f;
DI s16x4 vtr(const LAS unsigned char* p) { return __builtin_bit_cast(s16x4, __builtin_amdgcn_ds_read_tr16_b64_v4i16((LAS v4i16_t*)p)); }
DI float max3f(float a, float b, float c) { float r; asm("v_max3_f32 %0, %1, %2, %3" : "=v"(r) : "v"(a), "v"(b), "v"(c)); return r; }
DI float half_max(float v) { auto rr = __builtin_amdgcn_permlane32_swap(__float_as_uint(v), __float_as_uint(v), false, false); return fmaxf(__uint_as_float(rr[0]), __uint_as_float(rr[1])); }
DI float half_sum(float v) { auto rr = __builtin_amdgcn_permlane32_swap(__float_as_uint(v), __float_as_uint(v), false, false); return __uint_as_float(rr[0]) + __uint_as_float(rr[1]); }
DI bf16x8 pack8(const float (&f)[8]) { u32x4 w; w.x = cvt_pk_bf16(f[0], f[1]); w.y = cvt_pk_bf16(f[2], f[3]); w.z = cvt_pk_bf16(f[4], f[5]); w.w = cvt_pk_bf16(f[6], f[7]); return __builtin_bit_cast(bf16x8, w); }
DI void unpack8(const u32x4 w, float (&f)[8]) { f[0] = bflo(w.x); f[1] = bfhi(w.x); f[2] = bflo(w.y); f[3] = bfhi(w.y); f[4] = bflo(w.z); f[5] = bfhi(w.z); f[6] = bflo(w.w); f[7] = bfhi(w.w); }

template <int TYPE>
DI void attn_unit(LAS unsigned char* lds, const int tid, const int l, const int b, const int hg, const int qt, bf16* P1, const bf16* QC, const bf16* KVC, const f32x2* ROPE, const float* RSTDQ, const float* gq, const float* sinkp) {
    constexpr int DQ = TYPE == 2 ? 96 : 64, NS = DQ / 16, KS = DQ * 2 + 16, VS = 192, KBUF = 64 * KS, VBUF = 64 * VS;
    const int lane = tid & 63, wave = __builtin_amdgcn_readfirstlane(tid >> 6), r = lane & 31, h = lane >> 5;
    const int head = TYPE == 2 ? hg : hg * 4 + (wave & 3);
    const int q0 = TYPE == 2 ? qt * 256 + wave * 32 : qt * 64 + (wave >> 2) * 32;
    const int tq = q0 + r;
    const size_t qrow = (size_t)b * SEQ + tq;
    bf16x8 qf[NS];
    {
        float q[NS][8];
        const bf16* qsrc = TYPE == 0 ? P1 + qrow * P1W + C_QA + 64 * head : TYPE == 1 ? P1 + qrow * P1W + C_QB + 64 * head : QC + qrow * QCW + 96 * head;
#pragma unroll
        for (int s = 0; s < NS; ++s) unpack8(*(const u32x4*)(qsrc + 16 * s + 8 * h), q[s]);
        if (TYPE == 0) {
            float ss = 0.f;
#pragma unroll
            for (int s = 0; s < 4; ++s)
#pragma unroll
                for (int j = 0; j < 8; ++j) ss += q[s][j] * q[s][j];
            ss = half_sum(ss);
            const float rn = 1.0f / sqrtf(ss * (1.0f / 64.0f) + EPS) * C2_64;
#pragma unroll
            for (int s = 0; s < 4; ++s)
#pragma unroll
                for (int j = 0; j < 8; ++j) q[s][j] *= rn * gq[16 * s + 8 * h + j];
            const int gr = tq >> 6, gc = tq & 63;
#pragma unroll
            for (int j = 0; j < 8; ++j) { const f32x2 cr = ROPE[gr * 16 + 8 * h + j], cc = ROPE[gc * 16 + 8 * h + j];
                const float a1 = q[0][j], a2 = q[1][j]; q[0][j] = a1 * cr.x - a2 * cr.y; q[1][j] = a2 * cr.x + a1 * cr.y;
                const float b1 = q[2][j], b2 = q[3][j]; q[2][j] = b1 * cc.x - b2 * cc.y; q[3][j] = b2 * cc.x + b1 * cc.y; }
        } else if (TYPE == 1) {
#pragma unroll
            for (int s = 0; s < 4; ++s)
#pragma unroll
                for (int j = 0; j < 8; ++j) q[s][j] *= C2_64;
        } else {
            const float rs = RSTDQ[qrow] * C2_96;
#pragma unroll
            for (int s = 0; s < NS; ++s)
#pragma unroll
                for (int j = 0; j < 8; ++j) q[s][j] *= rs;
#pragma unroll
            for (int j = 0; j < 8; ++j) { const f32x2 cs = ROPE[tq * 16 + 8 * h + j]; const float a1 = q[NS - 2][j], a2 = q[NS - 1][j]; q[NS - 2][j] = a1 * cs.x - a2 * cs.y; q[NS - 1][j] = a2 * cs.x + a1 * cs.y; }
        }
#pragma unroll
        for (int s = 0; s < NS; ++s) qf[s] = pack8(q[s]);
    }
    const int kvh = TYPE == 2 ? 0 : hg;
    const bf16* Kg = TYPE == 0 ? P1 + C_KA + 64 * kvh : TYPE == 1 ? P1 + C_KB + 64 * kvh : KVC + 128 * head;
    const bf16* Vg = TYPE == 0 ? P1 + C_VA + 64 * kvh : TYPE == 1 ? P1 + C_VB + 64 * kvh : KVC + 128 * head + 64;
    const int kvp = TYPE == 2 ? KVW : P1W;
    const int kt_lo = TYPE == 1 ? (qt - 2 < 0 ? 0 : qt - 2) : 0, kt_hi = TYPE == 1 ? (qt + 2 > 31 ? 31 : qt + 2) : 31, nt = kt_hi - kt_lo + 1;
    const int lkey = tid >> 3, lch = tid & 7, pkey = (tid >> 2) & 63, pch = tid & 3;
    const size_t brow = (size_t)b * SEQ;
    u32x4 kreg, vreg, preg = (u32x4){0u, 0u, 0u, 0u};
    constexpr int SLOT = KBUF + VBUF;
#define ATT_LOAD(kt) do { const size_t kr_ = brow + (size_t)(kt) * 64 + lkey; kreg = *(const u32x4*)(Kg + kr_ * kvp + lch * 8); vreg = *(const u32x4*)(Vg + kr_ * kvp + lch * 8); \
        if (TYPE == 2 && tid < 256) preg = *(const u32x4*)(P1 + (brow + (size_t)(kt) * 64 + pkey) * P1W + C_KR + pch * 8); } while (0)
#define ATT_STORE(so) do { *(LAS u32x4*)(lds + (so) + lkey * KS + lch * 16) = kreg; *(LAS u32x4*)(lds + (so) + KBUF + lkey * VS + lch * 16) = vreg; \
        if (TYPE == 2 && tid < 256) *(LAS u32x4*)(lds + (so) + pkey * KS + 128 + pch * 16) = preg; } while (0)
    const int koff = r * KS + h * 16;
    const int voff = KBUF + (4 * h + ((lane & 15) >> 2)) * VS + ((lane >> 4) & 1) * 32 + (lane & 3) * 8;
    const int tboff = ATT_TBL_OFF + head * 1536 + (192 + 4 * h - tq) * 4;
    constexpr bool REL = (NS == 4);
    f32x16 o0, o1, negm, zero16;
#pragma unroll
    for (int i = 0; i < 16; ++i) { o0[i] = 0.f; o1[i] = 0.f; negm[i] = 0.f; zero16[i] = 0.f; }
    float m_run = 0.f, l_run = 0.f;
    int s_cur = 0, s_nxt = SLOT, s_nn = 2 * SLOT, s_n3 = 3 * SLOT;
    bf16x8 kfr[2 * NS]; s16x4 vlo[8], vhi[8]; bf16x8 pf[4];
#define ATT_KREAD(so, S0, S1) do { const LAS unsigned char* Kb_ = lds + (so) + koff; \
        _Pragma("unroll") for (int s = S0; s < S1; ++s) { kfr[2 * s] = *(const LAS bf16x8*)(Kb_ + s * 32); kfr[2 * s + 1] = *(const LAS bf16x8*)(Kb_ + 32 * KS + s * 32); } } while (0)
#define ATT_VREAD(so, K0, K1) do { const LAS unsigned char* Vb_ = lds + (so) + voff; \
        _Pragma("unroll") for (int kk = K0; kk < K1; ++kk) { vlo[2 * kk] = vtr(Vb_ + kk * 16 * VS); vhi[2 * kk] = vtr(Vb_ + kk * 16 * VS + 8 * VS); vlo[2 * kk + 1] = vtr(Vb_ + kk * 16 * VS + 64); vhi[2 * kk + 1] = vtr(Vb_ + kk * 16 * VS + 8 * VS + 64); } } while (0)
#define ATT_VF(i) (bf16x8){vlo[i][0], vlo[i][1], vlo[i][2], vlo[i][3], vhi[i][0], vhi[i][1], vhi[i][2], vhi[i][3]}
#define ATT_QKM(N0, N1, j) do { if (((j) & 1) == 0) N0 = __builtin_amdgcn_mfma_f32_32x32x16_bf16(kfr[j], qf[(j) >> 1], ((j) >> 1) == 0 ? (REL ? negm : zero16) : N0, 0, 0, 0); \
        else N1 = __builtin_amdgcn_mfma_f32_32x32x16_bf16(kfr[j], qf[(j) >> 1], ((j) >> 1) == 0 ? (REL ? negm : zero16) : N1, 0, 0, 0); } while (0)
#define ATT_EXP4(C, c, PFW, wlo) do { const float sh_ = REL ? 0.f : m_run; const float e0 = __builtin_amdgcn_exp2f(C[4 * (c)] - sh_), e1 = __builtin_amdgcn_exp2f(C[4 * (c) + 1] - sh_), e2 = __builtin_amdgcn_exp2f(C[4 * (c) + 2] - sh_), e3 = __builtin_amdgcn_exp2f(C[4 * (c) + 3] - sh_); \
        lsa += e0; lsb += e1; lsa += e2; lsb += e3; if (wlo) { PFW.x = cvtpk(e0, e1); PFW.y = cvtpk(e2, e3); } else { PFW.z = cvtpk(e0, e1); PFW.w = cvtpk(e2, e3); } } while (0)
#define ATT_BIAS(N0, N1, tt) do { if (TYPE == 1) { const LAS float* tb = (const LAS float*)(lds + tboff + (kt_lo + (tt)) * 256); \
        _Pragma("unroll") for (int i = 0; i < 16; ++i) { N0[i] += tb[(i & 3) + 8 * (i >> 2)]; N1[i] += tb[32 + (i & 3) + 8 * (i >> 2)]; } } } while (0)
#define ATT_BIAS4(N0, N1, tt, c) do { if (TYPE == 1) { const volatile LAS float* tb = (const volatile LAS float*)(lds + tboff + (kt_lo + (tt)) * 256 + 32 * (c)); \
        _Pragma("unroll") for (int i = 0; i < 4; ++i) { N0[4 * (c) + i] += tb[i]; N1[4 * (c) + i] += tb[32 + i]; } } } while (0)
#define PIN2(a_, b_) asm volatile("" : "+v"(a_), "+v"(b_))
#define PIN3(a_, b_, c_) asm volatile("" : "+v"(a_), "+v"(b_), "+v"(c_))
#define PIN4(a_, b_, c_, d_) asm volatile("" : "+v"(a_), "+v"(b_), "+v"(c_), "+v"(d_))
#define ATT_MAX4(N0, N1, c, acc) do { if (TYPE == 1) { acc = fmaxf(acc, fmaxf(fmaxf(N0[4 * (c)], N0[4 * (c) + 1]), fmaxf(N0[4 * (c) + 2], N0[4 * (c) + 3]))); acc = fmaxf(acc, fmaxf(fmaxf(N1[4 * (c)], N1[4 * (c) + 1]), fmaxf(N1[4 * (c) + 2], N1[4 * (c) + 3]))); } \
        else { acc = max3f(acc, N0[4 * (c)], N0[4 * (c) + 1]); acc = max3f(acc, N0[4 * (c) + 2], N0[4 * (c) + 3]); acc = max3f(acc, N1[4 * (c)], N1[4 * (c) + 1]); acc = max3f(acc, N1[4 * (c) + 2], N1[4 * (c) + 3]); } } while (0)
    {
        u32x4 k0_, v0_, p0_ = (u32x4){0u, 0u, 0u, 0u}, k1_, v1_, p1_ = p0_;
        ATT_LOAD(kt_lo); k0_ = kreg; v0_ = vreg; p0_ = preg;
        ATT_LOAD(kt_lo + 1); k1_ = kreg; v1_ = vreg; p1_ = preg;
        ATT_LOAD(kt_lo + 2);
        { const u32x4 k2_ = kreg, v2_ = vreg, p2_ = preg;
          if (nt > 3) ATT_LOAD(kt_lo + 3);
          const u32x4 k3_ = kreg, v3_ = vreg, p3_ = preg;
          kreg = k0_; vreg = v0_; preg = p0_; ATT_STORE(0);
          kreg = k1_; vreg = v1_; preg = p1_; ATT_STORE(SLOT);
          kreg = k2_; vreg = v2_; preg = p2_; ATT_STORE(2 * SLOT);
          kreg = k3_; vreg = v3_; preg = p3_; }
    }
    __syncthreads();
    f32x16 sa0, sa1, sb0, sb1; float tmx;
    ATT_KREAD(0, 0, NS);
#pragma unroll
    for (int j = 0; j < 2 * NS; ++j) ATT_QKM(sa0, sa1, j);
    ATT_BIAS(sa0, sa1, 0);
    tmx = ATT_NEG;
#pragma unroll
    for (int c = 0; c < 4; ++c) tmx = fmaxf(tmx, fmaxf(fmaxf(fmaxf(sa0[4 * c], sa0[4 * c + 1]), fmaxf(sa0[4 * c + 2], sa0[4 * c + 3])), fmaxf(fmaxf(sa1[4 * c], sa1[4 * c + 1]), fmaxf(sa1[4 * c + 2], sa1[4 * c + 3]))));
    tmx = half_max(tmx);
    m_run = tmx;
    if (REL) {
#pragma unroll
        for (int i = 0; i < 16; ++i) { sa0[i] -= m_run; sa1[i] -= m_run; negm[i] = -m_run; }
        tmx = 0.f; }
    constexpr int KP = 0;
    if (KP > 0 && nt > 1) ATT_KREAD(SLOT, 0, KP);
#define ATT_STEP(C0, C1, N0, N1, t, FULL, PRE) do { \
        if (FULL) ATT_KREAD(s_nxt, KP, 4); \
        if (__any(tmx > (REL ? 0.f : m_run) + ATT_THR)) { const float dl = fmaxf(tmx - (REL ? 0.f : m_run), 0.f), al = __builtin_amdgcn_exp2f(-dl); m_run += dl; l_run *= al; \
            _Pragma("unroll") for (int i = 0; i < 16; ++i) { o0[i] *= al; o1[i] *= al; } \
            if (REL) { _Pragma("unroll") for (int i = 0; i < 16; ++i) { C0[i] -= dl; C1[i] -= dl; negm[i] = -m_run; } } } \
        float lsa = 0.f, lsb = 0.f; u32x4 w0_ = (u32x4){0u, 0u, 0u, 0u}, w1_ = w0_, w2_ = w0_, w3_ = w0_; \
        if (FULL) ATT_QKM(N0, N1, 0); ATT_EXP4(C0, 0, w0_, true);  if (FULL) { PIN4(N0, lsa, lsb, w0_); } else { PIN3(lsa, lsb, w0_); } \
        if (FULL) ATT_QKM(N0, N1, 1); ATT_EXP4(C0, 1, w0_, false); if (FULL) { PIN4(N1, lsa, lsb, w0_); } else { PIN3(lsa, lsb, w0_); } \
        if (FULL) ATT_QKM(N0, N1, 2); ATT_EXP4(C0, 2, w1_, true);  if (FULL) { PIN4(N0, lsa, lsb, w1_); } else { PIN3(lsa, lsb, w1_); } \
        if (FULL) ATT_QKM(N0, N1, 3); ATT_EXP4(C0, 3, w1_, false); if (FULL && NS > 4) ATT_KREAD(s_nxt, 4, NS); ATT_VREAD(s_cur, 0, 2); if (FULL) { PIN4(N1, lsa, lsb, w1_); } else { PIN3(lsa, lsb, w1_); } \
        if (FULL) ATT_QKM(N0, N1, 4); ATT_EXP4(C1, 0, w2_, true);  if (FULL) { PIN4(N0, lsa, lsb, w2_); } else { PIN3(lsa, lsb, w2_); } \
        if (FULL) ATT_QKM(N0, N1, 5); ATT_EXP4(C1, 1, w2_, false); if (FULL) { PIN4(N1, lsa, lsb, w2_); } else { PIN3(lsa, lsb, w2_); } \
        if (FULL) ATT_QKM(N0, N1, 6); ATT_EXP4(C1, 2, w3_, true);  if (FULL) { PIN4(N0, lsa, lsb, w3_); } else { PIN3(lsa, lsb, w3_); } \
        if (FULL) ATT_QKM(N0, N1, 7); ATT_EXP4(C1, 3, w3_, false); if (FULL) { PIN4(N1, lsa, lsb, w3_); } else { PIN3(lsa, lsb, w3_); } \
        if (FULL && NS > 4) { ATT_QKM(N0, N1, 8); ATT_QKM(N0, N1, 9); ATT_QKM(N0, N1, 10); ATT_QKM(N0, N1, 11); } \
        ATT_VREAD(s_cur, 2, 4); \
        if ((t) + 3 < nt) ATT_STORE(s_n3); \
        if ((t) + 4 < nt) ATT_LOAD(kt_lo + (t) + 4); \
        l_run += lsa + lsb; \
        pf[0] = __builtin_bit_cast(bf16x8, w0_); pf[1] = __builtin_bit_cast(bf16x8, w1_); pf[2] = __builtin_bit_cast(bf16x8, w2_); pf[3] = __builtin_bit_cast(bf16x8, w3_); \
        tmx = ATT_NEG; \
        o0 = __builtin_amdgcn_mfma_f32_32x32x16_bf16(ATT_VF(0), pf[0], o0, 0, 0, 0); if (KP > 0 && PRE) ATT_KREAD(s_nn, 0, KP); PIN2(o0, tmx); \
        o1 = __builtin_amdgcn_mfma_f32_32x32x16_bf16(ATT_VF(1), pf[0], o1, 0, 0, 0); PIN2(o1, tmx); \
        o0 = __builtin_amdgcn_mfma_f32_32x32x16_bf16(ATT_VF(2), pf[1], o0, 0, 0, 0); PIN2(o0, tmx); \
        o1 = __builtin_amdgcn_mfma_f32_32x32x16_bf16(ATT_VF(3), pf[1], o1, 0, 0, 0); if (FULL) { ATT_BIAS4(N0, N1, (t) + 1, 0); ATT_MAX4(N0, N1, 0, tmx); } PIN2(o1, tmx); \
        o0 = __builtin_amdgcn_mfma_f32_32x32x16_bf16(ATT_VF(4), pf[2], o0, 0, 0, 0); if (FULL) { ATT_BIAS4(N0, N1, (t) + 1, 1); ATT_MAX4(N0, N1, 1, tmx); } PIN2(o0, tmx); \
        o1 = __builtin_amdgcn_mfma_f32_32x32x16_bf16(ATT_VF(5), pf[2], o1, 0, 0, 0); if (FULL) { ATT_BIAS4(N0, N1, (t) + 1, 2); ATT_MAX4(N0, N1, 2, tmx); } PIN2(o1, tmx); \
        o0 = __builtin_amdgcn_mfma_f32_32x32x16_bf16(ATT_VF(6), pf[3], o0, 0, 0, 0); if (FULL) { ATT_BIAS4(N0, N1, (t) + 1, 3); ATT_MAX4(N0, N1, 3, tmx); } PIN2(o0, tmx); \
        o1 = __builtin_amdgcn_mfma_f32_32x32x16_bf16(ATT_VF(7), pf[3], o1, 0, 0, 0); PIN2(o1, tmx); \
        if (FULL) tmx = half_max(tmx); \
        asm volatile("s_waitcnt lgkmcnt(0)\n\ts_barrier" ::: "memory");     \
        { const int tmp_ = s_cur; s_cur = s_nxt; s_nxt = s_nn; s_nn = s_n3; s_n3 = tmp_; } \
    } while (0)
    int t = 0;
    for (; t + 1 < nt; t += 2) { ATT_STEP(sa0, sa1, sb0, sb1, t, true, true); ATT_STEP(sb0, sb1, sa0, sa1, t + 1, true, true); }
    if (t < nt) { ATT_STEP(sa0, sa1, sb0, sb1, t, true, true); }
#undef ATT_STEP
#undef ATT_MAX4
#undef PIN2
#undef PIN3
#undef PIN4
#undef ATT_BIAS
#undef ATT_BIAS4
#undef ATT_EXP4
#undef ATT_QKM
#undef ATT_VF
#undef ATT_VREAD
#undef ATT_KREAD
#undef ATT_LOAD
#undef ATT_STORE
    float lt = half_sum(l_run);
    if (TYPE == 1) lt += __builtin_amdgcn_exp2f(sinkp[head] * LOG2E - m_run);
    const float inv = 1.0f / lt;
    bf16* od = P1 + qrow * P1W + (TYPE == 0 ? C_QA : TYPE == 1 ? C_QB : C_CQ) + 64 * head + 4 * h;
#pragma unroll
    for (int g = 0; g < 4; ++g) {
        *(u32x2*)(od + 8 * g) = (u32x2){cvt_pk_bf16(o0[4 * g] * inv, o0[4 * g + 1] * inv), cvt_pk_bf16(o0[4 * g + 2] * inv, o0[4 * g + 3] * inv)};
        *(u32x2*)(od + 32 + 8 * g) = (u32x2){cvt_pk_bf16(o1[4 * g] * inv, o1[4 * g + 1] * inv), cvt_pk_bf16(o1[4 * g + 2] * inv, o1[4 * g + 3] * inv)};
    }
}

constexpr int NPH = 1 + 11 * DEPTH;
__global__ void __launch_bounds__(512, 2) fwd_kernel(Args args) {
    extern __shared__ __attribute__((aligned(16))) unsigned char lds_raw[];
    LAS unsigned char* lds = (LAS unsigned char*)lds_raw;
    volatile LAS unsigned* MISC = (volatile LAS unsigned*)(lds + LDSCTL_OFF);
    const int tid0 = threadIdx.x, wave = __builtin_amdgcn_readfirstlane(tid0 >> 6);
    const int G = gridDim.x, bx = blockIdx.x;
    const int gw = bx * 8 + wave, NGW = G * 8;
    unsigned char* const ws0 = args.ws; unsigned char* const out0 = (unsigned char*)args.out;
    for (int u = tid0; u < (LDS_BYTES - LDSCTL_OFF) / 4; u += 512) MISC[u] = 0u;
    __syncthreads();
    XcdBarrier bar; bar.bar = (unsigned*)(ws0 + WS_CTL) + CW_BAR; bar.x = 0; bar.st = nullptr;
#if ONE_LAUNCH
    bar = xcd_barrier_post((unsigned*)(ws0 + WS_CTL) + CW_BAR, MISC + 8);
#endif
    const int lo = args.ph_lo, hi = args.ph_hi;
#define IN(k) (lo <= (k) && (k) < hi)
#define SEAM(k) do { if (IN(k) && IN((k) + 1)) { if (ONE_LAUNCH) xcd_barrier(bar); } } while (0)

#define PHASE_BEGIN \
    unsigned ones_ = ~0u; asm volatile("" : "+s"(ones_)); \
    int tid = wave * 64 + (int)__builtin_amdgcn_mbcnt_hi(ones_, __builtin_amdgcn_mbcnt_lo(ones_, 0u)); asm volatile("" : "+v"(tid)); const int lane = tid & 63; \
    size_t zoff = 0; asm volatile("" : "+s"(zoff)); unsigned char* ws = ws0 + zoff; unsigned char* outb = out0 + zoff; \
    unsigned* ctl = (unsigned*)(ws + WS_CTL); (void)ctl; (void)lane; \
    bf16* XB = (bf16*)(ws + WS_XB); bf16* P1 = (bf16*)(ws + WS_P1); bf16* GB = (bf16*)(ws + WS_G); (void)XB; (void)P1; (void)GB; \
    bf16* QC = (bf16*)(outb + DO_QC); bf16* KVC = (bf16*)(outb + DO_KVC); bf16* MG = KVC; (void)QC; (void)KVC; (void)MG; \
    bf16* Y = (bf16*)(ws + WS_G); bf16* HID = (bf16*)(ws + WS_P1); bf16* PAIR = (bf16*)(ws + WS_G); (void)Y; (void)HID; (void)PAIR; \
    unsigned char* Wb = ws + WS_W; (void)Wb; \
    f32x2* ROPE = (f32x2*)(ws + WS_ROPE); float* TB = (float*)(ws + WS_TB); (void)ROPE; (void)TB; \
    float* RSTDQ = (float*)(ws + WS_RSTDQ); float* RSTDKV = (float*)(ws + WS_RSTDKV); (void)RSTDQ; (void)RSTDKV; \
    int* LIST = (int*)(ws + WS_LIST); unsigned* ROUTE = (unsigned*)(ws + WS_ROUTE); (void)LIST; (void)ROUTE;

    if (EN(11) && IN(0)) { PHASE_BEGIN
        for (int idx = bx * 512 + tid; idx < 2048 * 16; idx += G * 512) { const int pos = idx >> 4, i = idx & 15; float c, s; cos_sin((double)pos * (double)inv_freq16(i), c, s); ROPE[idx] = (f32x2){c, s}; }
        for (int idx = bx * 512 + tid; idx < 8 * 257; idx += G * 512) { const int h = idx / 257, r = idx % 257, rel = r - 128; const int n = rel < 0 ? -rel : rel;
            const int bk = t5_bucket_n(n) + (rel > 0 ? 16 : 0); TB[h * 260 + r] = args.in[7][bk * 8 + h] * LOG2E; }
        const float* g = args.in[1]; const float* bb = args.in[2];
        f32x4 gv[4], bv[4];
#pragma unroll
        for (int j = 0; j < 4; ++j) { gv[j] = *(const f32x4*)(g + 256 * j + 4 * lane); bv[j] = *(const f32x4*)(bb + 256 * j + 4 * lane); }
        f32x4 xnx[4];
#pragma unroll
        for (int j = 0; j < 4; ++j) xnx[j] = *(const f32x4*)(args.in[0] + (size_t)(gw < NTOK ? gw : 0) * DM + 256 * j + 4 * lane);
        for (int m = gw; m < NTOK; m += NGW) {
            f32x4 v[4]; float s = 0.f;
#pragma unroll
            for (int j = 0; j < 4; ++j) { v[j] = xnx[j]; s += (v[j].x + v[j].y) + (v[j].z + v[j].w); }
            if (m + NGW < NTOK) {
#pragma unroll
                for (int j = 0; j < 4; ++j) xnx[j] = *(const f32x4*)(args.in[0] + (size_t)(m + NGW) * DM + 256 * j + 4 * lane); }
            const float mean = wave_sum(s) * (1.f / DM); float s2 = 0.f;
#pragma unroll
            for (int j = 0; j < 4; ++j) { v[j] = v[j] - mean; s2 += (v[j].x * v[j].x + v[j].y * v[j].y) + (v[j].z * v[j].z + v[j].w * v[j].w); }
            const float rstd = 1.f / sqrtf(wave_sum(s2) * (1.f / DM) + EPS);
#pragma unroll
            for (int j = 0; j < 4; ++j) { const f32x4 o = v[j] * rstd * gv[j] + bv[j]; *(u32x2*)(XB + (size_t)m * DM + 256 * j + 4 * lane) = (u32x2){pk2(o.x, o.y), pk2(o.z, o.w)}; }
        }
    }

    for (int l = 0; l < DEPTH; ++l) {
        const int pb = 1 + 11 * l;
        if (EN(0) && IN(pb + 0)) for (int rep_ = 0; rep_ < REPS_0; ++rep_) { PHASE_BEGIN
            LAS float* scr = (LAS float*)(lds + wave * 16384);
            const float* w_in = args.in[3] + (size_t)l * DM * INCOLS;
            const float* w_uq = args.in[10] + (size_t)l * 384 * 768; const float* w_ukv = args.in[11] + (size_t)l * 256 * 1024;
            const float* w_o = args.in[15] + (size_t)l * 1024 * 1024;
            const float* w_gate = args.in[20] + (size_t)l * 16 * 1024 * 512; const float* w_up = args.in[21] + (size_t)l * 16 * 1024 * 512; const float* w_down = args.in[22] + (size_t)l * 16 * 512 * 1024;
            const float* g_cq = args.in[8] + l * 384; const float* g_ckv = args.in[9] + l * 256;
            constexpr int I0 = 16 * 165, I1 = 6 * 24, I2 = 4 * 32, I3 = 8 * 32, I6 = 16 * 32, I7 = 16 * 16 * 16, I9 = 16 * 8 * 32;
            constexpr int NIT = I0 + I1 + I2 + 3 * I3 + I6 + 2 * I7 + I9;
            for (int it = gw; it < NIT; it += NGW) {
                int r = it;
                if (r < I0) { const int kb = r / 165, nb = r % 165; transpose_item(w_in, INCOLS, 64 * kb, 32 * nb, (bf16*)(Wb + W_WIN), 1024, 32 * (nb < 69 ? nb : nb + 3), nullptr, scr, lane); continue; } r -= I0;
                if (r < I1) { const int kb = r / 24, nb = r % 24; transpose_item(w_uq, 768, 64 * kb, 32 * nb, (bf16*)(Wb + W_WUP), 1024, 32 * nb, g_cq, scr, lane); continue; } r -= I1;
                if (r < I2) { const int kb = r / 32, nb = r % 32; transpose_item(w_ukv, 1024, 64 * kb, 32 * nb, (bf16*)(Wb + W_WUP), 1024, 768 + 32 * nb, g_ckv, scr, lane); continue; } r -= I2;
                if (r < 3 * I3) { const int j = r / I3, q = r % I3, kb = q / 32, nb = q % 32; transpose_item((j == 0 ? args.in[12] : j == 1 ? args.in[13] : args.in[14]) + (size_t)l * 512 * 1024, 1024, 64 * kb, 32 * nb, (bf16*)(Wb + W_WBR) + (size_t)j * 1024 * 512, 512, 32 * nb, nullptr, scr, lane); continue; } r -= 3 * I3;
                if (r < I6) { const int kb = r / 32, nb = r % 32; transpose_item(w_o, 1024, 64 * kb, 32 * nb, (bf16*)(Wb + W_WO), 1024, 32 * nb, nullptr, scr, lane); continue; } r -= I6;
                if (r < 2 * I7) { const int up = r / I7, q = r % I7, e = q / 256, kb = (q % 256) / 16, nb = q % 16;
                    transpose_item((up ? w_up : w_gate) + (size_t)e * 1024 * 512, 512, 64 * kb, 32 * nb, (bf16*)(Wb + W_WGU) + (size_t)e * 1024 * 1024, 1024, 32 * ((nb >> 2) * 8 + up * 4 + (nb & 3)), nullptr, scr, lane); continue; } r -= 2 * I7;
                { const int e = r / 256, kb = (r % 256) / 32, nb = r % 32; transpose_item(w_down + (size_t)e * 512 * 1024, 1024, 64 * kb, 32 * nb, (bf16*)(Wb + W_WD) + (size_t)e * 1024 * 512, 512, 32 * nb, nullptr, scr, lane); }
            }
            { unsigned zu = 0u; asm volatile("" : "+v"(zu));
              for (int idx = bx * 512 + tid; idx < 96 * 1024 / 8; idx += G * 512) *(u32x4*)((bf16*)(Wb + W_WIN) + (size_t)2208 * 1024 + (size_t)idx * 8) = (u32x4){zu, zu, zu, zu}; }
        }
        SEAM(pb + 0);

        if (EN(1) && IN(pb + 1)) for (int rep_ = 0; rep_ < REPS_1; ++rep_) { PHASE_BEGIN
            pg8::SchedPlain S; S.o.init(NTOK / 256, INW / 256 - 1, G, bx); S.A = (const char*)XB; S.Bt = (const char*)(Wb + W_WIN);
            S.lda2 = 2048; S.ldb2 = 2048;
            pg8::EpiInproj E{P1, GB};
            pg8::gemm_phase<pg8::EpiInproj, pg8::SchedPlain, true>(lds, tid, 1024, 2048, S, E);
        }
        SEAM(pb + 1);

        if (EN(2) && IN(pb + 2)) { PHASE_BEGIN
            const float* gk = args.in[5] + l * 64;
            const float gk0 = gk[2 * (lane & 31)], gk1 = gk[2 * (lane & 31) + 1];
            for (int m0 = gw; m0 < NTOK; m0 += 4 * NGW) {
                unsigned wka[4], wq[4][3], wk[4][2]; float vkr[4];
#pragma unroll
                for (int q = 0; q < 4; ++q) { const int m = m0 + q * NGW < NTOK ? m0 + q * NGW : m0; const bf16* pr = P1 + (size_t)m * P1W;
                    wka[q] = *(const unsigned*)(pr + C_KA + 2 * lane); vkr[q] = lane < 32 ? bf2f(pr[C_KR + lane]) : 0.f;
#pragma unroll
                    for (int j = 0; j < 3; ++j) wq[q][j] = *(const unsigned*)(pr + C_CQ + 128 * j + 2 * lane);
#pragma unroll
                    for (int j = 0; j < 2; ++j) wk[q][j] = *(const unsigned*)(pr + C_CKV + 128 * j + 2 * lane); }
#pragma unroll
                for (int q = 0; q < 4; ++q) { const int m = m0 + q * NGW; if (m < NTOK) {
                    bf16* pr = P1 + (size_t)m * P1W; const int t = m & (SEQ - 1), gr = t >> 6, gc = t & 63;
                    {
                        const int ll = lane & 31; float a = bflo(wka[q]), b = bfhi(wka[q]);
                        float ss = sum32(a * a + b * b);
                        const float r = 1.0f / sqrtf(ss * (1.0f / 64.0f) + EPS); const int d = 2 * ll; a = a * r * gk0; b = b * r * gk1;
                        const float pa = swz_xor<8>(a), pbv = swz_xor<8>(b);
                        const int pos = ll < 16 ? gr : gc, i0 = d & 15; const f32x2 c0 = ROPE[pos * 16 + i0], c1 = ROPE[pos * 16 + i0 + 1];
                        const bool first = (ll & 8) == 0;
                        const float oa = first ? a * c0.x - pa * c0.y : a * c0.x + pa * c0.y, ob = first ? b * c1.x - pbv * c1.y : b * c1.x + pbv * c1.y;
                        *(unsigned*)(pr + C_KA + 2 * lane) = pk2(oa, ob);
                    }
                    {
                        const float v = vkr[q]; const float p = swz_xor<16>(v);
                        const f32x2 cs = ROPE[t * 16 + (lane & 15)]; const float o = (lane < 16) ? v * cs.x - p * cs.y : v * cs.x + p * cs.y;
                        if (lane < 32) pr[C_KR + lane] = (bf16)f2bf(o);
                    }
                    {
                        float sq = 0.f, sk = 0.f;
#pragma unroll
                        for (int j = 0; j < 3; ++j) sq += bflo(wq[q][j]) * bflo(wq[q][j]) + bfhi(wq[q][j]) * bfhi(wq[q][j]);
#pragma unroll
                        for (int j = 0; j < 2; ++j) sk += bflo(wk[q][j]) * bflo(wk[q][j]) + bfhi(wk[q][j]) * bfhi(wk[q][j]);
                        sq = wave_sum(sq); sk = wave_sum(sk);
                        if (lane == 0) { RSTDQ[m] = 1.0f / sqrtf(sq * (1.0f / 384.0f) + EPS); RSTDKV[m] = 1.0f / sqrtf(sk * (1.0f / 256.0f) + EPS); }
                    } } }
            }
        }
        SEAM(pb + 2);

        if (EN(3) && IN(pb + 3)) for (int rep_ = 0; rep_ < REPS_3; ++rep_) { PHASE_BEGIN
            pg8::SchedUp S; S.G = G; S.c = bx; S.wsb = (const char*)ws; S.lda2 = P1W * 2;
            pg8::EpiUp E{QC, KVC, RSTDKV, GB};
            pg8::gemm_phase<pg8::EpiUp, pg8::SchedUp, true>(lds, tid, 384, 2048, S, E);
        }
        SEAM(pb + 3);

        if (EN(4) && IN(pb + 4)) { PHASE_BEGIN
#if ((ATTN_FAST & 7) != 7) && !defined(ATT_NO_NAIVE)
            for (int it = bx * 512 + tid; it < 3 * NBATCH * 8 * SEQ; it += G * 512) {
                const int t = it & (SEQ - 1), h = (it >> 11) & 7, b = (it >> 14) & 15, ty = it >> 18;
                if (ty == 0) { if (!(ATTN_FAST & 1)) naive_attn_item<0>(args, l, b, h, t); } else if (ty == 1) { if (!(ATTN_FAST & 2)) naive_attn_item<1>(args, l, b, h, t); } else { if (!(ATTN_FAST & 4)) naive_attn_item<2>(args, l, b, h, t); }
            }
            __syncthreads();
#endif
            const int xcd = bx & 7, idx = bx >> 3;
            const float* gq = args.in[4] + l * 64; const float* sinkp = args.in[6] + l * 8;
#if ATTN_FAST & 2
            for (int j = tid; j < 8 * 384; j += 512) { const int hh = j / 384, rel = j % 384 - 192; ((LAS float*)(lds + ATT_TBL_OFF))[j] = (rel >= -128 && rel <= 128) ? TB[hh * 260 + rel + 128] : ATT_NEG; }
            __syncthreads();
#endif
#if ATTN_FAST & 4
            for (int i = 0; ; ++i) { const int L = i * G + bx; if (L >= 1024 * REPS_4C) break;
                int u = L & 1023; if (G == 256) { const int rd = (L >> 8) & 3; u = (rd * 32 + xcd * 4 + (idx >> 3)) * 8 + (idx & 7); }
                attn_unit<2>(lds, tid, l, u >> 6, (u >> 3) & 7, u & 7, P1, QC, KVC, ROPE, RSTDQ, gq, sinkp); }
#endif
#if ATTN_FAST & 1
            for (int i = 0; ; ++i) { const int L = i * G + bx; if (L >= 1024) break;
                int u = L; if (G == 256) { const int rd = L >> 8; u = (rd * 8 + xcd) * 32 + idx; }
                attn_unit<0>(lds, tid, l, u >> 6, (u >> 5) & 1, u & 31, P1, QC, KVC, ROPE, RSTDQ, gq, sinkp); }
#endif
#if ATTN_FAST & 2
            for (int i = 0; ; ++i) { const int L = i * G + bx; if (L >= 1024) break;
                int u = L; if (G == 256) { const int rd = L >> 8; u = (rd * 8 + xcd) * 32 + idx; }
                attn_unit<1>(lds, tid, l, u >> 6, (u >> 5) & 1, u & 31, P1, QC, KVC, ROPE, RSTDQ, gq, sinkp); }
#endif
        }
        SEAM(pb + 4);

        if (EN(5) && IN(pb + 5)) for (int rep_ = 0; rep_ < REPS_5; ++rep_) { PHASE_BEGIN
            pg8::SchedMerge S; S.o.init(NTOK / 256, DM / 256, G, bx); S.P1 = (const char*)P1; S.Wbr = (const char*)(Wb + W_WBR); S.lda2 = P1W * 2;
            pg8::EpiMerge E{MG, GB};
            pg8::gemm_phase<pg8::EpiMerge, pg8::SchedMerge, true>(lds, tid, 512, 1024, S, E);
        }
        SEAM(pb + 5);

        if (EN(6) && IN(pb + 6)) for (int rep_ = 0; rep_ < REPS_6; ++rep_) { PHASE_BEGIN
            pg8::SchedPlain S; S.o.init(NTOK / 256, DM / 256, G, bx); S.A = (const char*)MG; S.Bt = (const char*)(Wb + W_WO); S.lda2 = 2048; S.ldb2 = 2048;
            pg8::EpiWo E{Y, XB};
            pg8::gemm_phase<pg8::EpiWo, pg8::SchedPlain, true>(lds, tid, 1024, 2048, S, E);
        }
        SEAM(pb + 6);

        if (EN(7) && IN(pb + 7)) { PHASE_BEGIN
            constexpr int WSTR = 1032;
            LAS bf16* WH = (LAS bf16*)lds; LAS bf16* WL = (LAS bf16*)(lds + 33280);
            LAS float* LG = (LAS float*)(lds + 69632);
            for (int idx = tid; idx < 16384; idx += 512) { const int k = idx >> 4, e = idx & 15; const float w = args.in[18][idx]; const unsigned hb = f2bf(w); const float rem = w - bf2f((bf16)hb);
                WH[e * WSTR + k] = (bf16)hb; WL[e * WSTR + k] = (bf16)f2bf(rem); }
            if (tid < 16) MISC[16 + tid] = 0u;
            __syncthreads();
            const float* g = args.in[16] + l * DM; const float* bb = args.in[17] + l * DM; const float* rb = args.in[19];
            const int rpb = (NTOK + G - 1) / G;
            const int r_lo = bx * rpb, r_hi = (r_lo + rpb < NTOK) ? r_lo + rpb : NTOK;
            const int fi = lane & 15, quad = lane >> 4;
            for (int g0 = r_lo + 16 * wave; g0 < r_hi; g0 += 128) {
                const int mrow = g0 + fi < r_hi ? g0 + fi : r_hi - 1;
                const bf16* yrow = Y + (size_t)mrow * DM + 8 * quad;
                float sm = 0.f, sq = 0.f;
#pragma unroll 8
                for (int sI = 0; sI < 32; ++sI) { const u32x4 w = *(const u32x4*)(yrow + 32 * sI);
                    const float e0 = bflo(w.x), e1 = bfhi(w.x), e2 = bflo(w.y), e3 = bfhi(w.y), e4 = bflo(w.z), e5 = bfhi(w.z), e6 = bflo(w.w), e7 = bfhi(w.w);
                    sm += ((e0 + e1) + (e2 + e3)) + ((e4 + e5) + (e6 + e7)); sq += ((e0 * e0 + e1 * e1) + (e2 * e2 + e3 * e3)) + ((e4 * e4 + e5 * e5) + (e6 * e6 + e7 * e7)); }
                sm += swz_xor<16>(sm); sm = xhalf_sum(sm); sq += swz_xor<16>(sq); sq = xhalf_sum(sq);
                const float mean = sm * (1.f / DM); const float var = fmaxf(sq * (1.f / DM) - mean * mean, 0.f);
                const float rstd = 1.f / sqrtf(var + EPS);
                f32x4 acc0 = (f32x4){0.f, 0.f, 0.f, 0.f}, acc1 = acc0;
                bf16* xrow = XB + (size_t)mrow * DM + 8 * quad; const bool wr_ok = (g0 + fi) < r_hi;
#pragma unroll 2
                for (int sI = 0; sI < 32; ++sI) {
                    const u32x4 w = *(const u32x4*)(yrow + 32 * sI); const int k0 = 32 * sI + 8 * quad;
                    const f32x4 ga = *(const f32x4*)(g + k0), gb = *(const f32x4*)(g + k0 + 4), ba = *(const f32x4*)(bb + k0), bc = *(const f32x4*)(bb + k0 + 4);
                    float x[8];
                    x[0] = (bflo(w.x) - mean) * rstd * ga.x + ba.x; x[1] = (bfhi(w.x) - mean) * rstd * ga.y + ba.y; x[2] = (bflo(w.y) - mean) * rstd * ga.z + ba.z; x[3] = (bfhi(w.y) - mean) * rstd * ga.w + ba.w;
                    x[4] = (bflo(w.z) - mean) * rstd * gb.x + bc.x; x[5] = (bfhi(w.z) - mean) * rstd * gb.y + bc.y; x[6] = (bflo(w.w) - mean) * rstd * gb.z + bc.z; x[7] = (bfhi(w.w) - mean) * rstd * gb.w + bc.w;
                    u32x4 hh; hh.x = pk2(x[0], x[1]); hh.y = pk2(x[2], x[3]); hh.z = pk2(x[4], x[5]); hh.w = pk2(x[6], x[7]);
                    if (wr_ok) *(u32x4*)(xrow + 32 * sI) = hh;
                    u32x4 ll; ll.x = pk2(x[0] - bflo(hh.x), x[1] - bfhi(hh.x)); ll.y = pk2(x[2] - bflo(hh.y), x[3] - bfhi(hh.y)); ll.z = pk2(x[4] - bflo(hh.z), x[5] - bfhi(hh.z)); ll.w = pk2(x[6] - bflo(hh.w), x[7] - bfhi(hh.w));
                    const bf16x8 wh = *(const LAS bf16x8*)(WH + fi * WSTR + k0), wl = *(const LAS bf16x8*)(WL + fi * WSTR + k0);
                    const bf16x8 xh = __builtin_bit_cast(bf16x8, hh), xl = __builtin_bit_cast(bf16x8, ll);
                    acc0 = __builtin_amdgcn_mfma_f32_16x16x32_bf16(xh, wh, acc0, 0, 0, 0);
                    acc1 = __builtin_amdgcn_mfma_f32_16x16x32_bf16(xh, wl, acc1, 0, 0, 0);
                    acc1 = __builtin_amdgcn_mfma_f32_16x16x32_bf16(xl, wh, acc1, 0, 0, 0);
                }
#pragma unroll
                for (int j = 0; j < 4; ++j) { const int mq = g0 + 4 * quad + j; if (mq < r_hi) LG[(mq - r_lo) * 16 + fi] = acc0[j] + acc1[j]; }
            }
            __syncthreads();
            if (tid < r_hi - r_lo) {
                float lg[16];
#pragma unroll
                for (int q = 0; q < 4; ++q) { const f32x4 t4 = *(const LAS f32x4*)(LG + tid * 16 + 4 * q); lg[4 * q] = t4.x; lg[4 * q + 1] = t4.y; lg[4 * q + 2] = t4.z; lg[4 * q + 3] = t4.w; }
                float sc[16], bi[16];
#pragma unroll
                for (int e = 0; e < 16; ++e) { sc[e] = 1.0f / (1.0f + expf(-lg[e])); bi[e] = sc[e] + rb[e]; }
                float gs[4]; int i1g[4], i2g[4];
#pragma unroll
                for (int q = 0; q < 4; ++q) { const float a = bi[4 * q], b = bi[4 * q + 1], c = bi[4 * q + 2], d = bi[4 * q + 3];
                    float best = a; int i1 = 0; if (b > best) { best = b; i1 = 1; } if (c > best) { best = c; i1 = 2; } if (d > best) { best = d; i1 = 3; }
                    float b2 = -1e30f; int i2 = 0;
                    if (i1 != 0 && a > b2) { b2 = a; i2 = 0; } if (i1 != 1 && b > b2) { b2 = b; i2 = 1; } if (i1 != 2 && c > b2) { b2 = c; i2 = 2; } if (i1 != 3 && d > b2) { b2 = d; i2 = 3; }
                    gs[q] = best + b2; i1g[q] = i1; i2g[q] = i2; }
                int sel = 0; float bg = gs[0];
#pragma unroll
                for (int q = 1; q < 4; ++q) if (gs[q] > bg) { bg = gs[q]; sel = q; }
                int i1 = i1g[0], i2 = i2g[0];
#pragma unroll
                for (int q = 1; q < 4; ++q) if (sel == q) { i1 = i1g[q]; i2 = i2g[q]; }
                const int e0 = sel * 4 + i1, e1 = sel * 4 + i2; float s0 = 0.f, s1 = 0.f;
#pragma unroll
                for (int e = 0; e < 16; ++e) { s0 = (e == e0) ? sc[e] : s0; s1 = (e == e1) ? sc[e] : s1; }
                const float w0 = s0 / (s0 + s1), w1 = s1 / (s0 + s1);
                const unsigned lp0 = atomicAdd((unsigned*)(MISC + 16 + e0), 1u), lp1 = atomicAdd((unsigned*)(MISC + 16 + e1), 1u);
                volatile LAS unsigned* ri = MISC + 128 + tid * 8; ri[0] = (unsigned)e0; ri[1] = lp0; ri[2] = (unsigned)e1; ri[3] = lp1; ri[4] = __float_as_uint(w0); ri[5] = __float_as_uint(w1);
            }
            __syncthreads();
            if (tid < 16) MISC[32 + tid] = __hip_atomic_fetch_add(ctl + CW_GCNT + (l * 16 + tid) * 64, MISC[16 + tid], __ATOMIC_RELAXED, __HIP_MEMORY_SCOPE_AGENT);
            __syncthreads();
            if (tid < r_hi - r_lo) { volatile LAS unsigned* ri = MISC + 128 + tid * 8; const int m = r_lo + tid;
                const unsigned e0 = ri[0], e1 = ri[2]; const unsigned p0 = MISC[32 + e0] + ri[1], p1 = MISC[32 + e1] + ri[3];
                LIST[e0 * LIST_CAP + p0] = m; LIST[e1 * LIST_CAP + p1] = m;
                *(u32x4*)(ROUTE + (size_t)m * 8) = (u32x4){e0, p0, e1, p1}; *(u32x2*)(ROUTE + (size_t)m * 8 + 4) = (u32x2){ri[4], ri[5]}; }
            __syncthreads();
        }
        SEAM(pb + 7);

        if (IN(pb + 8) || IN(pb + 9) || IN(pb + 10)) { PHASE_BEGIN
            if (tid == 0) { int ps = 0;
                for (int e = 0; e < 16; ++e) { const int c = (int)__hip_atomic_load(ctl + CW_GCNT + (l * 16 + e) * 64, __ATOMIC_RELAXED, __HIP_MEMORY_SCOPE_AGENT); MISC[64 + e] = (unsigned)ps; MISC[96 + e] = (unsigned)c; ps += (c + 255) >> 8; }
                MISC[80] = (unsigned)ps; }
            __syncthreads();
        }
        if (EN(8) && IN(pb + 8)) for (int rep_ = 0; rep_ < REPS_8; ++rep_) { PHASE_BEGIN
            pg8::SchedMoe<true> S; S.total_panels = (int)MISC[80]; S.G = G; S.c = bx; S.tab = (const volatile LAS int*)(MISC + 64); S.list = LIST; S.A = (const char*)XB; S.W = (const char*)(Wb + W_WGU);
            S.lda2 = 2048; S.wstride = (size_t)1024 * 1024 * 2; S.ldb2 = 2048;
            pg8::EpiMoeUp E{HID};
            pg8::gemm_phase<pg8::EpiMoeUp, pg8::SchedMoe<true>, true>(lds, tid, 1024, 2048, S, E);
        }
        SEAM(pb + 8);

        if (EN(9) && IN(pb + 9)) for (int rep_ = 0; rep_ < REPS_9; ++rep_) { PHASE_BEGIN
            pg8::SchedMoe<false> S; S.total_panels = (int)MISC[80]; S.G = G; S.c = bx; S.tab = (const volatile LAS int*)(MISC + 64); S.list = LIST; S.A = (const char*)HID; S.W = (const char*)(Wb + W_WD);
            S.lda2 = 1024; S.wstride = (size_t)1024 * 512 * 2; S.ldb2 = 1024;
            pg8::EpiBf16 E{PAIR, DM, nullptr};
            pg8::gemm_phase<pg8::EpiBf16, pg8::SchedMoe<false>, true>(lds, tid, 512, 1024, S, E);
        }
        SEAM(pb + 9);

        if (EN(10) && IN(pb + 10)) { PHASE_BEGIN
            const float* g = args.in[23] + l * DM; const float* bb = args.in[24] + l * DM;
            f32x4 gv[4], bv[4];
#pragma unroll
            for (int j = 0; j < 4; ++j) { gv[j] = *(const f32x4*)(g + 256 * j + 4 * lane); bv[j] = *(const f32x4*)(bb + 256 * j + 4 * lane); }
            for (int m0 = gw; m0 < NTOK; m0 += 4 * NGW) {
                u32x4 r4[4]; u32x2 w2[4];
#pragma unroll
                for (int q = 0; q < 4; ++q) { const int m = m0 + q * NGW < NTOK ? m0 + q * NGW : m0; r4[q] = *(const u32x4*)(ROUTE + (size_t)m * 8); w2[q] = *(const u32x2*)(ROUTE + (size_t)m * 8 + 4); }
                u32x2 xw[4][4], pa[4][4], pq[4][4];
#pragma unroll
                for (int q = 0; q < 4; ++q) { const int m = m0 + q * NGW < NTOK ? m0 + q * NGW : m0;
                    const size_t s0 = (size_t)MISC[64 + r4[q].x] * 256 + r4[q].y, s1 = (size_t)MISC[64 + r4[q].z] * 256 + r4[q].w;
#pragma unroll
                    for (int j = 0; j < 4; ++j) { xw[q][j] = *(const u32x2*)(XB + (size_t)m * DM + 256 * j + 4 * lane); pa[q][j] = *(const u32x2*)(PAIR + s0 * DM + 256 * j + 4 * lane); pq[q][j] = *(const u32x2*)(PAIR + s1 * DM + 256 * j + 4 * lane); } }
#pragma unroll
                for (int q = 0; q < 4; ++q) { const int m = m0 + q * NGW; if (m < NTOK) {
                    const float w0 = __uint_as_float(w2[q].x), w1 = __uint_as_float(w2[q].y);
                    f32x4 v[4]; float s = 0.f;
#pragma unroll
                    for (int j = 0; j < 4; ++j) {
                        v[j].x = ALPHA * bflo(xw[q][j].x) + w0 * bflo(pa[q][j].x) + w1 * bflo(pq[q][j].x); v[j].y = ALPHA * bfhi(xw[q][j].x) + w0 * bfhi(pa[q][j].x) + w1 * bfhi(pq[q][j].x);
                        v[j].z = ALPHA * bflo(xw[q][j].y) + w0 * bflo(pa[q][j].y) + w1 * bflo(pq[q][j].y); v[j].w = ALPHA * bfhi(xw[q][j].y) + w0 * bfhi(pa[q][j].y) + w1 * bfhi(pq[q][j].y);
                        s += (v[j].x + v[j].y) + (v[j].z + v[j].w); }
                    const float mean = wave_sum(s) * (1.f / DM); float s2 = 0.f;
#pragma unroll
                    for (int j = 0; j < 4; ++j) { v[j] = v[j] - mean; s2 += (v[j].x * v[j].x + v[j].y * v[j].y) + (v[j].z * v[j].z + v[j].w * v[j].w); }
                    const float rstd = 1.f / sqrtf(wave_sum(s2) * (1.f / DM) + EPS);
#pragma unroll
                    for (int j = 0; j < 4; ++j) { const f32x4 o = v[j] * rstd * gv[j] + bv[j];
                        if (l == DEPTH - 1) *(f32x4*)((float*)outb + (size_t)m * DM + 256 * j + 4 * lane) = o;
                        else *(u32x2*)(XB + (size_t)m * DM + 256 * j + 4 * lane) = (u32x2){pk2(o.x, o.y), pk2(o.z, o.w)}; } } }
            }
        }
        SEAM(pb + 10);
    }
#undef IN
#undef SEAM
}

extern "C" void kernel_launch(void* const* d_in, const int* in_sizes, int n_in, void* d_out, int out_size, void* d_ws, size_t ws_size, hipStream_t stream) {
    static int grid = 0;
    if (grid == 0) {
        if (n_in != 25 || out_size != NTOK * DM || ws_size < WS_END) { fprintf(stderr, "kernel_launch: unexpected shapes (n_in %d, out %d, ws %zu)\n", n_in, out_size, ws_size); grid = -1; return; }
        int dev = 0, cus = 0, per_cu = 0;
        if (hipGetDevice(&dev) != hipSuccess || hipDeviceGetAttribute(&cus, hipDeviceAttributeMultiprocessorCount, dev) != hipSuccess) { grid = -1; return; }
        if (hipFuncSetAttribute((const void*)fwd_kernel, hipFuncAttributeMaxDynamicSharedMemorySize, LDS_BYTES) != hipSuccess) { fprintf(stderr, "kernel_launch: hipFuncSetAttribute failed\n"); grid = -1; return; }
        if (hipOccupancyMaxActiveBlocksPerMultiprocessor(&per_cu, (const void*)fwd_kernel, 512, LDS_BYTES) != hipSuccess || per_cu < 1) fprintf(stderr, "kernel_launch: occupancy query reports %d\n", per_cu);
        (void)hipGetLastError();
        grid = cus;
    }
    if (grid < 0) return;
    (void)hipMemsetAsync((char*)d_ws + WS_CTL, 0, CTL_ZERO_BYTES, stream);
    Args a{};
    for (int i = 0; i < 25; ++i) a.in[i] = (const float*)d_in[i];
    a.out = (float*)d_out; a.ws = (unsigned char*)d_ws;
#if ONE_LAUNCH
    a.ph_lo = 0; a.ph_hi = NPH;
    hipLaunchKernelGGL(fwd_kernel, dim3(grid), dim3(512), LDS_BYTES, stream, a);
#else
    for (int p = 0; p < NPH; ++p) { a.ph_lo = p; a.ph_hi = p + 1; hipLaunchKernelGGL(fwd_kernel, dim3(grid), dim3(512), LDS_BYTES, stream, a); }
#endif
}
```

```cpp
#include <hip/hip_runtime.h>
#include <cstdio>
#include <cstdint>

#ifndef PHMASK
#define PHMASK 0xFFF
#endif
#define EN(k) (((PHMASK) >> (k)) & 1)
#ifndef REPS_0
#define REPS_0 1
#endif
#ifndef REPS_1
#define REPS_1 1
#endif
#ifndef REPS_3
#define REPS_3 1
#endif
#ifndef REPS_4C
#define REPS_4C 1
#endif
#ifndef REPS_5
#define REPS_5 1
#endif
#ifndef REPS_6
#define REPS_6 1
#endif
#ifndef REPS_8
#define REPS_8 1
#endif
#ifndef REPS_9
#define REPS_9 1
#endif
#ifndef ATTN_FAST
#define ATTN_FAST 7
#endif
#ifndef ONE_LAUNCH
#define ONE_LAUNCH 1
#endif

#define GAS __attribute__((address_space(1)))
#define LAS __attribute__((address_space(3)))
typedef unsigned short bf16;
typedef short bf16x8 __attribute__((ext_vector_type(8)));
typedef float f32x4 __attribute__((ext_vector_type(4)));
typedef float f32x2 __attribute__((ext_vector_type(2)));
typedef unsigned u32x4 __attribute__((ext_vector_type(4)));
typedef unsigned u32x2 __attribute__((ext_vector_type(2)));
#define DI __device__ __forceinline__

constexpr int NTOK = 32768, DM = 1024, SEQ = 2048, NBATCH = 16, DEPTH = 2;
constexpr int P1W = 2304, GW = 3072, INW = 5376, QCW = 768, KVW = 1024, INCOLS = 5280;
constexpr int NEXP = 16, DFF = 512, SLOT_ROWS = 69632, LIST_CAP = 32768;
constexpr float EPS = 1e-6f, ALPHA = 1.4142135623730951f, LOG2E = 1.4426950408889634f;
constexpr float C2_64 = 0.125f * LOG2E;
constexpr float C2_96 = 0.10206207261596577f * LOG2E;
constexpr int C_QA = 0, C_KA = 512, C_VA = 640, C_QB = 768, C_KB = 1280, C_VB = 1408, C_CQ = 1536, C_CKV = 1920, C_KR = 2176;

constexpr size_t MiB = 1u << 20;
constexpr size_t WS_CTL = 0, CTL_ZERO_BYTES = 1 * MiB;
constexpr size_t WS_ROPE = 1 * MiB;
constexpr size_t WS_TB = WS_ROPE + 2048 * 16 * 8;
constexpr size_t WS_RSTDQ = WS_TB + 8 * 260 * 4 + 1728;
constexpr size_t WS_RSTDKV = WS_RSTDQ + NTOK * 4;
constexpr size_t WS_LIST = 2 * MiB;
constexpr size_t WS_ROUTE = 4 * MiB;
constexpr size_t WS_W = 8 * MiB;
constexpr size_t W_WIN = 0, W_WUQ = 11010048, W_WUKV = 11599872, W_WBR = 12124160, W_WO = 15269888, W_WGU = 17367040, W_WD = 50921472, W_WUP = 67698688, W_END = 71368704;
constexpr size_t WS_XB = 77 * MiB;
constexpr size_t WS_P1 = 141 * MiB;
constexpr size_t WS_G = 285 * MiB;
constexpr size_t WS_END = 477 * MiB;
static_assert(WS_W + W_END <= WS_XB && WS_RSTDKV + NTOK * 4 <= WS_LIST, "ws map");
static_assert((size_t)SLOT_ROWS * 1024 * 2 <= WS_END - WS_G && (size_t)SLOT_ROWS * 512 * 2 <= WS_G - WS_P1, "ws map 2");
constexpr size_t DO_QC = 0, DO_KVC = 48 * MiB;
constexpr int CW_BAR = 4096;
constexpr int CW_GCNT = 16384;

constexpr int RING_BYTES = 131072, LDSCTL_OFF = RING_BYTES, LDS_BYTES = 147456;

DI float bf2f(unsigned short h) { return __builtin_bit_cast(float, (unsigned)h << 16); }
DI float bflo(unsigned w) { return __builtin_bit_cast(float, w << 16); }
DI float bfhi(unsigned w) { return __builtin_bit_cast(float, w & 0xffff0000u); }
DI unsigned f2bf(float f) { unsigned u = __builtin_bit_cast(unsigned, f); return (u + 0x7fffu + ((u >> 16) & 1u)) >> 16; }
DI unsigned pk2(float lo, float hi) { return f2bf(lo) | (f2bf(hi) << 16); }
DI unsigned cvt_pk_bf16(float lo, float hi) { unsigned r; asm volatile("v_cvt_pk_bf16_f32 %0, %1, %2" : "=v"(r) : "v"(lo), "v"(hi)); return r; }
typedef __bf16 bf16x2_t __attribute__((ext_vector_type(2)));
DI unsigned cvtpk(float lo, float hi) { const f32x2 v = {lo, hi}; const bf16x2_t bb = __builtin_convertvector(v, bf16x2_t); return __builtin_bit_cast(unsigned, bb); }
DI float fsigmoid(float x) { return __builtin_amdgcn_rcpf(1.0f + __builtin_amdgcn_exp2f(-x * LOG2E)); }
DI unsigned gate_q8x4(const f32x4 v) {
    const unsigned b0 = (unsigned)fmaxf(fsigmoid(v[0]) * 255.0f + 0.5f, 1.0f), b1 = (unsigned)fmaxf(fsigmoid(v[1]) * 255.0f + 0.5f, 1.0f);
    const unsigned b2 = (unsigned)fmaxf(fsigmoid(v[2]) * 255.0f + 0.5f, 1.0f), b3 = (unsigned)fmaxf(fsigmoid(v[3]) * 255.0f + 0.5f, 1.0f);
    return b0 | (b1 << 8) | (b2 << 16) | (b3 << 24); }
DI f32x4 gate_f4(const unsigned w) { return (f32x4){(float)(w & 0xffu), (float)((w >> 8) & 0xffu), (float)((w >> 16) & 0xffu), (float)(w >> 24)}; }
DI f32x4 rcp4(const f32x4 v) { return (f32x4){__builtin_amdgcn_rcpf(v[0]), __builtin_amdgcn_rcpf(v[1]), __builtin_amdgcn_rcpf(v[2]), __builtin_amdgcn_rcpf(v[3])}; }
template <int M> DI float swz_xor(float v) { return __builtin_bit_cast(float, __builtin_amdgcn_ds_swizzle(__builtin_bit_cast(int, v), (M << 10) | 0x1F)); }
DI float xhalf_sum(float v) { auto rr = __builtin_amdgcn_permlane32_swap(__float_as_uint(v), __float_as_uint(v), false, false); return __uint_as_float(rr[0]) + __uint_as_float(rr[1]); }
DI float sum32(float v) { v += swz_xor<1>(v); v += swz_xor<2>(v); v += swz_xor<4>(v); v += swz_xor<8>(v); v += swz_xor<16>(v); return v; }
DI float wave_sum(float v) { return xhalf_sum(sum32(v)); }
#define LDS_WAIT() asm volatile("s_waitcnt lgkmcnt(0)" ::: "memory")
#define VM_WAIT() asm volatile("s_waitcnt vmcnt(0)" ::: "memory")

namespace pg8 {
constexpr int BM = 256, BK = 64, HALF = 128, HTB = HALF * BK * 2, STAGE_BYTES = 8 * HTB, NXCD = 8, WGM = 8;
DI int lds_byte(int r, int c) { const int st = (r >> 4) * 2 + (c >> 5), rr = r & 15, cc = c & 31, ob = rr * 64 + cc * 2; return st * 1024 + (ob ^ (((ob >> 9) & 1) << 5)); }
DI void stage_rc(int b, int& R, int& C) { const int st = b / 1024, sb = b % 1024, swz = sb ^ (((sb >> 9) & 1) << 5); R = (st >> 1) * 16 + swz / 64; C = (st & 1) * 32 + (swz % 64) / 2; }
DI int perm32(int rho) { const int n = rho >> 4, i = rho & 15; return 8 * (i >> 2) + 4 * n + (i & 3); }

struct Unit { int pm, pn, e, aux; };
struct TileOrder {
    int nM, nN, nwg, G, c;
    DI void init(int nM_, int nN_, int G_, int c_) { nM = nM_; nN = nN_; nwg = nM * nN; G = G_; c = c_; }
    DI bool tile(int i, int& pm, int& pn) const {
        const long L = (long)i * G + c; if (L >= nwg) return false;
        int wgid = (int)L; { const int q = nwg / NXCD, r = nwg % NXCD, xcd = wgid % NXCD, off = wgid / NXCD; wgid = (xcd < r ? xcd * (q + 1) : r * (q + 1) + (xcd - r) * q) + off; }
        const int nig = WGM * nN, gid = wgid / nig, fm = gid * WGM, gsz = (nM - fm) < WGM ? (nM - fm) : WGM;
        pm = fm + ((wgid % nig) % gsz); pn = (wgid % nig) / gsz; return true;
    }
};

template <class Epi, class Sched, bool ALIGN_EPI>
DI void gemm_phase(LAS unsigned char* lds, const int tid, const int K, const unsigned ldb2, const Sched& S, const Epi& E) {
    const int wid = __builtin_amdgcn_readfirstlane(tid >> 6), lane = tid & 63, wr = wid >> 2, wc = wid & 3, fr = lane & 15, fq = lane >> 4;
    int nt = K / BK;
    int Rr[2], Cc[2]; unsigned voffA[2], voffB[2];
    const unsigned lda2 = S.lda2;
#pragma unroll
    for (int i = 0; i < 2; ++i) { int R, C; stage_rc(tid * 16 + i * 8192, R, C); const int Rb = Epi::PERM ? ((R & ~31) + perm32(R & 31)) : R;
        Rr[i] = R; Cc[i] = C * 2; voffA[i] = (unsigned)R * lda2 + (unsigned)C * 2u; voffB[i] = (unsigned)Rb * ldb2 + (unsigned)C * 2u; }
    const size_t kstep = (size_t)(BK * 2);
    const size_t hstepB = (size_t)HALF * ldb2, hstepA = (size_t)HALF * lda2;
    const unsigned ldsw = (unsigned)wid * 1024u;
    const int aoff = lds_byte(wr * 64 + fr, fq * 8), boff = lds_byte(wc * 32 + fr, fq * 8);
#define PG8_SA(b, h) (((b) * 2 + (h)) * HTB)
#define PG8_SB(b, h) ((4 + (b) * 2 + (h)) * HTB)
#define PG8_STAGE(bufoff, gbase, voff) do { _Pragma("unroll") for (int _i = 0; _i < 2; ++_i) \
        __builtin_amdgcn_global_load_lds((const unsigned*)((const char*)(gbase) + (voff)[_i]), (LAS unsigned*)(lds + (bufoff) + ldsw + _i * 8192), 16, 0, 0); } while (0)
#define PG8_STAGE_A(bufoff, gbase, h, g0, g1) do { if constexpr (Sched::GATHER) { if ((h) == 0) PG8_STAGE(bufoff, gbase, g0); else PG8_STAGE(bufoff, gbase, g1); } \
        else { PG8_STAGE(bufoff, (gbase) + (h) * hstepA, voffA); } } while (0)
#define PG8_LDA(dst, b, h) do { _Pragma("unroll") for (int m = 0; m < 4; ++m) _Pragma("unroll") for (int k = 0; k < 2; ++k) dst[m][k] = *(const LAS bf16x8*)(lds + PG8_SA(b, h) + aoff + m * 2048 + k * 1024); } while (0)
#define PG8_LDB(dst, b, h) do { _Pragma("unroll") for (int n = 0; n < 2; ++n) _Pragma("unroll") for (int k = 0; k < 2; ++k) dst[n][k] = *(const LAS bf16x8*)(lds + PG8_SB(b, h) + boff + n * 2048 + k * 1024); } while (0)
#define PG8_MMA(ai, bj, At, Bt) do { __builtin_amdgcn_s_setprio(1); _Pragma("unroll") for (int m = 0; m < 4; ++m) _Pragma("unroll") for (int n = 0; n < 2; ++n) _Pragma("unroll") for (int k = 0; k < 2; ++k) \
        acc[ai][bj][m][n] = __builtin_amdgcn_mfma_f32_16x16x32_bf16(Bt[n][k], At[m][k], acc[ai][bj][m][n], 0, 0, 0); __builtin_amdgcn_s_setprio(0); } while (0)
#define PG8_WAIT_V(n) asm volatile("s_waitcnt vmcnt(" #n ")" ::: "memory")
#define PG8_WAIT_L(n) asm volatile("s_waitcnt lgkmcnt(" #n ")" ::: "memory")
#define PG8_BAR __builtin_amdgcn_s_barrier()
#define PG8_SCHED __builtin_amdgcn_sched_barrier(0)
    Unit cur, nxt; int ui = 0;
    if (!S.next(0, cur)) return;
    f32x4 acc[2][2][4][2];
    float zf = 0.f; asm volatile("" : "+v"(zf));
#pragma unroll
    for (int a = 0; a < 2; ++a)
#pragma unroll
        for (int b = 0; b < 2; ++b)
#pragma unroll
            for (int m = 0; m < 4; ++m)
#pragma unroll
                for (int n = 0; n < 2; ++n) acc[a][b][m][n] = (f32x4){zf, zf, zf, zf};
    bf16x8 At[4][2], B0[2][2], B1[2][2];
    unsigned ao0[2] = {0u, 0u}, ao1[2] = {0u, 0u}, no0[2] = {0u, 0u}, no1[2] = {0u, 0u};
    if constexpr (Sched::GATHER) {
#pragma unroll
        for (int i = 0; i < 2; ++i) { ao0[i] = S.a_off(cur, Rr[i]) + Cc[i]; ao1[i] = S.a_off(cur, HALF + Rr[i]) + Cc[i]; } }
    const char* cA = S.a_base(cur); const char* cB = S.b_base(cur); nt = S.ktiles(cur, nt);
    PG8_STAGE(PG8_SB(0, 0), cB, voffB); PG8_STAGE(PG8_SB(0, 1), cB + hstepB, voffB); PG8_STAGE_A(PG8_SA(0, 0), cA, 0, ao0, ao1); PG8_STAGE_A(PG8_SA(0, 1), cA, 1, ao0, ao1);
    if (wr == 1) PG8_BAR;
    PG8_WAIT_V(2); PG8_BAR;
    PG8_STAGE(PG8_SB(1, 0), cB + kstep, voffB); PG8_STAGE_A(PG8_SA(1, 0), cA + kstep, 0, ao0, ao1); PG8_STAGE(PG8_SB(1, 1), cB + hstepB + kstep, voffB);
    PG8_WAIT_V(6); PG8_BAR;
    for (;;) {
        const bool has_next = S.next(ui + 1, nxt);
        const char* nA = cA; const char* nB = cB;
        if constexpr (Sched::GATHER) {
#pragma unroll
            for (int i = 0; i < 2; ++i) { no0[i] = ao0[i]; no1[i] = ao1[i]; } }
        if (has_next) { nA = S.a_base(nxt); nB = S.b_base(nxt);
            if constexpr (Sched::GATHER) {
#pragma unroll
                for (int i = 0; i < 2; ++i) { no0[i] = S.a_off(nxt, Rr[i]) + Cc[i]; no1[i] = S.a_off(nxt, HALF + Rr[i]) + Cc[i]; } } }
#pragma unroll 1
        for (int t = 0; t < nt; t += 2) {
            const bool last = (t == nt - 2);
            const char* a1 = cA + (size_t)(t + 1) * kstep;
            const char* a2 = last ? nA : cA + (size_t)(t + 2) * kstep; const char* b2 = last ? nB : cB + (size_t)(t + 2) * kstep;
            const char* a3 = a2 + kstep; const char* b3 = b2 + kstep;
            unsigned x0[2] = {0u, 0u}, x1[2] = {0u, 0u};
            if constexpr (Sched::GATHER) {
#pragma unroll
                for (int i = 0; i < 2; ++i) { x0[i] = last ? no0[i] : ao0[i]; x1[i] = last ? no1[i] : ao1[i]; } }
            PG8_LDB(B0, 0, 0); PG8_LDB(B1, 0, 1); PG8_SCHED; PG8_LDA(At, 0, 0); PG8_STAGE_A(PG8_SA(1, 1), a1, 1, ao0, ao1);
            PG8_WAIT_V(8); PG8_WAIT_L(0); PG8_BAR; PG8_MMA(0, 0, At, B0); PG8_MMA(0, 1, At, B1); PG8_BAR; PG8_SCHED;
            PG8_LDA(At, 0, 1); PG8_STAGE(PG8_SB(0, 0), b2, voffB); PG8_STAGE(PG8_SB(0, 1), b2 + hstepB, voffB); PG8_STAGE_A(PG8_SA(0, 0), a2, 0, x0, x1);
            PG8_WAIT_V(8); PG8_WAIT_L(0); PG8_BAR; PG8_MMA(1, 0, At, B0); PG8_MMA(1, 1, At, B1); PG8_BAR; PG8_SCHED;
            PG8_LDB(B0, 1, 0); PG8_LDB(B1, 1, 1); PG8_SCHED; PG8_LDA(At, 1, 0); PG8_STAGE_A(PG8_SA(0, 1), a2, 1, x0, x1);
            PG8_WAIT_V(8); PG8_WAIT_L(0); PG8_BAR; PG8_MMA(0, 0, At, B0); PG8_MMA(0, 1, At, B1); PG8_BAR; PG8_SCHED;
            PG8_LDA(At, 1, 1); PG8_STAGE(PG8_SB(1, 0), b3, voffB); PG8_STAGE(PG8_SB(1, 1), b3 + hstepB, voffB); PG8_STAGE_A(PG8_SA(1, 0), a3, 0, x0, x1);
            PG8_WAIT_V(8); PG8_WAIT_L(0); PG8_BAR; PG8_MMA(1, 0, At, B0); PG8_MMA(1, 1, At, B1); PG8_BAR; PG8_SCHED;
        }
        if constexpr (ALIGN_EPI) { if (wr == 0) PG8_BAR; }
        bool keep = false;
        if constexpr (Sched::KEEP) keep = S.keep_acc(cur);
        if constexpr (Sched::KEEP) { if (keep) E.mid(acc, cur, wr, wc, fr, fq); else E(acc, cur, wr, wc, fr, fq); } else { E(acc, cur, wr, wc, fr, fq); }
        if (!has_next) break;
        if (!keep) {
#pragma unroll
        for (int a = 0; a < 2; ++a)
#pragma unroll
            for (int b = 0; b < 2; ++b)
#pragma unroll
                for (int m = 0; m < 4; ++m)
#pragma unroll
                    for (int n = 0; n < 2; ++n) acc[a][b][m][n] = (f32x4){zf, zf, zf, zf};
        }
        cur = nxt; cA = nA; cB = nB; ++ui; nt = S.ktiles(cur, nt);
        if constexpr (Sched::GATHER) {
#pragma unroll
            for (int i = 0; i < 2; ++i) { ao0[i] = no0[i]; ao1[i] = no1[i]; } }
        if constexpr (ALIGN_EPI) { if (wr == 1) PG8_BAR; }
    }
    PG8_WAIT_V(0);
    if constexpr (!ALIGN_EPI) { if (wr == 0) PG8_BAR; }
    PG8_BAR;
#undef PG8_SA
#undef PG8_SB
#undef PG8_STAGE
#undef PG8_STAGE_A
#undef PG8_LDA
#undef PG8_LDB
#undef PG8_MMA
#undef PG8_WAIT_V
#undef PG8_WAIT_L
#undef PG8_BAR
#undef PG8_SCHED
}

struct SchedPlain {
    static constexpr bool GATHER = false, KEEP = false;
    TileOrder o; const char* A; const char* Bt; unsigned lda2, ldb2;
    DI bool next(int i, Unit& u) const { u.e = 0; u.aux = 0; return o.tile(i, u.pm, u.pn); }
    DI const char* a_base(const Unit& u) const { return A + (size_t)u.pm * BM * lda2; }
    DI unsigned a_off(const Unit&, int) const { return 0u; }
    DI int ktiles(const Unit&, int d) const { return d; }
    DI const char* b_base(const Unit& u) const { return Bt + (size_t)u.pn * BM * ldb2; }
};
struct SchedMerge {
    static constexpr bool GATHER = false, KEEP = true;
    TileOrder o; const char* P1; const char* Wbr; unsigned lda2;
    DI bool next(int i, Unit& u) const { u.e = i % 3; u.aux = 0; return o.tile(i / 3, u.pm, u.pn); }
    DI bool keep_acc(const Unit& u) const { return u.e < 2; }
    DI const char* a_base(const Unit& u) const { return P1 + (size_t)u.e * (768 * 2) + (size_t)u.pm * BM * lda2; }
    DI unsigned a_off(const Unit&, int) const { return 0u; }
    DI int ktiles(const Unit&, int d) const { return d; }
    DI const char* b_base(const Unit& u) const { return Wbr + (size_t)u.e * (1024 * 512 * 2) + (size_t)u.pn * BM * 1024; }
};
struct SchedUp {
    static constexpr bool GATHER = true, KEEP = false;
    int G, c; const char* wsb; unsigned lda2;
    DI void qunit(int i, Unit& u) const { u.e = 0; u.pm = i / 3; u.pn = i % 3; }
    DI void kvunit(int i, Unit& u) const { u.e = 1; u.pm = i >> 2; u.pn = 3 + (i & 3); }
    DI bool next(int i, Unit& u) const {
        u.aux = 0;
        if (G == 256) {
            if (c < 128) { if (i == 0) { u.e = 2; u.pm = c; u.pn = 7; return true; } if (i == 1) { qunit(c, u); return true; } if (i == 2) { kvunit(c, u); return true; } return false; }
            const int d = c - 128; if (i < 2) { qunit(128 + 2 * d + i, u); return true; } if (i < 5) { kvunit(128 + 3 * d + (i - 2), u); return true; } return false;
        }
        const int L = i * G + c; if (L >= 1024) return false;
        if (L < 128) { u.e = 2; u.pm = L; u.pn = 7; } else if (L < 512) qunit(L - 128, u); else kvunit(L - 512, u);
        return true;
    }
    DI const char* a_base(const Unit& u) const { const size_t off = u.e == 2 ? WS_XB + (size_t)u.pm * BM * 2048 : WS_P1 + (size_t)(u.e ? C_CKV * 2 : C_CQ * 2) + (size_t)u.pm * BM * (P1W * 2); return wsb + off; }
    DI unsigned a_off(const Unit& u, int r) const { return (unsigned)r * (u.e == 2 ? 2048u : (unsigned)(P1W * 2)); }
    DI int ktiles(const Unit& u, int) const { return u.e == 2 ? 16 : (u.e ? 4 : 6); }
    DI const char* b_base(const Unit& u) const { const size_t off = u.e == 2 ? WS_W + W_WIN + (size_t)5120 * 2048 : WS_W + W_WUP + (size_t)u.pn * BM * 2048; return wsb + off; }
};
template <bool GATHER_> struct SchedMoe {
    static constexpr bool GATHER = GATHER_, KEEP = false;
    int total_panels, G, c; const volatile LAS int* tab; const int* list; const char* A; const char* W; unsigned lda2; size_t wstride; unsigned ldb2;
    DI bool next(int i, Unit& u) const {
        int panel;
        if ((G & 7) == 0) { const int x = c & 7, per = G >> 3, p0 = (x * total_panels) >> 3, p1 = ((x + 1) * total_panels) >> 3;
            const int uu = i * per + (c >> 3); if (uu >= (p1 - p0) * 4) return false;
            panel = p0 + (uu >> 2); u.pn = uu & 3; }
        else { const int L = i * G + c; if (L >= total_panels * 4) return false; panel = L >> 2; u.pn = L & 3; }
        u.pm = panel; int e = 0;
#pragma unroll
        for (int j = 1; j < 16; ++j) e += (panel >= tab[j]) ? 1 : 0;
        u.e = e; u.aux = (panel - tab[e]) * BM; return true;
    }
    DI const char* a_base(const Unit& u) const { return GATHER ? A : A + (size_t)u.pm * BM * lda2; }
    DI unsigned a_off(const Unit& u, int r) const {
        int pos = u.aux + r; const int cnt = tab[32 + u.e]; pos = pos < cnt ? pos : cnt - 1; return (unsigned)list[u.e * LIST_CAP + pos] * lda2;
    }
    DI int ktiles(const Unit&, int d) const { return d; }
    DI const char* b_base(const Unit& u) const { return W + (size_t)u.e * wstride + (size_t)u.pn * BM * ldb2; }
};

struct EpiInproj {
    static constexpr bool PERM = true;
    bf16* P1; unsigned char* G8;
    DI void operator()(const f32x4 (&acc)[2][2][4][2], const Unit& u, int wr, int wc, int fr, int fq) const {
        const int row0 = u.pm * BM + wr * 64 + fr; const bool sig = u.pn >= 9;
        if (sig) {
            const int off0 = (u.pn - 9) * BM + wc * 64 + fq * 16;
#pragma unroll
            for (int ai = 0; ai < 2; ++ai)
#pragma unroll
                for (int m = 0; m < 4; ++m) { u32x4 w; w.x = gate_q8x4(acc[ai][0][m][0]); w.y = gate_q8x4(acc[ai][0][m][1]); w.z = gate_q8x4(acc[ai][1][m][0]); w.w = gate_q8x4(acc[ai][1][m][1]);
                    *(u32x4*)(G8 + (size_t)(row0 + ai * HALF + m * 16) * GW + off0) = w; }
        } else {
            const int col0 = u.pn * BM + wc * 32 + 8 * fq;
#pragma unroll
            for (int ai = 0; ai < 2; ++ai)
#pragma unroll
                for (int m = 0; m < 4; ++m) { bf16* rowp = P1 + (size_t)(row0 + ai * HALF + m * 16) * P1W + col0;
#pragma unroll
                    for (int bj = 0; bj < 2; ++bj) { const f32x4 v0 = acc[ai][bj][m][0], v1 = acc[ai][bj][m][1];
                        u32x4 w; w.x = cvt_pk_bf16(v0[0], v0[1]); w.y = cvt_pk_bf16(v0[2], v0[3]); w.z = cvt_pk_bf16(v1[0], v1[1]); w.w = cvt_pk_bf16(v1[2], v1[3]);
                        *(u32x4*)(rowp + bj * HALF) = w; } }
        }
    }
};
struct EpiBf16 {
    static constexpr bool PERM = true;
    bf16* O; int ldc; const float* rscale;
    DI void operator()(const f32x4 (&acc)[2][2][4][2], const Unit& u, int wr, int wc, int fr, int fq) const {
        const int row0 = u.pm * BM + wr * 64 + fr; const int col0 = u.pn * BM + wc * 32 + 8 * fq;
#pragma unroll
        for (int ai = 0; ai < 2; ++ai)
#pragma unroll
            for (int m = 0; m < 4; ++m) { const int row = row0 + ai * HALF + m * 16; bf16* rowp = O + (size_t)row * ldc + col0; const float s = rscale ? rscale[row] : 1.0f;
#pragma unroll
                for (int bj = 0; bj < 2; ++bj) { const f32x4 v0 = acc[ai][bj][m][0] * s, v1 = acc[ai][bj][m][1] * s;
                    u32x4 w; w.x = cvt_pk_bf16(v0[0], v0[1]); w.y = cvt_pk_bf16(v0[2], v0[3]); w.z = cvt_pk_bf16(v1[0], v1[1]); w.w = cvt_pk_bf16(v1[2], v1[3]);
                    *(u32x4*)(rowp + bj * HALF) = w; } }
    }
};
struct EpiUp {
    static constexpr bool PERM = true;
    bf16* QC; bf16* KVC; const float* rscale; unsigned char* G8;
    DI void operator()(const f32x4 (&acc)[2][2][4][2], const Unit& u, int wr, int wc, int fr, int fq) const {
        const int row0 = u.pm * BM + wr * 64 + fr; const bool kv = u.e == 1, gt = u.e == 2;
        if (gt) {
            const int off0 = 11 * BM + wc * 64 + fq * 16;
#pragma unroll
            for (int ai = 0; ai < 2; ++ai)
#pragma unroll
                for (int m = 0; m < 4; ++m) { u32x4 w; w.x = gate_q8x4(acc[ai][0][m][0]); w.y = gate_q8x4(acc[ai][0][m][1]); w.z = gate_q8x4(acc[ai][1][m][0]); w.w = gate_q8x4(acc[ai][1][m][1]);
                    *(u32x4*)(G8 + (size_t)(row0 + ai * HALF + m * 16) * GW + off0) = w; }
            return;
        }
        const int ld = kv ? KVW : QCW; const int col0 = (kv ? (u.pn - 3) : u.pn) * BM + wc * 32 + 8 * fq;
        const unsigned long long qi_ = (unsigned long long)QC, ki_ = (unsigned long long)KVC;
        const unsigned long long bsel = qi_ + (unsigned long long)(kv ? 1 : 0) * (ki_ - qi_);
#pragma unroll
        for (int ai = 0; ai < 2; ++ai)
#pragma unroll
            for (int m = 0; m < 4; ++m) { const int row = row0 + ai * HALF + m * 16; const size_t eo = (size_t)row * ld + col0; const float s = kv ? rscale[row] : 1.0f;
#pragma unroll
                for (int bj = 0; bj < 2; ++bj) { const f32x4 v0 = acc[ai][bj][m][0] * s, v1 = acc[ai][bj][m][1] * s;
                    u32x4 w; w.x = cvt_pk_bf16(v0[0], v0[1]); w.y = cvt_pk_bf16(v0[2], v0[3]); w.z = cvt_pk_bf16(v1[0], v1[1]); w.w = cvt_pk_bf16(v1[2], v1[3]);
                    *(GAS u32x4*)(bsel + (eo + bj * HALF) * 2) = w; } }
    }
};
struct EpiMerge {
    static constexpr bool PERM = true;
    bf16* MG; const unsigned char* G8;
    DI void mid(f32x4 (&acc)[2][2][4][2], const Unit& u, int wr, int wc, int fr, int fq) const {
        const int row0 = u.pm * BM + wr * 64 + fr; const int off0 = (u.e * 4 + u.pn) * BM + wc * 64 + fq * 16;
        u32x4 ga[2][4], gb[2][4];
#pragma unroll
        for (int ai = 0; ai < 2; ++ai)
#pragma unroll
            for (int m = 0; m < 4; ++m) { const unsigned char* gp = G8 + (size_t)(row0 + ai * HALF + m * 16) * GW + off0; ga[ai][m] = *(const u32x4*)gp; gb[ai][m] = *(const u32x4*)(gp + 4 * BM); }
#pragma unroll
        for (int ai = 0; ai < 2; ++ai)
#pragma unroll
            for (int m = 0; m < 4; ++m) { const u32x4 a = ga[ai][m], b = gb[ai][m];
                acc[ai][0][m][0] *= gate_f4(a.x) * rcp4(gate_f4(b.x)); acc[ai][0][m][1] *= gate_f4(a.y) * rcp4(gate_f4(b.y));
                acc[ai][1][m][0] *= gate_f4(a.z) * rcp4(gate_f4(b.z)); acc[ai][1][m][1] *= gate_f4(a.w) * rcp4(gate_f4(b.w)); }
    }
    DI void operator()(const f32x4 (&acc)[2][2][4][2], const Unit& u, int wr, int wc, int fr, int fq) const {
        const int row0 = u.pm * BM + wr * 64 + fr; const int col0 = u.pn * BM + wc * 32 + 8 * fq; const int off0 = (8 + u.pn) * BM + wc * 64 + fq * 16;
        u32x4 gq[2][4];
#pragma unroll
        for (int ai = 0; ai < 2; ++ai)
#pragma unroll
            for (int m = 0; m < 4; ++m) gq[ai][m] = *(const u32x4*)(G8 + (size_t)(row0 + ai * HALF + m * 16) * GW + off0);
#pragma unroll
        for (int ai = 0; ai < 2; ++ai)
#pragma unroll
            for (int m = 0; m < 4; ++m) { bf16* rowp = MG + (size_t)(row0 + ai * HALF + m * 16) * DM + col0; const u32x4 g = gq[ai][m];
#pragma unroll
                for (int bj = 0; bj < 2; ++bj) { const f32x4 a0 = acc[ai][bj][m][0] * (gate_f4(bj ? g.z : g.x) * (1.0f / 255.0f)), a1 = acc[ai][bj][m][1] * (gate_f4(bj ? g.w : g.y) * (1.0f / 255.0f));
                    u32x4 w; w.x = cvt_pk_bf16(a0[0], a0[1]); w.y = cvt_pk_bf16(a0[2], a0[3]); w.z = cvt_pk_bf16(a1[0], a1[1]); w.w = cvt_pk_bf16(a1[2], a1[3]);
                    *(u32x4*)(rowp + bj * HALF) = w; } }
    }
};
struct EpiWo {
    static constexpr bool PERM = true;
    bf16* Y; const bf16* XB;
    DI void operator()(const f32x4 (&acc)[2][2][4][2], const Unit& u, int wr, int wc, int fr, int fq) const {
        const int row0 = u.pm * BM + wr * 64 + fr, col0 = u.pn * BM + wc * 32 + 8 * fq;
#pragma unroll
        for (int ai = 0; ai < 2; ++ai) {
            u32x4 xq[4][2];
#pragma unroll
            for (int m = 0; m < 4; ++m) { const size_t off = (size_t)(row0 + ai * HALF + m * 16) * DM + col0;
#pragma unroll
                for (int bj = 0; bj < 2; ++bj) xq[m][bj] = *(const u32x4*)(XB + off + bj * HALF); }
#pragma unroll
            for (int m = 0; m < 4; ++m) { const size_t off = (size_t)(row0 + ai * HALF + m * 16) * DM + col0;
#pragma unroll
                for (int bj = 0; bj < 2; ++bj) { const u32x4 xb = xq[m][bj]; const f32x4 a0 = acc[ai][bj][m][0], a1 = acc[ai][bj][m][1];
                    u32x4 w; w.x = cvt_pk_bf16(a0[0] + ALPHA * bflo(xb.x), a0[1] + ALPHA * bfhi(xb.x)); w.y = cvt_pk_bf16(a0[2] + ALPHA * bflo(xb.y), a0[3] + ALPHA * bfhi(xb.y));
                    w.z = cvt_pk_bf16(a1[0] + ALPHA * bflo(xb.z), a1[1] + ALPHA * bfhi(xb.z)); w.w = cvt_pk_bf16(a1[2] + ALPHA * bflo(xb.w), a1[3] + ALPHA * bfhi(xb.w));
                    *(u32x4*)(Y + off + bj * HALF) = w; } }
        }
    }
};
struct EpiMoeUp {
    static constexpr bool PERM = true;
    bf16* H;
    DI void operator()(const f32x4 (&acc)[2][2][4][2], const Unit& u, int wr, int wc, int fr, int fq) const {
        const int row0 = u.pm * BM + wr * 64 + fr; const int col0 = u.pn * HALF + wc * 32 + 8 * fq;
#pragma unroll
        for (int ai = 0; ai < 2; ++ai)
#pragma unroll
            for (int m = 0; m < 4; ++m) { bf16* rowp = H + (size_t)(row0 + ai * HALF + m * 16) * DFF + col0; float o[8];
#pragma unroll
                for (int n = 0; n < 2; ++n)
#pragma unroll
                    for (int j = 0; j < 4; ++j) { const float g = acc[ai][0][m][n][j], up = acc[ai][1][m][n][j]; o[n * 4 + j] = g * fsigmoid(g) * up; }
                u32x4 w; w.x = cvt_pk_bf16(o[0], o[1]); w.y = cvt_pk_bf16(o[2], o[3]); w.z = cvt_pk_bf16(o[4], o[5]); w.w = cvt_pk_bf16(o[6], o[7]);
                *(u32x4*)rowp = w; }
    }
};
}

#define XB_TMO      128
#define XB_XCNT(j)  (256  + 64 * (j))
#define XB_XSUB(j)  (1280 + 64 * (j))
#define XB_XGEN(j)  (2304 + 64 * (j))
#define XB_TOP      3328
#define XB_TOPGEN   3392
#define XCD_BAR_WORDS 3456
#define XB_SPIN_CAP (1u << 18)
DI unsigned xb_ld(unsigned* p)              { return __hip_atomic_load(p, __ATOMIC_RELAXED, __HIP_MEMORY_SCOPE_AGENT); }
DI unsigned xb_add(unsigned* p, unsigned v) { return __hip_atomic_fetch_add(p, v, __ATOMIC_RELAXED, __HIP_MEMORY_SCOPE_AGENT); }
DI unsigned xb_xcc_id() { return (unsigned)__builtin_amdgcn_s_getreg((3 << 11) | 20) & 0xFu; }
#define XB_SPIN(cond, bar) do { unsigned _sp = 0; while (cond) { __builtin_amdgcn_s_sleep(1); \
    if ((++_sp & 255u) == 0u) { if (xb_ld(&(bar)[XB_TMO])) break; if (_sp > XB_SPIN_CAP) { atomicAdd(&(bar)[XB_TMO], 1u); break; } } } } while (0)
struct XcdBarrier { unsigned* bar; unsigned x; volatile LAS unsigned* st; };
DI XcdBarrier xcd_barrier_post(unsigned* bar, volatile LAS unsigned* st) {
    XcdBarrier b; b.bar = bar; b.x = xb_xcc_id(); b.st = st;
    if (threadIdx.x == 0) (void)xb_add(&bar[XB_XCNT(b.x)], 1u);
    return b;
}
DI void xcd_barrier_complete(unsigned* bar, unsigned x, unsigned& nloc, unsigned& nx) {
    const unsigned G = gridDim.x * gridDim.y * gridDim.z;
    unsigned sum, cnt, mine, sp = 0u;
    for (;;) {
        sum = 0u; cnt = 0u; mine = 0u;
#pragma unroll
        for (unsigned j = 0; j < 16; ++j) { const unsigned c = xb_ld(&bar[XB_XCNT(j)]); sum += c; cnt += (c > 0u) ? 1u : 0u; mine = (j == x) ? c : mine; }
        if (sum == G) break;
        __builtin_amdgcn_s_sleep(1);
        if ((++sp & 255u) == 0u) { if (xb_ld(&bar[XB_TMO])) break; if (sp > XB_SPIN_CAP) { atomicAdd(&bar[XB_TMO], 1u); break; } }
    }
    nloc = mine > 0u ? mine : 1u; nx = cnt > 0u ? cnt : 1u;
}
DI void xcd_barrier(const XcdBarrier& b) {
    asm volatile("s_waitcnt vmcnt(0)" ::: "memory");
    __syncthreads();
    if (threadIdx.x == 0) {
        unsigned* bar = b.bar;
        __builtin_amdgcn_s_waitcnt(0);
        unsigned nloc = b.st[0], nx = b.st[1];
        if (nloc == 0u) { xcd_barrier_complete(bar, b.x, nloc, nx); b.st[0] = nloc; b.st[1] = nx; }
        const unsigned old = xb_add(&bar[XB_XSUB(b.x)], 1u);
        const unsigned gen = old / nloc;
        if (old + 1u == (gen + 1u) * nloc) {
            __builtin_amdgcn_fence(__ATOMIC_RELEASE, "agent");
            asm volatile("s_waitcnt vmcnt(0)" ::: "memory");
            const unsigned og = xb_add(&bar[XB_TOP], 1u);
            const unsigned tg = og / nx;
            if (og + 1u == (tg + 1u) * nx) xb_add(&bar[XB_TOPGEN], 1u);
            else XB_SPIN(xb_ld(&bar[XB_TOPGEN]) == tg, bar);
            __builtin_amdgcn_fence(__ATOMIC_ACQUIRE, "agent");
            xb_add(&bar[XB_XGEN(b.x)], 1u);
            asm volatile("s_waitcnt vmcnt(0)" ::: "memory");
        } else {
            XB_SPIN(xb_ld(&bar[XB_XGEN(b.x)]) == gen, bar);
            __builtin_amdgcn_fence(__ATOMIC_ACQUIRE, "agent");
            asm volatile("s_waitcnt vmcnt(0)" ::: "memory");
        }
    }
    __syncthreads();
}

DI float inv_freq16(int i) {
    const float t = (float)i * (-13.287712379549449f / 16.0f);
    return __builtin_amdgcn_exp2f(t);
}
DI void cos_sin(double a, float& c, float& s) {
    const double kq = __builtin_rint(a * 0.63661977236758134308);
    const double r = a - kq * 1.57079632679489661923;
    const double r2 = r * r;
    const double sp = r * (1.0 + r2 * (-1.0 / 6 + r2 * (1.0 / 120 + r2 * (-1.0 / 5040 + r2 * (1.0 / 362880 + r2 * (-1.0 / 39916800))))));
    const double cp = 1.0 + r2 * (-0.5 + r2 * (1.0 / 24 + r2 * (-1.0 / 720 + r2 * (1.0 / 40320 + r2 * (-1.0 / 3628800 + r2 * (1.0 / 479001600))))));
    const int q = (int)kq & 3;
    const double cc = (q == 0) ? cp : (q == 1) ? -sp : (q == 2) ? -cp : sp;
    const double ss = (q == 0) ? sp : (q == 1) ? cp : (q == 2) ? -sp : -cp;
    c = (float)cc; s = (float)ss;
}
DI int t5_bucket_n(int n) { return n < 8 ? n : n < 12 ? 8 : n < 16 ? 9 : n < 23 ? 10 : n < 32 ? 11 : n < 46 ? 12 : n < 64 ? 13 : n < 91 ? 14 : 15; }

DI void transpose_item(const float* W, int Nsrc, int k0, int n0, bf16* WT, int Kdst, int d0, const float* kscale, LAS float* scr, int lane) {
#pragma unroll
    for (int i = 0; i < 8; ++i) { const int kk = 8 * i + (lane >> 3); f32x4 v = *(const f32x4*)(W + (size_t)(k0 + kk) * Nsrc + n0 + 4 * (lane & 7)); if (kscale) v = v * kscale[k0 + kk];
        LAS float* d = scr + kk * 33 + 4 * (lane & 7); d[0] = v.x; d[1] = v.y; d[2] = v.z; d[3] = v.w; }
    LDS_WAIT(); asm volatile("" ::: "memory");
    const int c = lane & 7;
#pragma unroll
    for (int j = 0; j < 4; ++j) { const int n = (lane >> 3) + 8 * j; const LAS float* s = scr + (8 * c) * 33 + n;
        u32x4 o; o.x = pk2(s[0 * 33], s[1 * 33]); o.y = pk2(s[2 * 33], s[3 * 33]); o.z = pk2(s[4 * 33], s[5 * 33]); o.w = pk2(s[6 * 33], s[7 * 33]);
        *(GAS u32x4*)(WT + (size_t)(d0 + n) * Kdst + k0 + 8 * c) = o; }
    LDS_WAIT(); asm volatile("" ::: "memory");
}

struct Args { const float* in[25]; float* out; unsigned char* ws; int ph_lo, ph_hi; };

template <int TYPE>
DI void naive_attn_item(const Args& args, int l, int b, int h, int t) {
    constexpr int DQ = TYPE == 2 ? 96 : 64;
    unsigned char* ws = args.ws;
    bf16* P1 = (bf16*)(ws + WS_P1); bf16* QC = (bf16*)((unsigned char*)args.out + DO_QC); const bf16* KVC = (const bf16*)((unsigned char*)args.out + DO_KVC);
    const f32x2* ROPE = (const f32x2*)(ws + WS_ROPE);
    const size_t row = (size_t)b * SEQ + t;
    float q[DQ];
    const bf16* qsrc = TYPE == 0 ? P1 + row * P1W + C_QA + 64 * h : TYPE == 1 ? P1 + row * P1W + C_QB + 64 * h : QC + row * QCW + 96 * h;
#pragma unroll
    for (int c = 0; c < DQ / 8; ++c) { const u32x4 w = *(const u32x4*)(qsrc + 8 * c);
        q[8 * c + 0] = bflo(w.x); q[8 * c + 1] = bfhi(w.x); q[8 * c + 2] = bflo(w.y); q[8 * c + 3] = bfhi(w.y); q[8 * c + 4] = bflo(w.z); q[8 * c + 5] = bfhi(w.z); q[8 * c + 6] = bflo(w.w); q[8 * c + 7] = bfhi(w.w); }
    if (TYPE == 0) {
        float ss = 0.f;
#pragma unroll
        for (int d = 0; d < 64; ++d) ss += q[d] * q[d];
        const float r = 1.0f / sqrtf(ss * (1.0f / 64.0f) + EPS); const float* gq = args.in[4] + l * 64;
#pragma unroll
        for (int d = 0; d < 64; ++d) q[d] = q[d] * r * gq[d];
        const int gr = t >> 6, gc = t & 63;
#pragma unroll
        for (int i = 0; i < 16; ++i) { const f32x2 cr = ROPE[gr * 16 + i], cc = ROPE[gc * 16 + i];
            const float a1 = q[i], a2 = q[16 + i]; q[i] = a1 * cr.x - a2 * cr.y; q[16 + i] = a2 * cr.x + a1 * cr.y;
            const float b1 = q[32 + i], b2 = q[48 + i]; q[32 + i] = b1 * cc.x - b2 * cc.y; q[48 + i] = b2 * cc.x + b1 * cc.y; }
#pragma unroll
        for (int d = 0; d < 64; ++d) q[d] *= C2_64;
    } else if (TYPE == 1) {
#pragma unroll
        for (int d = 0; d < 64; ++d) q[d] *= C2_64;
    } else {
        const float rs = ((const float*)(ws + WS_RSTDQ))[row] * C2_96;
#pragma unroll
        for (int d = 0; d < 96; ++d) q[d] *= rs;
#pragma unroll
        for (int i = 0; i < 16; ++i) { const f32x2 cs = ROPE[t * 16 + i]; const float a1 = q[64 + i], a2 = q[80 + i]; q[64 + i] = a1 * cs.x - a2 * cs.y; q[80 + i] = a2 * cs.x + a1 * cs.y; }
    }
    float o[64];
#pragma unroll
    for (int d = 0; d < 64; ++d) o[d] = 0.f;
    float mx = -1e30f, lsum = 0.f;
    const int kvh = h >> 2;
    const int s_lo = TYPE == 1 ? (t - 128 < 0 ? 0 : t - 128) : 0, s_hi = TYPE == 1 ? (t + 128 > SEQ - 1 ? SEQ - 1 : t + 128) : SEQ - 1;
    const float* TB = (const float*)(ws + WS_TB) + h * 260;
    for (int s = s_lo; s <= s_hi; ++s) {
        const size_t krow = (size_t)b * SEQ + s;
        const bf16* kp = TYPE == 0 ? P1 + krow * P1W + C_KA + 64 * kvh : TYPE == 1 ? P1 + krow * P1W + C_KB + 64 * kvh : KVC + krow * KVW + 128 * h;
        const bf16* vp = TYPE == 0 ? P1 + krow * P1W + C_VA + 64 * kvh : TYPE == 1 ? P1 + krow * P1W + C_VB + 64 * kvh : KVC + krow * KVW + 128 * h + 64;
        float dot = 0.f;
#pragma unroll
        for (int c = 0; c < 8; ++c) { const u32x4 w = *(const u32x4*)(kp + 8 * c);
            dot += q[8 * c + 0] * bflo(w.x) + q[8 * c + 1] * bfhi(w.x) + q[8 * c + 2] * bflo(w.y) + q[8 * c + 3] * bfhi(w.y) + q[8 * c + 4] * bflo(w.z) + q[8 * c + 5] * bfhi(w.z) + q[8 * c + 6] * bflo(w.w) + q[8 * c + 7] * bfhi(w.w); }
        if (TYPE == 2) { const bf16* rp = P1 + krow * P1W + C_KR;
#pragma unroll
            for (int c = 0; c < 4; ++c) { const u32x4 w = *(const u32x4*)(rp + 8 * c);
                dot += q[64 + 8 * c + 0] * bflo(w.x) + q[64 + 8 * c + 1] * bfhi(w.x) + q[64 + 8 * c + 2] * bflo(w.y) + q[64 + 8 * c + 3] * bfhi(w.y) + q[64 + 8 * c + 4] * bflo(w.z) + q[64 + 8 * c + 5] * bfhi(w.z) + q[64 + 8 * c + 6] * bflo(w.w) + q[64 + 8 * c + 7] * bfhi(w.w); } }
        if (TYPE == 1) dot += TB[s - t + 128];
        const float mn = fmaxf(mx, dot), corr = __builtin_amdgcn_exp2f(mx - mn), p = __builtin_amdgcn_exp2f(dot - mn);
        lsum = lsum * corr + p; mx = mn;
#pragma unroll
        for (int c = 0; c < 8; ++c) { const u32x4 w = *(const u32x4*)(vp + 8 * c);
            o[8 * c + 0] = o[8 * c + 0] * corr + p * bflo(w.x); o[8 * c + 1] = o[8 * c + 1] * corr + p * bfhi(w.x); o[8 * c + 2] = o[8 * c + 2] * corr + p * bflo(w.y); o[8 * c + 3] = o[8 * c + 3] * corr + p * bfhi(w.y);
            o[8 * c + 4] = o[8 * c + 4] * corr + p * bflo(w.z); o[8 * c + 5] = o[8 * c + 5] * corr + p * bfhi(w.z); o[8 * c + 6] = o[8 * c + 6] * corr + p * bflo(w.w); o[8 * c + 7] = o[8 * c + 7] * corr + p * bfhi(w.w); }
    }
    if (TYPE == 1) { const float sk = args.in[6][l * 8 + h] * LOG2E; lsum += __builtin_amdgcn_exp2f(sk - mx); }
    const float inv = 1.0f / lsum;
    bf16* od = TYPE == 2 ? P1 + row * P1W + C_CQ + 64 * h : (bf16*)qsrc;
#pragma unroll
    for (int c = 0; c < 8; ++c) { u32x4 w; w.x = pk2(o[8 * c + 0] * inv, o[8 * c + 1] * inv); w.y = pk2(o[8 * c + 2] * inv, o[8 * c + 3] * inv); w.z = pk2(o[8 * c + 4] * inv, o[8 * c + 5] * inv); w.w = pk2(o[8 * c + 6] * inv, o[8 * c + 7] * inv);
        *(u32x4*)(od + 8 * c) = w; }
}


typedef float f32x16 __attribute__((ext_vector_type(16)));
typedef short s16x4 __attribute__((ext_vector_type(4)));
typedef short v4i16_t __attribute__((ext_vector_type(4)));
constexpr int ATT_TBL_OFF = 104448;
constexpr float ATT_NEG = -1.0e30f, ATT_THR = 6.0f;
DI s16x4 vtr(const LAS unsigned char* p) { return __builtin_bit_cast(s16x4, __builtin_amdgcn_ds_read_tr16_b64_v4i16((LAS v4i16_t*)p)); }
DI float max3f(float a, float b, float c) { float r; asm("v_max3_f32 %0, %1, %2, %3" : "=v"(r) : "v"(a), "v"(b), "v"(c)); return r; }
DI float half_max(float v) { auto rr = __builtin_amdgcn_permlane32_swap(__float_as_uint(v), __float_as_uint(v), false, false); return fmaxf(__uint_as_float(rr[0]), __uint_as_float(rr[1])); }
DI float half_sum(float v) { auto rr = __builtin_amdgcn_permlane32_swap(__float_as_uint(v), __float_as_uint(v), false, false); return __uint_as_float(rr[0]) + __uint_as_float(rr[1]); }
DI bf16x8 pack8(const float (&f)[8]) { u32x4 w; w.x = cvt_pk_bf16(f[0], f[1]); w.y = cvt_pk_bf16(f[2], f[3]); w.z = cvt_pk_bf16(f[4], f[5]); w.w = cvt_pk_bf16(f[6], f[7]); return __builtin_bit_cast(bf16x8, w); }
DI void unpack8(const u32x4 w, float (&f)[8]) { f[0] = bflo(w.x); f[1] = bfhi(w.x); f[2] = bflo(w.y); f[3] = bfhi(w.y); f[4] = bflo(w.z); f[5] = bfhi(w.z); f[6] = bflo(w.w); f[7] = bfhi(w.w); }

template <int TYPE>
DI void attn_unit(LAS unsigned char* lds, const int tid, const int l, const int b, const int hg, const int qt, bf16* P1, const bf16* QC, const bf16* KVC, const f32x2* ROPE, const float* RSTDQ, const float* gq, const float* sinkp) {
    constexpr int DQ = TYPE == 2 ? 96 : 64, NS = DQ / 16, KS = DQ * 2 + 16, VS = 192, KBUF = 64 * KS, VBUF = 64 * VS;
    const int lane = tid & 63, wave = __builtin_amdgcn_readfirstlane(tid >> 6), r = lane & 31, h = lane >> 5;
    const int head = TYPE == 2 ? hg : hg * 4 + (wave & 3);
    const int q0 = TYPE == 2 ? qt * 256 + wave * 32 : qt * 64 + (wave >> 2) * 32;
    const int tq = q0 + r;
    const size_t qrow = (size_t)b * SEQ + tq;
    bf16x8 qf[NS];
    {
        float q[NS][8];
        const bf16* qsrc = TYPE == 0 ? P1 + qrow * P1W + C_QA + 64 * head : TYPE == 1 ? P1 + qrow * P1W + C_QB + 64 * head : QC + qrow * QCW + 96 * head;
#pragma unroll
        for (int s = 0; s < NS; ++s) unpack8(*(const u32x4*)(qsrc + 16 * s + 8 * h), q[s]);
        if (TYPE == 0) {
            float ss = 0.f;
#pragma unroll
            for (int s = 0; s < 4; ++s)
#pragma unroll
                for (int j = 0; j < 8; ++j) ss += q[s][j] * q[s][j];
            ss = half_sum(ss);
            const float rn = 1.0f / sqrtf(ss * (1.0f / 64.0f) + EPS) * C2_64;
#pragma unroll
            for (int s = 0; s < 4; ++s)
#pragma unroll
                for (int j = 0; j < 8; ++j) q[s][j] *= rn * gq[16 * s + 8 * h + j];
            const int gr = tq >> 6, gc = tq & 63;
#pragma unroll
            for (int j = 0; j < 8; ++j) { const f32x2 cr = ROPE[gr * 16 + 8 * h + j], cc = ROPE[gc * 16 + 8 * h + j];
                const float a1 = q[0][j], a2 = q[1][j]; q[0][j] = a1 * cr.x - a2 * cr.y; q[1][j] = a2 * cr.x + a1 * cr.y;
                const float b1 = q[2][j], b2 = q[3][j]; q[2][j] = b1 * cc.x - b2 * cc.y; q[3][j] = b2 * cc.x + b1 * cc.y; }
        } else if (TYPE == 1) {
#pragma unroll
            for (int s = 0; s < 4; ++s)
#pragma unroll
                for (int j = 0; j < 8; ++j) q[s][j] *= C2_64;
        } else {
            const float rs = RSTDQ[qrow] * C2_96;
#pragma unroll
            for (int s = 0; s < NS; ++s)
#pragma unroll
                for (int j = 0; j < 8; ++j) q[s][j] *= rs;
#pragma unroll
            for (int j = 0; j < 8; ++j) { const f32x2 cs = ROPE[tq * 16 + 8 * h + j]; const float a1 = q[NS - 2][j], a2 = q[NS - 1][j]; q[NS - 2][j] = a1 * cs.x - a2 * cs.y; q[NS - 1][j] = a2 * cs.x + a1 * cs.y; }
        }
#pragma unroll
        for (int s = 0; s < NS; ++s) qf[s] = pack8(q[s]);
    }
    const int kvh = TYPE == 2 ? 0 : hg;
    const bf16* Kg = TYPE == 0 ? P1 + C_KA + 64 * kvh : TYPE == 1 ? P1 + C_KB + 64 * kvh : KVC + 128 * head;
    const bf16* Vg = TYPE == 0 ? P1 + C_VA + 64 * kvh : TYPE == 1 ? P1 + C_VB + 64 * kvh : KVC + 128 * head + 64;
    const int kvp = TYPE == 2 ? KVW : P1W;
    const int kt_lo = TYPE == 1 ? (qt - 2 < 0 ? 0 : qt - 2) : 0, kt_hi = TYPE == 1 ? (qt + 2 > 31 ? 31 : qt + 2) : 31, nt = kt_hi - kt_lo + 1;
    const int lkey = tid >> 3, lch = tid & 7, pkey = (tid >> 2) & 63, pch = tid & 3;
    const size_t brow = (size_t)b * SEQ;
    u32x4 kreg, vreg, preg = (u32x4){0u, 0u, 0u, 0u};
    constexpr int SLOT = KBUF + VBUF;
#define ATT_LOAD(kt) do { const size_t kr_ = brow + (size_t)(kt) * 64 + lkey; kreg = *(const u32x4*)(Kg + kr_ * kvp + lch * 8); vreg = *(const u32x4*)(Vg + kr_ * kvp + lch * 8); \
        if (TYPE == 2 && tid < 256) preg = *(const u32x4*)(P1 + (brow + (size_t)(kt) * 64 + pkey) * P1W + C_KR + pch * 8); } while (0)
#define ATT_STORE(so) do { *(LAS u32x4*)(lds + (so) + lkey * KS + lch * 16) = kreg; *(LAS u32x4*)(lds + (so) + KBUF + lkey * VS + lch * 16) = vreg; \
        if (TYPE == 2 && tid < 256) *(LAS u32x4*)(lds + (so) + pkey * KS + 128 + pch * 16) = preg; } while (0)
    const int koff = r * KS + h * 16;
    const int voff = KBUF + (4 * h + ((lane & 15) >> 2)) * VS + ((lane >> 4) & 1) * 32 + (lane & 3) * 8;
    const int tboff = ATT_TBL_OFF + head * 1536 + (192 + 4 * h - tq) * 4;
    constexpr bool REL = (NS == 4);
    f32x16 o0, o1, negm, zero16;
#pragma unroll
    for (int i = 0; i < 16; ++i) { o0[i] = 0.f; o1[i] = 0.f; negm[i] = 0.f; zero16[i] = 0.f; }
    float m_run = 0.f, l_run = 0.f;
    int s_cur = 0, s_nxt = SLOT, s_nn = 2 * SLOT, s_n3 = 3 * SLOT;
    bf16x8 kfr[2 * NS]; s16x4 vlo[8], vhi[8]; bf16x8 pf[4];
#define ATT_KREAD(so, S0, S1) do { const LAS unsigned char* Kb_ = lds + (so) + koff; \
        _Pragma("unroll") for (int s = S0; s < S1; ++s) { kfr[2 * s] = *(const LAS bf16x8*)(Kb_ + s * 32); kfr[2 * s + 1] = *(const LAS bf16x8*)(Kb_ + 32 * KS + s * 32); } } while (0)
#define ATT_VREAD(so, K0, K1) do { const LAS unsigned char* Vb_ = lds + (so) + voff; \
        _Pragma("unroll") for (int kk = K0; kk < K1; ++kk) { vlo[2 * kk] = vtr(Vb_ + kk * 16 * VS); vhi[2 * kk] = vtr(Vb_ + kk * 16 * VS + 8 * VS); vlo[2 * kk + 1] = vtr(Vb_ + kk * 16 * VS + 64); vhi[2 * kk + 1] = vtr(Vb_ + kk * 16 * VS + 8 * VS + 64); } } while (0)
#define ATT_VF(i) (bf16x8){vlo[i][0], vlo[i][1], vlo[i][2], vlo[i][3], vhi[i][0], vhi[i][1], vhi[i][2], vhi[i][3]}
#define ATT_QKM(N0, N1, j) do { if (((j) & 1) == 0) N0 = __builtin_amdgcn_mfma_f32_32x32x16_bf16(kfr[j], qf[(j) >> 1], ((j) >> 1) == 0 ? (REL ? negm : zero16) : N0, 0, 0, 0); \
        else N1 = __builtin_amdgcn_mfma_f32_32x32x16_bf16(kfr[j], qf[(j) >> 1], ((j) >> 1) == 0 ? (REL ? negm : zero16) : N1, 0, 0, 0); } while (0)
#define ATT_EXP4(C, c, PFW, wlo) do { const float sh_ = REL ? 0.f : m_run; const float e0 = __builtin_amdgcn_exp2f(C[4 * (c)] - sh_), e1 = __builtin_amdgcn_exp2f(C[4 * (c) + 1] - sh_), e2 = __builtin_amdgcn_exp2f(C[4 * (c) + 2] - sh_), e3 = __builtin_amdgcn_exp2f(C[4 * (c) + 3] - sh_); \
        lsa += e0; lsb += e1; lsa += e2; lsb += e3; if (wlo) { PFW.x = cvtpk(e0, e1); PFW.y = cvtpk(e2, e3); } else { PFW.z = cvtpk(e0, e1); PFW.w = cvtpk(e2, e3); } } while (0)
#define ATT_BIAS(N0, N1, tt) do { if (TYPE == 1) { const LAS float* tb = (const LAS float*)(lds + tboff + (kt_lo + (tt)) * 256); \
        _Pragma("unroll") for (int i = 0; i < 16; ++i) { N0[i] += tb[(i & 3) + 8 * (i >> 2)]; N1[i] += tb[32 + (i & 3) + 8 * (i >> 2)]; } } } while (0)
#define ATT_BIAS4(N0, N1, tt, c) do { if (TYPE == 1) { const volatile LAS float* tb = (const volatile LAS float*)(lds + tboff + (kt_lo + (tt)) * 256 + 32 * (c)); \
        _Pragma("unroll") for (int i = 0; i < 4; ++i) { N0[4 * (c) + i] += tb[i]; N1[4 * (c) + i] += tb[32 + i]; } } } while (0)
#define PIN2(a_, b_) asm volatile("" : "+v"(a_), "+v"(b_))
#define PIN3(a_, b_, c_) asm volatile("" : "+v"(a_), "+v"(b_), "+v"(c_))
#define PIN4(a_, b_, c_, d_) asm volatile("" : "+v"(a_), "+v"(b_), "+v"(c_), "+v"(d_))
#define ATT_MAX4(N0, N1, c, acc) do { if (TYPE == 1) { acc = fmaxf(acc, fmaxf(fmaxf(N0[4 * (c)], N0[4 * (c) + 1]), fmaxf(N0[4 * (c) + 2], N0[4 * (c) + 3]))); acc = fmaxf(acc, fmaxf(fmaxf(N1[4 * (c)], N1[4 * (c) + 1]), fmaxf(N1[4 * (c) + 2], N1[4 * (c) + 3]))); } \
        else { acc = max3f(acc, N0[4 * (c)], N0[4 * (c) + 1]); acc = max3f(acc, N0[4 * (c) + 2], N0[4 * (c) + 3]); acc = max3f(acc, N1[4 * (c)], N1[4 * (c) + 1]); acc = max3f(acc, N1[4 * (c) + 2], N1[4 * (c) + 3]); } } while (0)
    {
        u32x4 k0_, v0_, p0_ = (u32x4){0u, 0u, 0u, 0u}, k1_, v1_, p1_ = p0_;
        ATT_LOAD(kt_lo); k0_ = kreg; v0_ = vreg; p0_ = preg;
        ATT_LOAD(kt_lo + 1); k1_ = kreg; v1_ = vreg; p1_ = preg;
        ATT_LOAD(kt_lo + 2);
        { const u32x4 k2_ = kreg, v2_ = vreg, p2_ = preg;
          if (nt > 3) ATT_LOAD(kt_lo + 3);
          const u32x4 k3_ = kreg, v3_ = vreg, p3_ = preg;
          kreg = k0_; vreg = v0_; preg = p0_; ATT_STORE(0);
          kreg = k1_; vreg = v1_; preg = p1_; ATT_STORE(SLOT);
          kreg = k2_; vreg = v2_; preg = p2_; ATT_STORE(2 * SLOT);
          kreg = k3_; vreg = v3_; preg = p3_; }
    }
    __syncthreads();
    f32x16 sa0, sa1, sb0, sb1; float tmx;
    ATT_KREAD(0, 0, NS);
#pragma unroll
    for (int j = 0; j < 2 * NS; ++j) ATT_QKM(sa0, sa1, j);
    ATT_BIAS(sa0, sa1, 0);
    tmx = ATT_NEG;
#pragma unroll
    for (int c = 0; c < 4; ++c) tmx = fmaxf(tmx, fmaxf(fmaxf(fmaxf(sa0[4 * c], sa0[4 * c + 1]), fmaxf(sa0[4 * c + 2], sa0[4 * c + 3])), fmaxf(fmaxf(sa1[4 * c], sa1[4 * c + 1]), fmaxf(sa1[4 * c + 2], sa1[4 * c + 3]))));
    tmx = half_max(tmx);
    m_run = tmx;
    if (REL) {
#pragma unroll
        for (int i = 0; i < 16; ++i) { sa0[i] -= m_run; sa1[i] -= m_run; negm[i] = -m_run; }
        tmx = 0.f; }
    constexpr int KP = 0;
    if (KP > 0 && nt > 1) ATT_KREAD(SLOT, 0, KP);
#define ATT_STEP(C0, C1, N0, N1, t, FULL, PRE) do { \
        if (FULL) ATT_KREAD(s_nxt, KP, 4); \
        if (__any(tmx > (REL ? 0.f : m_run) + ATT_THR)) { const float dl = fmaxf(tmx - (REL ? 0.f : m_run), 0.f), al = __builtin_amdgcn_exp2f(-dl); m_run += dl; l_run *= al; \
            _Pragma("unroll") for (int i = 0; i < 16; ++i) { o0[i] *= al; o1[i] *= al; } \
            if (REL) { _Pragma("unroll") for (int i = 0; i < 16; ++i) { C0[i] -= dl; C1[i] -= dl; negm[i] = -m_run; } } } \
        float lsa = 0.f, lsb = 0.f; u32x4 w0_ = (u32x4){0u, 0u, 0u, 0u}, w1_ = w0_, w2_ = w0_, w3_ = w0_; \
        if (FULL) ATT_QKM(N0, N1, 0); ATT_EXP4(C0, 0, w0_, true);  if (FULL) { PIN4(N0, lsa, lsb, w0_); } else { PIN3(lsa, lsb, w0_); } \
        if (FULL) ATT_QKM(N0, N1, 1); ATT_EXP4(C0, 1, w0_, false); if (FULL) { PIN4(N1, lsa, lsb, w0_); } else { PIN3(lsa, lsb, w0_); } \
        if (FULL) ATT_QKM(N0, N1, 2); ATT_EXP4(C0, 2, w1_, true);  if (FULL) { PIN4(N0, lsa, lsb, w1_); } else { PIN3(lsa, lsb, w1_); } \
        if (FULL) ATT_QKM(N0, N1, 3); ATT_EXP4(C0, 3, w1_, false); if (FULL && NS > 4) ATT_KREAD(s_nxt, 4, NS); ATT_VREAD(s_cur, 0, 2); if (FULL) { PIN4(N1, lsa, lsb, w1_); } else { PIN3(lsa, lsb, w1_); } \
        if (FULL) ATT_QKM(N0, N1, 4); ATT_EXP4(C1, 0, w2_, true);  if (FULL) { PIN4(N0, lsa, lsb, w2_); } else { PIN3(lsa, lsb, w2_); } \
        if (FULL) ATT_QKM(N0, N1, 5); ATT_EXP4(C1, 1, w2_, false); if (FULL) { PIN4(N1, lsa, lsb, w2_); } else { PIN3(lsa, lsb, w2_); } \
        if (FULL) ATT_QKM(N0, N1, 6); ATT_EXP4(C1, 2, w3_, true);  if (FULL) { PIN4(N0, lsa, lsb, w3_); } else { PIN3(lsa, lsb, w3_); } \
        if (FULL) ATT_QKM(N0, N1, 7); ATT_EXP4(C1, 3, w3_, false); if (FULL) { PIN4(N1, lsa, lsb, w3_); } else { PIN3(lsa, lsb, w3_); } \
        if (FULL && NS > 4) { ATT_QKM(N0, N1, 8); ATT_QKM(N0, N1, 9); ATT_QKM(N0, N1, 10); ATT_QKM(N0, N1, 11); } \
        ATT_VREAD(s_cur, 2, 4); \
        if ((t) + 3 < nt) ATT_STORE(s_n3); \
        if ((t) + 4 < nt) ATT_LOAD(kt_lo + (t) + 4); \
        l_run += lsa + lsb; \
        pf[0] = __builtin_bit_cast(bf16x8, w0_); pf[1] = __builtin_bit_cast(bf16x8, w1_); pf[2] = __builtin_bit_cast(bf16x8, w2_); pf[3] = __builtin_bit_cast(bf16x8, w3_); \
        tmx = ATT_NEG; \
        o0 = __builtin_amdgcn_mfma_f32_32x32x16_bf16(ATT_VF(0), pf[0], o0, 0, 0, 0); if (KP > 0 && PRE) ATT_KREAD(s_nn, 0, KP); PIN2(o0, tmx); \
        o1 = __builtin_amdgcn_mfma_f32_32x32x16_bf16(ATT_VF(1), pf[0], o1, 0, 0, 0); PIN2(o1, tmx); \
        o0 = __builtin_amdgcn_mfma_f32_32x32x16_bf16(ATT_VF(2), pf[1], o0, 0, 0, 0); PIN2(o0, tmx); \
        o1 = __builtin_amdgcn_mfma_f32_32x32x16_bf16(ATT_VF(3), pf[1], o1, 0, 0, 0); if (FULL) { ATT_BIAS4(N0, N1, (t) + 1, 0); ATT_MAX4(N0, N1, 0, tmx); } PIN2(o1, tmx); \
        o0 = __builtin_amdgcn_mfma_f32_32x32x16_bf16(ATT_VF(4), pf[2], o0, 0, 0, 0); if (FULL) { ATT_BIAS4(N0, N1, (t) + 1, 1); ATT_MAX4(N0, N1, 1, tmx); } PIN2(o0, tmx); \
        o1 = __builtin_amdgcn_mfma_f32_32x32x16_bf16(ATT_VF(5), pf[2], o1, 0, 0, 0); if (FULL) { ATT_BIAS4(N0, N1, (t) + 1, 2); ATT_MAX4(N0, N1, 2, tmx); } PIN2(o1, tmx); \
        o0 = __builtin_amdgcn_mfma_f32_32x32x16_bf16(ATT_VF(6), pf[3], o0, 0, 0, 0); if (FULL) { ATT_BIAS4(N0, N1, (t) + 1, 3); ATT_MAX4(N0, N1, 3, tmx); } PIN2(o0, tmx); \
        o1 = __builtin_amdgcn_mfma_f32_32x32x16_bf16(ATT_VF(7), pf[3], o1, 0, 0, 0); PIN2(o1, tmx); \
        if (FULL) tmx = half_max(tmx); \
        asm volatile("s_waitcnt lgkmcnt(0)\n\ts_barrier" ::: "memory");     \
        { const int tmp_ = s_cur; s_cur = s_nxt; s_nxt = s_nn; s_nn = s_n3; s_n3 = tmp_; } \
    } while (0)
    int t = 0;
    for (; t + 1 < nt; t += 2) { ATT_STEP(sa0, sa1, sb0, sb1, t, true, true); ATT_STEP(sb0, sb1, sa0, sa1, t + 1, true, true); }
    if (t < nt) { ATT_STEP(sa0, sa1, sb0, sb1, t, true, true); }
#undef ATT_STEP
#undef ATT_MAX4
#undef PIN2
#undef PIN3
#undef PIN4
#undef ATT_BIAS
#undef ATT_BIAS4
#undef ATT_EXP4
#undef ATT_QKM
#undef ATT_VF
#undef ATT_VREAD
#undef ATT_KREAD
#undef ATT_LOAD
#undef ATT_STORE
    float lt = half_sum(l_run);
    if (TYPE == 1) lt += __builtin_amdgcn_exp2f(sinkp[head] * LOG2E - m_run);
    const float inv = 1.0f / lt;
    bf16* od = P1 + qrow * P1W + (TYPE == 0 ? C_QA : TYPE == 1 ? C_QB : C_CQ) + 64 * head + 4 * h;
#pragma unroll
    for (int g = 0; g < 4; ++g) {
        *(u32x2*)(od + 8 * g) = (u32x2){cvt_pk_bf16(o0[4 * g] * inv, o0[4 * g + 1] * inv), cvt_pk_bf16(o0[4 * g + 2] * inv, o0[4 * g + 3] * inv)};
        *(u32x2*)(od + 32 + 8 * g) = (u32x2){cvt_pk_bf16(o1[4 * g] * inv, o1[4 * g + 1] * inv), cvt_pk_bf16(o1[4 * g + 2] * inv, o1[4 * g + 3] * inv)};
    }
}

constexpr int NPH = 1 + 11 * DEPTH;
__global__ void __launch_bounds__(512, 2) fwd_kernel(Args args) {
    extern __shared__ __attribute__((aligned(16))) unsigned char lds_raw[];
    LAS unsigned char* lds = (LAS unsigned char*)lds_raw;
    volatile LAS unsigned* MISC = (volatile LAS unsigned*)(lds + LDSCTL_OFF);
    const int tid0 = threadIdx.x, wave = __builtin_amdgcn_readfirstlane(tid0 >> 6);
    const int G = gridDim.x, bx = blockIdx.x;
    const int gw = bx * 8 + wave, NGW = G * 8;
    unsigned char* const ws0 = args.ws; unsigned char* const out0 = (unsigned char*)args.out;
    for (int u = tid0; u < (LDS_BYTES - LDSCTL_OFF) / 4; u += 512) MISC[u] = 0u;
    __syncthreads();
    XcdBarrier bar; bar.bar = (unsigned*)(ws0 + WS_CTL) + CW_BAR; bar.x = 0; bar.st = nullptr;
#if ONE_LAUNCH
    bar = xcd_barrier_post((unsigned*)(ws0 + WS_CTL) + CW_BAR, MISC + 8);
#endif
    const int lo = args.ph_lo, hi = args.ph_hi;
#define IN(k) (lo <= (k) && (k) < hi)
#define SEAM(k) do { if (IN(k) && IN((k) + 1)) { if (ONE_LAUNCH) xcd_barrier(bar); } } while (0)

#define PHASE_BEGIN \
    unsigned ones_ = ~0u; asm volatile("" : "+s"(ones_)); \
    int tid = wave * 64 + (int)__builtin_amdgcn_mbcnt_hi(ones_, __builtin_amdgcn_mbcnt_lo(ones_, 0u)); asm volatile("" : "+v"(tid)); const int lane = tid & 63; \
    size_t zoff = 0; asm volatile("" : "+s"(zoff)); unsigned char* ws = ws0 + zoff; unsigned char* outb = out0 + zoff; \
    unsigned* ctl = (unsigned*)(ws + WS_CTL); (void)ctl; (void)lane; \
    bf16* XB = (bf16*)(ws + WS_XB); bf16* P1 = (bf16*)(ws + WS_P1); bf16* GB = (bf16*)(ws + WS_G); (void)XB; (void)P1; (void)GB; \
    bf16* QC = (bf16*)(outb + DO_QC); bf16* KVC = (bf16*)(outb + DO_KVC); bf16* MG = KVC; (void)QC; (void)KVC; (void)MG; \
    bf16* Y = (bf16*)(ws + WS_G); bf16* HID = (bf16*)(ws + WS_P1); bf16* PAIR = (bf16*)(ws + WS_G); (void)Y; (void)HID; (void)PAIR; \
    unsigned char* Wb = ws + WS_W; (void)Wb; \
    f32x2* ROPE = (f32x2*)(ws + WS_ROPE); float* TB = (float*)(ws + WS_TB); (void)ROPE; (void)TB; \
    float* RSTDQ = (float*)(ws + WS_RSTDQ); float* RSTDKV = (float*)(ws + WS_RSTDKV); (void)RSTDQ; (void)RSTDKV; \
    int* LIST = (int*)(ws + WS_LIST); unsigned* ROUTE = (unsigned*)(ws + WS_ROUTE); (void)LIST; (void)ROUTE;

    if (EN(11) && IN(0)) { PHASE_BEGIN
        for (int idx = bx * 512 + tid; idx < 2048 * 16; idx += G * 512) { const int pos = idx >> 4, i = idx & 15; float c, s; cos_sin((double)pos * (double)inv_freq16(i), c, s); ROPE[idx] = (f32x2){c, s}; }
        for (int idx = bx * 512 + tid; idx < 8 * 257; idx += G * 512) { const int h = idx / 257, r = idx % 257, rel = r - 128; const int n = rel < 0 ? -rel : rel;
            const int bk = t5_bucket_n(n) + (rel > 0 ? 16 : 0); TB[h * 260 + r] = args.in[7][bk * 8 + h] * LOG2E; }
        const float* g = args.in[1]; const float* bb = args.in[2];
        f32x4 gv[4], bv[4];
#pragma unroll
        for (int j = 0; j < 4; ++j) { gv[j] = *(const f32x4*)(g + 256 * j + 4 * lane); bv[j] = *(const f32x4*)(bb + 256 * j + 4 * lane); }
        f32x4 xnx[4];
#pragma unroll
        for (int j = 0; j < 4; ++j) xnx[j] = *(const f32x4*)(args.in[0] + (size_t)(gw < NTOK ? gw : 0) * DM + 256 * j + 4 * lane);
        for (int m = gw; m < NTOK; m += NGW) {
            f32x4 v[4]; float s = 0.f;
#pragma unroll
            for (int j = 0; j < 4; ++j) { v[j] = xnx[j]; s += (v[j].x + v[j].y) + (v[j].z + v[j].w); }
            if (m + NGW < NTOK) {
#pragma unroll
                for (int j = 0; j < 4; ++j) xnx[j] = *(const f32x4*)(args.in[0] + (size_t)(m + NGW) * DM + 256 * j + 4 * lane); }
            const float mean = wave_sum(s) * (1.f / DM); float s2 = 0.f;
#pragma unroll
            for (int j = 0; j < 4; ++j) { v[j] = v[j] - mean; s2 += (v[j].x * v[j].x + v[j].y * v[j].y) + (v[j].z * v[j].z + v[j].w * v[j].w); }
            const float rstd = 1.f / sqrtf(wave_sum(s2) * (1.f / DM) + EPS);
#pragma unroll
            for (int j = 0; j < 4; ++j) { const f32x4 o = v[j] * rstd * gv[j] + bv[j]; *(u32x2*)(XB + (size_t)m * DM + 256 * j + 4 * lane) = (u32x2){pk2(o.x, o.y), pk2(o.z, o.w)}; }
        }
    }

    for (int l = 0; l < DEPTH; ++l) {
        const int pb = 1 + 11 * l;
        if (EN(0) && IN(pb + 0)) for (int rep_ = 0; rep_ < REPS_0; ++rep_) { PHASE_BEGIN
            LAS float* scr = (LAS float*)(lds + wave * 16384);
            const float* w_in = args.in[3] + (size_t)l * DM * INCOLS;
            const float* w_uq = args.in[10] + (size_t)l * 384 * 768; const float* w_ukv = args.in[11] + (size_t)l * 256 * 1024;
            const float* w_o = args.in[15] + (size_t)l * 1024 * 1024;
            const float* w_gate = args.in[20] + (size_t)l * 16 * 1024 * 512; const float* w_up = args.in[21] + (size_t)l * 16 * 1024 * 512; const float* w_down = args.in[22] + (size_t)l * 16 * 512 * 1024;
            const float* g_cq = args.in[8] + l * 384; const float* g_ckv = args.in[9] + l * 256;
            constexpr int I0 = 16 * 165, I1 = 6 * 24, I2 = 4 * 32, I3 = 8 * 32, I6 = 16 * 32, I7 = 16 * 16 * 16, I9 = 16 * 8 * 32;
            constexpr int NIT = I0 + I1 + I2 + 3 * I3 + I6 + 2 * I7 + I9;
            for (int it = gw; it < NIT; it += NGW) {
                int r = it;
                if (r < I0) { const int kb = r / 165, nb = r % 165; transpose_item(w_in, INCOLS, 64 * kb, 32 * nb, (bf16*)(Wb + W_WIN), 1024, 32 * (nb < 69 ? nb : nb + 3), nullptr, scr, lane); continue; } r -= I0;
                if (r < I1) { const int kb = r / 24, nb = r % 24; transpose_item(w_uq, 768, 64 * kb, 32 * nb, (bf16*)(Wb + W_WUP), 1024, 32 * nb, g_cq, scr, lane); continue; } r -= I1;
                if (r < I2) { const int kb = r / 32, nb = r % 32; transpose_item(w_ukv, 1024, 64 * kb, 32 * nb, (bf16*)(Wb + W_WUP), 1024, 768 + 32 * nb, g_ckv, scr, lane); continue; } r -= I2;
                if (r < 3 * I3) { const int j = r / I3, q = r % I3, kb = q / 32, nb = q % 32; transpose_item((j == 0 ? args.in[12] : j == 1 ? args.in[13] : args.in[14]) + (size_t)l * 512 * 1024, 1024, 64 * kb, 32 * nb, (bf16*)(Wb + W_WBR) + (size_t)j * 1024 * 512, 512, 32 * nb, nullptr, scr, lane); continue; } r -= 3 * I3;
                if (r < I6) { const int kb = r / 32, nb = r % 32; transpose_item(w_o, 1024, 64 * kb, 32 * nb, (bf16*)(Wb + W_WO), 1024, 32 * nb, nullptr, scr, lane); continue; } r -= I6;
                if (r < 2 * I7) { const int up = r / I7, q = r % I7, e = q / 256, kb = (q % 256) / 16, nb = q % 16;
                    transpose_item((up ? w_up : w_gate) + (size_t)e * 1024 * 512, 512, 64 * kb, 32 * nb, (bf16*)(Wb + W_WGU) + (size_t)e * 1024 * 1024, 1024, 32 * ((nb >> 2) * 8 + up * 4 + (nb & 3)), nullptr, scr, lane); continue; } r -= 2 * I7;
                { const int e = r / 256, kb = (r % 256) / 32, nb = r % 32; transpose_item(w_down + (size_t)e * 512 * 1024, 1024, 64 * kb, 32 * nb, (bf16*)(Wb + W_WD) + (size_t)e * 1024 * 512, 512, 32 * nb, nullptr, scr, lane); }
            }
            { unsigned zu = 0u; asm volatile("" : "+v"(zu));
              for (int idx = bx * 512 + tid; idx < 96 * 1024 / 8; idx += G * 512) *(u32x4*)((bf16*)(Wb + W_WIN) + (size_t)2208 * 1024 + (size_t)idx * 8) = (u32x4){zu, zu, zu, zu}; }
        }
        SEAM(pb + 0);

        if (EN(1) && IN(pb + 1)) for (int rep_ = 0; rep_ < REPS_1; ++rep_) { PHASE_BEGIN
            pg8::SchedPlain S; S.o.init(NTOK / 256, INW / 256 - 1, G, bx); S.A = (const char*)XB; S.Bt = (const char*)(Wb + W_WIN);
            S.lda2 = 2048; S.ldb2 = 2048;
            pg8::EpiInproj E{P1, (unsigned char*)GB};
            pg8::gemm_phase<pg8::EpiInproj, pg8::SchedPlain, true>(lds, tid, 1024, 2048, S, E);
        }
        SEAM(pb + 1);

        if (EN(2) && IN(pb + 2)) { PHASE_BEGIN
            const float* gk = args.in[5] + l * 64;
            const float gk0 = gk[2 * (lane & 31)], gk1 = gk[2 * (lane & 31) + 1];
            for (int m0 = gw; m0 < NTOK; m0 += 4 * NGW) {
                unsigned wka[4], wq[4][3], wk[4][2]; float vkr[4];
#pragma unroll
                for (int q = 0; q < 4; ++q) { const int m = m0 + q * NGW < NTOK ? m0 + q * NGW : m0; const bf16* pr = P1 + (size_t)m * P1W;
                    wka[q] = *(const unsigned*)(pr + C_KA + 2 * lane); vkr[q] = lane < 32 ? bf2f(pr[C_KR + lane]) : 0.f;
#pragma unroll
                    for (int j = 0; j < 3; ++j) wq[q][j] = *(const unsigned*)(pr + C_CQ + 128 * j + 2 * lane);
#pragma unroll
                    for (int j = 0; j < 2; ++j) wk[q][j] = *(const unsigned*)(pr + C_CKV + 128 * j + 2 * lane); }
#pragma unroll
                for (int q = 0; q < 4; ++q) { const int m = m0 + q * NGW; if (m < NTOK) {
                    bf16* pr = P1 + (size_t)m * P1W; const int t = m & (SEQ - 1), gr = t >> 6, gc = t & 63;
                    {
                        const int ll = lane & 31; float a = bflo(wka[q]), b = bfhi(wka[q]);
                        float ss = sum32(a * a + b * b);
                        const float r = 1.0f / sqrtf(ss * (1.0f / 64.0f) + EPS); const int d = 2 * ll; a = a * r * gk0; b = b * r * gk1;
                        const float pa = swz_xor<8>(a), pbv = swz_xor<8>(b);
                        const int pos = ll < 16 ? gr : gc, i0 = d & 15; const f32x2 c0 = ROPE[pos * 16 + i0], c1 = ROPE[pos * 16 + i0 + 1];
                        const bool first = (ll & 8) == 0;
                        const float oa = first ? a * c0.x - pa * c0.y : a * c0.x + pa * c0.y, ob = first ? b * c1.x - pbv * c1.y : b * c1.x + pbv * c1.y;
                        *(unsigned*)(pr + C_KA + 2 * lane) = pk2(oa, ob);
                    }
                    {
                        const float v = vkr[q]; const float p = swz_xor<16>(v);
                        const f32x2 cs = ROPE[t * 16 + (lane & 15)]; const float o = (lane < 16) ? v * cs.x - p * cs.y : v * cs.x + p * cs.y;
                        if (lane < 32) pr[C_KR + lane] = (bf16)f2bf(o);
                    }
                    {
                        float sq = 0.f, sk = 0.f;
#pragma unroll
                        for (int j = 0; j < 3; ++j) sq += bflo(wq[q][j]) * bflo(wq[q][j]) + bfhi(wq[q][j]) * bfhi(wq[q][j]);
#pragma unroll
                        for (int j = 0; j < 2; ++j) sk += bflo(wk[q][j]) * bflo(wk[q][j]) + bfhi(wk[q][j]) * bfhi(wk[q][j]);
                        sq = wave_sum(sq); sk = wave_sum(sk);
                        if (lane == 0) { RSTDQ[m] = 1.0f / sqrtf(sq * (1.0f / 384.0f) + EPS); RSTDKV[m] = 1.0f / sqrtf(sk * (1.0f / 256.0f) + EPS); }
                    } } }
            }
        }
        SEAM(pb + 2);

        if (EN(3) && IN(pb + 3)) for (int rep_ = 0; rep_ < REPS_3; ++rep_) { PHASE_BEGIN
            pg8::SchedUp S; S.G = G; S.c = bx; S.wsb = (const char*)ws; S.lda2 = P1W * 2;
            pg8::EpiUp E{QC, KVC, RSTDKV, (unsigned char*)GB};
            pg8::gemm_phase<pg8::EpiUp, pg8::SchedUp, true>(lds, tid, 384, 2048, S, E);
        }
        SEAM(pb + 3);

        if (EN(4) && IN(pb + 4)) { PHASE_BEGIN
#if ((ATTN_FAST & 7) != 7) && !defined(ATT_NO_NAIVE)
            for (int it = bx * 512 + tid; it < 3 * NBATCH * 8 * SEQ; it += G * 512) {
                const int t = it & (SEQ - 1), h = (it >> 11) & 7, b = (it >> 14) & 15, ty = it >> 18;
                if (ty == 0) { if (!(ATTN_FAST & 1)) naive_attn_item<0>(args, l, b, h, t); } else if (ty == 1) { if (!(ATTN_FAST & 2)) naive_attn_item<1>(args, l, b, h, t); } else { if (!(ATTN_FAST & 4)) naive_attn_item<2>(args, l, b, h, t); }
            }
            __syncthreads();
#endif
            const int xcd = bx & 7, idx = bx >> 3;
            const float* gq = args.in[4] + l * 64; const float* sinkp = args.in[6] + l * 8;
#if ATTN_FAST & 2
            for (int j = tid; j < 8 * 384; j += 512) { const int hh = j / 384, rel = j % 384 - 192; ((LAS float*)(lds + ATT_TBL_OFF))[j] = (rel >= -128 && rel <= 128) ? TB[hh * 260 + rel + 128] : ATT_NEG; }
            __syncthreads();
#endif
#if ATTN_FAST & 4
            for (int i = 0; ; ++i) { const int L = i * G + bx; if (L >= 1024 * REPS_4C) break;
                int u = L & 1023; if (G == 256) { const int rd = (L >> 8) & 3; u = (rd * 32 + xcd * 4 + (idx >> 3)) * 8 + (idx & 7); }
                attn_unit<2>(lds, tid, l, u >> 6, (u >> 3) & 7, u & 7, P1, QC, KVC, ROPE, RSTDQ, gq, sinkp); }
#endif
#if ATTN_FAST & 1
            for (int i = 0; ; ++i) { const int L = i * G + bx; if (L >= 1024) break;
                int u = L; if (G == 256) { const int rd = L >> 8; u = (rd * 8 + xcd) * 32 + idx; }
                attn_unit<0>(lds, tid, l, u >> 6, (u >> 5) & 1, u & 31, P1, QC, KVC, ROPE, RSTDQ, gq, sinkp); }
#endif
#if ATTN_FAST & 2
            for (int i = 0; ; ++i) { const int L = i * G + bx; if (L >= 1024) break;
                int u = L; if (G == 256) { const int rd = L >> 8; u = (rd * 8 + xcd) * 32 + idx; }
                attn_unit<1>(lds, tid, l, u >> 6, (u >> 5) & 1, u & 31, P1, QC, KVC, ROPE, RSTDQ, gq, sinkp); }
#endif
        }
        SEAM(pb + 4);

        if (EN(5) && IN(pb + 5)) for (int rep_ = 0; rep_ < REPS_5; ++rep_) { PHASE_BEGIN
            pg8::SchedMerge S; S.o.init(NTOK / 256, DM / 256, G, bx); S.P1 = (const char*)P1; S.Wbr = (const char*)(Wb + W_WBR); S.lda2 = P1W * 2;
            pg8::EpiMerge E{MG, (const unsigned char*)GB};
            pg8::gemm_phase<pg8::EpiMerge, pg8::SchedMerge, true>(lds, tid, 512, 1024, S, E);
        }
        SEAM(pb + 5);

        if (EN(6) && IN(pb + 6)) for (int rep_ = 0; rep_ < REPS_6; ++rep_) { PHASE_BEGIN
            pg8::SchedPlain S; S.o.init(NTOK / 256, DM / 256, G, bx); S.A = (const char*)MG; S.Bt = (const char*)(Wb + W_WO); S.lda2 = 2048; S.ldb2 = 2048;
            pg8::EpiWo E{Y, XB};
            pg8::gemm_phase<pg8::EpiWo, pg8::SchedPlain, true>(lds, tid, 1024, 2048, S, E);
        }
        SEAM(pb + 6);

        if (EN(7) && IN(pb + 7)) { PHASE_BEGIN
            constexpr int WSTR = 1032;
            LAS bf16* WH = (LAS bf16*)lds; LAS bf16* WL = (LAS bf16*)(lds + 33280);
            LAS float* LG = (LAS float*)(lds + 69632);
            for (int idx = tid; idx < 16384; idx += 512) { const int k = idx >> 4, e = idx & 15; const float w = args.in[18][idx]; const unsigned hb = f2bf(w); const float rem = w - bf2f((bf16)hb);
                WH[e * WSTR + k] = (bf16)hb; WL[e * WSTR + k] = (bf16)f2bf(rem); }
            if (tid < 16) MISC[16 + tid] = 0u;
            __syncthreads();
            const float* g = args.in[16] + l * DM; const float* bb = args.in[17] + l * DM; const float* rb = args.in[19];
            const int rpb = (NTOK + G - 1) / G;
            const int r_lo = bx * rpb, r_hi = (r_lo + rpb < NTOK) ? r_lo + rpb : NTOK;
            const int fi = lane & 15, quad = lane >> 4;
            for (int g0 = r_lo + 16 * wave; g0 < r_hi; g0 += 128) {
                const int mrow = g0 + fi < r_hi ? g0 + fi : r_hi - 1;
                const bf16* yrow = Y + (size_t)mrow * DM + 8 * quad;
                float sm = 0.f, sq = 0.f;
#pragma unroll 8
                for (int sI = 0; sI < 32; ++sI) { const u32x4 w = *(const u32x4*)(yrow + 32 * sI);
                    const float e0 = bflo(w.x), e1 = bfhi(w.x), e2 = bflo(w.y), e3 = bfhi(w.y), e4 = bflo(w.z), e5 = bfhi(w.z), e6 = bflo(w.w), e7 = bfhi(w.w);
                    sm += ((e0 + e1) + (e2 + e3)) + ((e4 + e5) + (e6 + e7)); sq += ((e0 * e0 + e1 * e1) + (e2 * e2 + e3 * e3)) + ((e4 * e4 + e5 * e5) + (e6 * e6 + e7 * e7)); }
                sm += swz_xor<16>(sm); sm = xhalf_sum(sm); sq += swz_xor<16>(sq); sq = xhalf_sum(sq);
                const float mean = sm * (1.f / DM); const float var = fmaxf(sq * (1.f / DM) - mean * mean, 0.f);
                const float rstd = 1.f / sqrtf(var + EPS);
                f32x4 acc0 = (f32x4){0.f, 0.f, 0.f, 0.f}, acc1 = acc0;
                bf16* xrow = XB + (size_t)mrow * DM + 8 * quad; const bool wr_ok = (g0 + fi) < r_hi;
#pragma unroll 2
                for (int sI = 0; sI < 32; ++sI) {
                    const u32x4 w = *(const u32x4*)(yrow + 32 * sI); const int k0 = 32 * sI + 8 * quad;
                    const f32x4 ga = *(const f32x4*)(g + k0), gb = *(const f32x4*)(g + k0 + 4), ba = *(const f32x4*)(bb + k0), bc = *(const f32x4*)(bb + k0 + 4);
                    float x[8];
                    x[0] = (bflo(w.x) - mean) * rstd * ga.x + ba.x; x[1] = (bfhi(w.x) - mean) * rstd * ga.y + ba.y; x[2] = (bflo(w.y) - mean) * rstd * ga.z + ba.z; x[3] = (bfhi(w.y) - mean) * rstd * ga.w + ba.w;
                    x[4] = (bflo(w.z) - mean) * rstd * gb.x + bc.x; x[5] = (bfhi(w.z) - mean) * rstd * gb.y + bc.y; x[6] = (bflo(w.w) - mean) * rstd * gb.z + bc.z; x[7] = (bfhi(w.w) - mean) * rstd * gb.w + bc.w;
                    u32x4 hh; hh.x = pk2(x[0], x[1]); hh.y = pk2(x[2], x[3]); hh.z = pk2(x[4], x[5]); hh.w = pk2(x[6], x[7]);
                    if (wr_ok) *(u32x4*)(xrow + 32 * sI) = hh;
                    u32x4 ll; ll.x = pk2(x[0] - bflo(hh.x), x[1] - bfhi(hh.x)); ll.y = pk2(x[2] - bflo(hh.y), x[3] - bfhi(hh.y)); ll.z = pk2(x[4] - bflo(hh.z), x[5] - bfhi(hh.z)); ll.w = pk2(x[6] - bflo(hh.w), x[7] - bfhi(hh.w));
                    const bf16x8 wh = *(const LAS bf16x8*)(WH + fi * WSTR + k0), wl = *(const LAS bf16x8*)(WL + fi * WSTR + k0);
                    const bf16x8 xh = __builtin_bit_cast(bf16x8, hh), xl = __builtin_bit_cast(bf16x8, ll);
                    acc0 = __builtin_amdgcn_mfma_f32_16x16x32_bf16(xh, wh, acc0, 0, 0, 0);
                    acc1 = __builtin_amdgcn_mfma_f32_16x16x32_bf16(xh, wl, acc1, 0, 0, 0);
                    acc1 = __builtin_amdgcn_mfma_f32_16x16x32_bf16(xl, wh, acc1, 0, 0, 0);
                }
#pragma unroll
                for (int j = 0; j < 4; ++j) { const int mq = g0 + 4 * quad + j; if (mq < r_hi) LG[(mq - r_lo) * 16 + fi] = acc0[j] + acc1[j]; }
            }
            __syncthreads();
            if (tid < r_hi - r_lo) {
                float lg[16];
#pragma unroll
                for (int q = 0; q < 4; ++q) { const f32x4 t4 = *(const LAS f32x4*)(LG + tid * 16 + 4 * q); lg[4 * q] = t4.x; lg[4 * q + 1] = t4.y; lg[4 * q + 2] = t4.z; lg[4 * q + 3] = t4.w; }
                float sc[16], bi[16];
#pragma unroll
                for (int e = 0; e < 16; ++e) { sc[e] = 1.0f / (1.0f + expf(-lg[e])); bi[e] = sc[e] + rb[e]; }
                float gs[4]; int i1g[4], i2g[4];
#pragma unroll
                for (int q = 0; q < 4; ++q) { const float a = bi[4 * q], b = bi[4 * q + 1], c = bi[4 * q + 2], d = bi[4 * q + 3];
                    float best = a; int i1 = 0; if (b > best) { best = b; i1 = 1; } if (c > best) { best = c; i1 = 2; } if (d > best) { best = d; i1 = 3; }
                    float b2 = -1e30f; int i2 = 0;
                    if (i1 != 0 && a > b2) { b2 = a; i2 = 0; } if (i1 != 1 && b > b2) { b2 = b; i2 = 1; } if (i1 != 2 && c > b2) { b2 = c; i2 = 2; } if (i1 != 3 && d > b2) { b2 = d; i2 = 3; }
                    gs[q] = best + b2; i1g[q] = i1; i2g[q] = i2; }
                int sel = 0; float bg = gs[0];
#pragma unroll
                for (int q = 1; q < 4; ++q) if (gs[q] > bg) { bg = gs[q]; sel = q; }
                int i1 = i1g[0], i2 = i2g[0];
#pragma unroll
                for (int q = 1; q < 4; ++q) if (sel == q) { i1 = i1g[q]; i2 = i2g[q]; }
                const int e0 = sel * 4 + i1, e1 = sel * 4 + i2; float s0 = 0.f, s1 = 0.f;
#pragma unroll
                for (int e = 0; e < 16; ++e) { s0 = (e == e0) ? sc[e] : s0; s1 = (e == e1) ? sc[e] : s1; }
                const float w0 = s0 / (s0 + s1), w1 = s1 / (s0 + s1);
                const unsigned lp0 = atomicAdd((unsigned*)(MISC + 16 + e0), 1u), lp1 = atomicAdd((unsigned*)(MISC + 16 + e1), 1u);
                volatile LAS unsigned* ri = MISC + 128 + tid * 8; ri[0] = (unsigned)e0; ri[1] = lp0; ri[2] = (unsigned)e1; ri[3] = lp1; ri[4] = __float_as_uint(w0); ri[5] = __float_as_uint(w1);
            }
            __syncthreads();
            if (tid < 16) MISC[32 + tid] = __hip_atomic_fetch_add(ctl + CW_GCNT + (l * 16 + tid) * 64, MISC[16 + tid], __ATOMIC_RELAXED, __HIP_MEMORY_SCOPE_AGENT);
            __syncthreads();
            if (tid < r_hi - r_lo) { volatile LAS unsigned* ri = MISC + 128 + tid * 8; const int m = r_lo + tid;
                const unsigned e0 = ri[0], e1 = ri[2]; const unsigned p0 = MISC[32 + e0] + ri[1], p1 = MISC[32 + e1] + ri[3];
                LIST[e0 * LIST_CAP + p0] = m; LIST[e1 * LIST_CAP + p1] = m;
                *(u32x4*)(ROUTE + (size_t)m * 8) = (u32x4){e0, p0, e1, p1}; *(u32x2*)(ROUTE + (size_t)m * 8 + 4) = (u32x2){ri[4], ri[5]}; }
            __syncthreads();
        }
        SEAM(pb + 7);

        if (IN(pb + 8) || IN(pb + 9) || IN(pb + 10)) { PHASE_BEGIN
            if (tid == 0) { int ps = 0;
                for (int e = 0; e < 16; ++e) { const int c = (int)__hip_atomic_load(ctl + CW_GCNT + (l * 16 + e) * 64, __ATOMIC_RELAXED, __HIP_MEMORY_SCOPE_AGENT); MISC[64 + e] = (unsigned)ps; MISC[96 + e] = (unsigned)c; ps += (c + 255) >> 8; }
                MISC[80] = (unsigned)ps; }
            __syncthreads();
        }
        if (EN(8) && IN(pb + 8)) for (int rep_ = 0; rep_ < REPS_8; ++rep_) { PHASE_BEGIN
            pg8::SchedMoe<true> S; S.total_panels = (int)MISC[80]; S.G = G; S.c = bx; S.tab = (const volatile LAS int*)(MISC + 64); S.list = LIST; S.A = (const char*)XB; S.W = (const char*)(Wb + W_WGU);
            S.lda2 = 2048; S.wstride = (size_t)1024 * 1024 * 2; S.ldb2 = 2048;
            pg8::EpiMoeUp E{HID};
            pg8::gemm_phase<pg8::EpiMoeUp, pg8::SchedMoe<true>, true>(lds, tid, 1024, 2048, S, E);
        }
        SEAM(pb + 8);

        if (EN(9) && IN(pb + 9)) for (int rep_ = 0; rep_ < REPS_9; ++rep_) { PHASE_BEGIN
            pg8::SchedMoe<false> S; S.total_panels = (int)MISC[80]; S.G = G; S.c = bx; S.tab = (const volatile LAS int*)(MISC + 64); S.list = LIST; S.A = (const char*)HID; S.W = (const char*)(Wb + W_WD);
            S.lda2 = 1024; S.wstride = (size_t)1024 * 512 * 2; S.ldb2 = 1024;
            pg8::EpiBf16 E{PAIR, DM, nullptr};
            pg8::gemm_phase<pg8::EpiBf16, pg8::SchedMoe<false>, true>(lds, tid, 512, 1024, S, E);
        }
        SEAM(pb + 9);

        if (EN(10) && IN(pb + 10)) { PHASE_BEGIN
            const float* g = args.in[23] + l * DM; const float* bb = args.in[24] + l * DM;
            f32x4 gv[4], bv[4];
#pragma unroll
            for (int j = 0; j < 4; ++j) { gv[j] = *(const f32x4*)(g + 256 * j + 4 * lane); bv[j] = *(const f32x4*)(bb + 256 * j + 4 * lane); }
            for (int m0 = gw; m0 < NTOK; m0 += 4 * NGW) {
                u32x4 r4[4]; u32x2 w2[4];
#pragma unroll
                for (int q = 0; q < 4; ++q) { const int m = m0 + q * NGW < NTOK ? m0 + q * NGW : m0; r4[q] = *(const u32x4*)(ROUTE + (size_t)m * 8); w2[q] = *(const u32x2*)(ROUTE + (size_t)m * 8 + 4); }
                u32x2 xw[4][4], pa[4][4], pq[4][4];
#pragma unroll
                for (int q = 0; q < 4; ++q) { const int m = m0 + q * NGW < NTOK ? m0 + q * NGW : m0;
                    const size_t s0 = (size_t)MISC[64 + r4[q].x] * 256 + r4[q].y, s1 = (size_t)MISC[64 + r4[q].z] * 256 + r4[q].w;
#pragma unroll
                    for (int j = 0; j < 4; ++j) { xw[q][j] = *(const u32x2*)(XB + (size_t)m * DM + 256 * j + 4 * lane); pa[q][j] = *(const u32x2*)(PAIR + s0 * DM + 256 * j + 4 * lane); pq[q][j] = *(const u32x2*)(PAIR + s1 * DM + 256 * j + 4 * lane); } }
#pragma unroll
                for (int q = 0; q < 4; ++q) { const int m = m0 + q * NGW; if (m < NTOK) {
                    const float w0 = __uint_as_float(w2[q].x), w1 = __uint_as_float(w2[q].y);
                    f32x4 v[4]; float s = 0.f;
#pragma unroll
                    for (int j = 0; j < 4; ++j) {
                        v[j].x = ALPHA * bflo(xw[q][j].x) + w0 * bflo(pa[q][j].x) + w1 * bflo(pq[q][j].x); v[j].y = ALPHA * bfhi(xw[q][j].x) + w0 * bfhi(pa[q][j].x) + w1 * bfhi(pq[q][j].x);
                        v[j].z = ALPHA * bflo(xw[q][j].y) + w0 * bflo(pa[q][j].y) + w1 * bflo(pq[q][j].y); v[j].w = ALPHA * bfhi(xw[q][j].y) + w0 * bfhi(pa[q][j].y) + w1 * bfhi(pq[q][j].y);
                        s += (v[j].x + v[j].y) + (v[j].z + v[j].w); }
                    const float mean = wave_sum(s) * (1.f / DM); float s2 = 0.f;
#pragma unroll
                    for (int j = 0; j < 4; ++j) { v[j] = v[j] - mean; s2 += (v[j].x * v[j].x + v[j].y * v[j].y) + (v[j].z * v[j].z + v[j].w * v[j].w); }
                    const float rstd = 1.f / sqrtf(wave_sum(s2) * (1.f / DM) + EPS);
#pragma unroll
                    for (int j = 0; j < 4; ++j) { const f32x4 o = v[j] * rstd * gv[j] + bv[j];
                        if (l == DEPTH - 1) *(f32x4*)((float*)outb + (size_t)m * DM + 256 * j + 4 * lane) = o;
                        else *(u32x2*)(XB + (size_t)m * DM + 256 * j + 4 * lane) = (u32x2){pk2(o.x, o.y), pk2(o.z, o.w)}; } } }
            }
        }
        SEAM(pb + 10);
    }
#undef IN
#undef SEAM
}

extern "C" void kernel_launch(void* const* d_in, const int* in_sizes, int n_in, void* d_out, int out_size, void* d_ws, size_t ws_size, hipStream_t stream) {
    static int grid = 0;
    if (grid == 0) {
        if (n_in != 25 || out_size != NTOK * DM || ws_size < WS_END) { fprintf(stderr, "kernel_launch: unexpected shapes (n_in %d, out %d, ws %zu)\n", n_in, out_size, ws_size); grid = -1; return; }
        int dev = 0, cus = 0, per_cu = 0;
        if (hipGetDevice(&dev) != hipSuccess || hipDeviceGetAttribute(&cus, hipDeviceAttributeMultiprocessorCount, dev) != hipSuccess) { grid = -1; return; }
        if (hipFuncSetAttribute((const void*)fwd_kernel, hipFuncAttributeMaxDynamicSharedMemorySize, LDS_BYTES) != hipSuccess) { fprintf(stderr, "kernel_launch: hipFuncSetAttribute failed\n"); grid = -1; return; }
        if (hipOccupancyMaxActiveBlocksPerMultiprocessor(&per_cu, (const void*)fwd_kernel, 512, LDS_BYTES) != hipSuccess || per_cu < 1) fprintf(stderr, "kernel_launch: occupancy query reports %d\n", per_cu);
        (void)hipGetLastError();
        grid = cus;
    }
    if (grid < 0) return;
    (void)hipMemsetAsync((char*)d_ws + WS_CTL, 0, CTL_ZERO_BYTES, stream);
    Args a{};
    for (int i = 0; i < 25; ++i) a.in[i] = (const float*)d_in[i];
    a.out = (float*)d_out; a.ws = (unsigned char*)d_ws;
#if ONE_LAUNCH
    a.ph_lo = 0; a.ph_hi = NPH;
    hipLaunchKernelGGL(fwd_kernel, dim3(grid), dim3(512), LDS_BYTES, stream, a);
#else
    for (int p = 0; p < NPH; ++p) { a.ph_lo = p; a.ph_hi = p + 1; hipLaunchKernelGGL(fwd_kernel, dim3(grid), dim3(512), LDS_BYTES, stream, a); }
#endif
}
```

```cpp
#include <hip/hip_runtime.h>
#include <cstdio>
#include <cstdint>

#ifndef PHMASK
#define PHMASK 0xFFF
#endif
#define EN(k) (((PHMASK) >> (k)) & 1)
#ifndef REPS_0
#define REPS_0 1
#endif
#ifndef REPS_1
#define REPS_1 1
#endif
#ifndef REPS_3
#define REPS_3 1
#endif
#ifndef REPS_4C
#define REPS_4C 1
#endif
#ifndef REPS_5
#define REPS_5 1
#endif
#ifndef REPS_6
#define REPS_6 1
#endif
#ifndef REPS_8
#define REPS_8 1
#endif
#ifndef REPS_9
#define REPS_9 1
#endif
#ifndef ATTN_FAST
#define ATTN_FAST 7
#endif
#ifndef ONE_LAUNCH
#define ONE_LAUNCH 1
#endif

#define GAS __attribute__((address_space(1)))
#define LAS __attribute__((address_space(3)))
typedef unsigned short bf16;
typedef short bf16x8 __attribute__((ext_vector_type(8)));
typedef float f32x4 __attribute__((ext_vector_type(4)));
typedef float f32x2 __attribute__((ext_vector_type(2)));
typedef unsigned u32x4 __attribute__((ext_vector_type(4)));
typedef unsigned u32x2 __attribute__((ext_vector_type(2)));
#define DI __device__ __forceinline__

constexpr int NTOK = 32768, DM = 1024, SEQ = 2048, NBATCH = 16, DEPTH = 2;
constexpr int P1W = 2304, GW = 3072, INW = 5376, QCW = 768, KVW = 1024, INCOLS = 5280;
constexpr int NEXP = 16, DFF = 512, SLOT_ROWS = 69632, LIST_CAP = 32768;
constexpr float EPS = 1e-6f, ALPHA = 1.4142135623730951f, LOG2E = 1.4426950408889634f;
constexpr float C2_64 = 0.125f * LOG2E;
constexpr float C2_96 = 0.10206207261596577f * LOG2E;
constexpr int C_QA = 0, C_KA = 512, C_VA = 640, C_QB = 768, C_KB = 1280, C_VB = 1408, C_CQ = 1536, C_CKV = 1920, C_KR = 2176;

constexpr size_t MiB = 1u << 20;
constexpr size_t WS_CTL = 0, CTL_ZERO_BYTES = 1 * MiB;
constexpr size_t WS_ROPE = 1 * MiB;
constexpr size_t WS_TB = WS_ROPE + 2048 * 16 * 8;
constexpr size_t WS_RSTDQ = WS_TB + 8 * 260 * 4 + 1728;
constexpr size_t WS_RSTDKV = WS_RSTDQ + NTOK * 4;
constexpr size_t WS_LIST = 2 * MiB;
constexpr size_t WS_ROUTE = 4 * MiB;
constexpr size_t WS_W = 8 * MiB;
constexpr size_t W_WIN = 0, W_WUQ = 11010048, W_WUKV = 11599872, W_WBR = 12124160, W_WO = 15269888, W_WGU = 17367040, W_WD = 50921472, W_WUP = 67698688, W_END = 71368704;
constexpr size_t WS_XB = 77 * MiB;
constexpr size_t WS_P1 = 141 * MiB;
constexpr size_t WS_G = 285 * MiB;
constexpr size_t WS_END = 477 * MiB;
static_assert(WS_W + W_END <= WS_XB && WS_RSTDKV + NTOK * 4 <= WS_LIST, "ws map");
static_assert((size_t)SLOT_ROWS * 1024 * 2 <= WS_END - WS_G && (size_t)SLOT_ROWS * 512 * 2 <= WS_G - WS_P1, "ws map 2");
constexpr size_t DO_QC = 0, DO_KVC = 48 * MiB;
constexpr int CW_BAR = 4096;
constexpr int CW_GCNT = 16384;

constexpr int RING_BYTES = 131072, LDSCTL_OFF = RING_BYTES, LDS_BYTES = 147456;

DI float bf2f(unsigned short h) { return __builtin_bit_cast(float, (unsigned)h << 16); }
DI float bflo(unsigned w) { return __builtin_bit_cast(float, w << 16); }
DI float bfhi(unsigned w) { return __builtin_bit_cast(float, w & 0xffff0000u); }
DI unsigned f2bf(float f) { unsigned u = __builtin_bit_cast(unsigned, f); return (u + 0x7fffu + ((u >> 16) & 1u)) >> 16; }
DI unsigned pk2(float lo, float hi) { return f2bf(lo) | (f2bf(hi) << 16); }
DI unsigned cvt_pk_bf16(float lo, float hi) { unsigned r; asm volatile("v_cvt_pk_bf16_f32 %0, %1, %2" : "=v"(r) : "v"(lo), "v"(hi)); return r; }
typedef __bf16 bf16x2_t __attribute__((ext_vector_type(2)));
DI unsigned cvtpk(float lo, float hi) { const f32x2 v = {lo, hi}; const bf16x2_t bb = __builtin_convertvector(v, bf16x2_t); return __builtin_bit_cast(unsigned, bb); }
DI float fsigmoid(float x) { return __builtin_amdgcn_rcpf(1.0f + __builtin_amdgcn_exp2f(-x * LOG2E)); }
DI unsigned gate_q8x4(const f32x4 v) {
    const unsigned b0 = (unsigned)fmaxf(fsigmoid(v[0]) * 255.0f + 0.5f, 1.0f), b1 = (unsigned)fmaxf(fsigmoid(v[1]) * 255.0f + 0.5f, 1.0f);
    const unsigned b2 = (unsigned)fmaxf(fsigmoid(v[2]) * 255.0f + 0.5f, 1.0f), b3 = (unsigned)fmaxf(fsigmoid(v[3]) * 255.0f + 0.5f, 1.0f);
    return b0 | (b1 << 8) | (b2 << 16) | (b3 << 24); }
DI f32x4 gate_f4(const unsigned w) { return (f32x4){(float)(w & 0xffu), (float)((w >> 8) & 0xffu), (float)((w >> 16) & 0xffu), (float)(w >> 24)}; }
DI f32x4 rcp4(const f32x4 v) { return (f32x4){__builtin_amdgcn_rcpf(v[0]), __builtin_amdgcn_rcpf(v[1]), __builtin_amdgcn_rcpf(v[2]), __builtin_amdgcn_rcpf(v[3])}; }
template <int M> DI float swz_xor(float v) { return __builtin_bit_cast(float, __builtin_amdgcn_ds_swizzle(__builtin_bit_cast(int, v), (M << 10) | 0x1F)); }
DI float xhalf_sum(float v) { auto rr = __builtin_amdgcn_permlane32_swap(__float_as_uint(v), __float_as_uint(v), false, false); return __uint_as_float(rr[0]) + __uint_as_float(rr[1]); }
DI float sum32(float v) { v += swz_xor<1>(v); v += swz_xor<2>(v); v += swz_xor<4>(v); v += swz_xor<8>(v); v += swz_xor<16>(v); return v; }
DI float wave_sum(float v) { return xhalf_sum(sum32(v)); }
#define LDS_WAIT() asm volatile("s_waitcnt lgkmcnt(0)" ::: "memory")
#define VM_WAIT() asm volatile("s_waitcnt vmcnt(0)" ::: "memory")

namespace pg8 {
constexpr int BM = 256, BK = 64, HALF = 128, HTB = HALF * BK * 2, STAGE_BYTES = 8 * HTB, NXCD = 8, WGM = 8;
DI int lds_byte(int r, int c) { const int st = (r >> 4) * 2 + (c >> 5), rr = r & 15, cc = c & 31, ob = rr * 64 + cc * 2; return st * 1024 + (ob ^ (((ob >> 9) & 1) << 5)); }
DI void stage_rc(int b, int& R, int& C) { const int st = b / 1024, sb = b % 1024, swz = sb ^ (((sb >> 9) & 1) << 5); R = (st >> 1) * 16 + swz / 64; C = (st & 1) * 32 + (swz % 64) / 2; }
DI int perm32(int rho) { const int n = rho >> 4, i = rho & 15; return 8 * (i >> 2) + 4 * n + (i & 3); }

struct Unit { int pm, pn, e, aux; };
struct TileOrder {
    int nM, nN, nwg, G, c;
    DI void init(int nM_, int nN_, int G_, int c_) { nM = nM_; nN = nN_; nwg = nM * nN; G = G_; c = c_; }
    DI bool tile(int i, int& pm, int& pn) const {
        const long L = (long)i * G + c; if (L >= nwg) return false;
        int wgid = (int)L; { const int q = nwg / NXCD, r = nwg % NXCD, xcd = wgid % NXCD, off = wgid / NXCD; wgid = (xcd < r ? xcd * (q + 1) : r * (q + 1) + (xcd - r) * q) + off; }
        const int nig = WGM * nN, gid = wgid / nig, fm = gid * WGM, gsz = (nM - fm) < WGM ? (nM - fm) : WGM;
        pm = fm + ((wgid % nig) % gsz); pn = (wgid % nig) / gsz; return true;
    }
};

template <class Epi, class Sched, bool ALIGN_EPI>
DI void gemm_phase(LAS unsigned char* lds, const int tid, const int K, const unsigned ldb2, const Sched& S, const Epi& E) {
    const int wid = __builtin_amdgcn_readfirstlane(tid >> 6), lane = tid & 63, wr = wid >> 2, wc = wid & 3, fr = lane & 15, fq = lane >> 4;
    int nt = K / BK;
    int Rr[2], Cc[2]; unsigned voffA[2], voffB[2];
    const unsigned lda2 = S.lda2;
#pragma unroll
    for (int i = 0; i < 2; ++i) { int R, C; stage_rc(tid * 16 + i * 8192, R, C); const int Rb = Epi::PERM ? ((R & ~31) + perm32(R & 31)) : R;
        Rr[i] = R; Cc[i] = C * 2; voffA[i] = (unsigned)R * lda2 + (unsigned)C * 2u; voffB[i] = (unsigned)Rb * ldb2 + (unsigned)C * 2u; }
    const size_t kstep = (size_t)(BK * 2);
    const size_t hstepB = (size_t)HALF * ldb2, hstepA = (size_t)HALF * lda2;
    const unsigned ldsw = (unsigned)wid * 1024u;
    const int aoff = lds_byte(wr * 64 + fr, fq * 8), boff = lds_byte(wc * 32 + fr, fq * 8);
#define PG8_SA(b, h) (((b) * 2 + (h)) * HTB)
#define PG8_SB(b, h) ((4 + (b) * 2 + (h)) * HTB)
#define PG8_STAGE(bufoff, gbase, voff) do { _Pragma("unroll") for (int _i = 0; _i < 2; ++_i) \
        __builtin_amdgcn_global_load_lds((const unsigned*)((const char*)(gbase) + (voff)[_i]), (LAS unsigned*)(lds + (bufoff) + ldsw + _i * 8192), 16, 0, 0); } while (0)
#define PG8_STAGE_A(bufoff, gbase, h, g0, g1) do { if constexpr (Sched::GATHER) { if ((h) == 0) PG8_STAGE(bufoff, gbase, g0); else PG8_STAGE(bufoff, gbase, g1); } \
        else { PG8_STAGE(bufoff, (gbase) + (h) * hstepA, voffA); } } while (0)
#define PG8_LDA(dst, b, h) do { _Pragma("unroll") for (int m = 0; m < 4; ++m) _Pragma("unroll") for (int k = 0; k < 2; ++k) dst[m][k] = *(const LAS bf16x8*)(lds + PG8_SA(b, h) + aoff + m * 2048 + k * 1024); } while (0)
#define PG8_LDB(dst, b, h) do { _Pragma("unroll") for (int n = 0; n < 2; ++n) _Pragma("unroll") for (int k = 0; k < 2; ++k) dst[n][k] = *(const LAS bf16x8*)(lds + PG8_SB(b, h) + boff + n * 2048 + k * 1024); } while (0)
#define PG8_MMA(ai, bj, At, Bt) do { __builtin_amdgcn_s_setprio(1); _Pragma("unroll") for (int m = 0; m < 4; ++m) _Pragma("unroll") for (int n = 0; n < 2; ++n) _Pragma("unroll") for (int k = 0; k < 2; ++k) \
        acc[ai][bj][m][n] = __builtin_amdgcn_mfma_f32_16x16x32_bf16(Bt[n][k], At[m][k], acc[ai][bj][m][n], 0, 0, 0); __builtin_amdgcn_s_setprio(0); } while (0)
#define PG8_WAIT_V(n) asm volatile("s_waitcnt vmcnt(" #n ")" ::: "memory")
#define PG8_WAIT_L(n) asm volatile("s_waitcnt lgkmcnt(" #n ")" ::: "memory")
#define PG8_BAR __builtin_amdgcn_s_barrier()
#define PG8_SCHED __builtin_amdgcn_sched_barrier(0)
    Unit cur, nxt; int ui = 0;
    if (!S.next(0, cur)) return;
    f32x4 acc[2][2][4][2];
    float zf = 0.f; asm volatile("" : "+v"(zf));
#pragma unroll
    for (int a = 0; a < 2; ++a)
#pragma unroll
        for (int b = 0; b < 2; ++b)
#pragma unroll
            for (int m = 0; m < 4; ++m)
#pragma unroll
                for (int n = 0; n < 2; ++n) acc[a][b][m][n] = (f32x4){zf, zf, zf, zf};
    bf16x8 At[4][2], B0[2][2], B1[2][2];
    u32x4 carry[4];
    if constexpr (Sched::KEEP) { unsigned zc = 0u; asm volatile("" : "+v"(zc));
#pragma unroll
        for (int m = 0; m < 4; ++m) carry[m] = (u32x4){zc, zc, zc, zc}; }
    unsigned ao0[2] = {0u, 0u}, ao1[2] = {0u, 0u}, no0[2] = {0u, 0u}, no1[2] = {0u, 0u};
    if constexpr (Sched::GATHER) {
#pragma unroll
        for (int i = 0; i < 2; ++i) { ao0[i] = S.a_off(cur, Rr[i]) + Cc[i]; ao1[i] = S.a_off(cur, HALF + Rr[i]) + Cc[i]; } }
    const char* cA = S.a_base(cur); const char* cB = S.b_base(cur); nt = S.ktiles(cur, nt);
    bool chalf = false; if constexpr (Sched::HALFM) chalf = (cur.pn >> 4) != 0;
    PG8_STAGE(PG8_SB(0, 0), cB, voffB); PG8_STAGE(PG8_SB(0, 1), cB + hstepB, voffB); PG8_STAGE_A(PG8_SA(0, 0), cA, 0, ao0, ao1); PG8_STAGE_A(PG8_SA(0, 1), cA, 1, ao0, ao1);
    if (wr == 1) PG8_BAR;
    PG8_WAIT_V(2); PG8_BAR;
    PG8_STAGE(PG8_SB(1, 0), cB + kstep, voffB); PG8_STAGE_A(PG8_SA(1, 0), cA + kstep, 0, ao0, ao1); PG8_STAGE(PG8_SB(1, 1), cB + hstepB + kstep, voffB);
    PG8_WAIT_V(6); PG8_BAR;
    for (;;) {
        const bool has_next = S.next(ui + 1, nxt);
        const char* nA = cA; const char* nB = cB;
        if constexpr (Sched::GATHER) {
#pragma unroll
            for (int i = 0; i < 2; ++i) { no0[i] = ao0[i]; no1[i] = ao1[i]; } }
        if (has_next) { nA = S.a_base(nxt); nB = S.b_base(nxt);
            if constexpr (Sched::GATHER) {
#pragma unroll
                for (int i = 0; i < 2; ++i) { no0[i] = S.a_off(nxt, Rr[i]) + Cc[i]; no1[i] = S.a_off(nxt, HALF + Rr[i]) + Cc[i]; } } }
#pragma unroll 1
        for (int t = 0; t < nt; t += 2) {
            const bool last = (t == nt - 2);
            const char* a1 = cA + (size_t)(t + 1) * kstep;
            const char* a2 = last ? nA : cA + (size_t)(t + 2) * kstep; const char* b2 = last ? nB : cB + (size_t)(t + 2) * kstep;
            const char* a3 = a2 + kstep; const char* b3 = b2 + kstep;
            unsigned x0[2] = {0u, 0u}, x1[2] = {0u, 0u};
            if constexpr (Sched::GATHER) {
#pragma unroll
                for (int i = 0; i < 2; ++i) { x0[i] = last ? no0[i] : ao0[i]; x1[i] = last ? no1[i] : ao1[i]; } }
            PG8_LDB(B0, 0, 0); PG8_LDB(B1, 0, 1); PG8_SCHED; PG8_LDA(At, 0, 0); PG8_STAGE_A(PG8_SA(1, 1), a1, 1, ao0, ao1);
            PG8_WAIT_V(8); PG8_WAIT_L(0); PG8_BAR; PG8_MMA(0, 0, At, B0); PG8_MMA(0, 1, At, B1); PG8_BAR; PG8_SCHED;
            PG8_LDA(At, 0, 1); PG8_STAGE(PG8_SB(0, 0), b2, voffB); PG8_STAGE(PG8_SB(0, 1), b2 + hstepB, voffB); PG8_STAGE_A(PG8_SA(0, 0), a2, 0, x0, x1);
            PG8_WAIT_V(8); PG8_WAIT_L(0); PG8_BAR; if (!chalf) { PG8_MMA(1, 0, At, B0); PG8_MMA(1, 1, At, B1); } PG8_BAR; PG8_SCHED;
            PG8_LDB(B0, 1, 0); PG8_LDB(B1, 1, 1); PG8_SCHED; PG8_LDA(At, 1, 0); PG8_STAGE_A(PG8_SA(0, 1), a2, 1, x0, x1);
            PG8_WAIT_V(8); PG8_WAIT_L(0); PG8_BAR; PG8_MMA(0, 0, At, B0); PG8_MMA(0, 1, At, B1); PG8_BAR; PG8_SCHED;
            PG8_LDA(At, 1, 1); PG8_STAGE(PG8_SB(1, 0), b3, voffB); PG8_STAGE(PG8_SB(1, 1), b3 + hstepB, voffB); PG8_STAGE_A(PG8_SA(1, 0), a3, 0, x0, x1);
            PG8_WAIT_V(8); PG8_WAIT_L(0); PG8_BAR; if (!chalf) { PG8_MMA(1, 0, At, B0); PG8_MMA(1, 1, At, B1); } PG8_BAR; PG8_SCHED;
        }
        if constexpr (ALIGN_EPI) { if (wr == 0) PG8_BAR; }
        bool keep = false;
        if constexpr (Sched::KEEP) keep = S.keep_acc(cur);
        if constexpr (Sched::KEEP) { if (keep) E.mid(acc, carry, cur, wr, wc, fr, fq); else E(acc, carry, cur, wr, wc, fr, fq); } else { E(acc, cur, wr, wc, fr, fq); }
        if (!has_next) break;
        if (!keep) {
#pragma unroll
        for (int a = 0; a < 2; ++a)
#pragma unroll
            for (int b = 0; b < 2; ++b)
#pragma unroll
                for (int m = 0; m < 4; ++m)
#pragma unroll
                    for (int n = 0; n < 2; ++n) acc[a][b][m][n] = (f32x4){zf, zf, zf, zf};
        }
        cur = nxt; cA = nA; cB = nB; ++ui; nt = S.ktiles(cur, nt);
        if constexpr (Sched::HALFM) chalf = (cur.pn >> 4) != 0;
        if constexpr (Sched::GATHER) {
#pragma unroll
            for (int i = 0; i < 2; ++i) { ao0[i] = no0[i]; ao1[i] = no1[i]; } }
        if constexpr (ALIGN_EPI) { if (wr == 1) PG8_BAR; }
    }
    PG8_WAIT_V(0);
    if constexpr (!ALIGN_EPI) { if (wr == 0) PG8_BAR; }
    PG8_BAR;
#undef PG8_SA
#undef PG8_SB
#undef PG8_STAGE
#undef PG8_STAGE_A
#undef PG8_LDA
#undef PG8_LDB
#undef PG8_MMA
#undef PG8_WAIT_V
#undef PG8_WAIT_L
#undef PG8_BAR
#undef PG8_SCHED
}

struct SchedPlain {
    static constexpr bool GATHER = false, KEEP = false, HALFM = false;
    TileOrder o; const char* A; const char* Bt; unsigned lda2, ldb2;
    DI bool next(int i, Unit& u) const { u.e = 0; u.aux = 0; return o.tile(i, u.pm, u.pn); }
    DI const char* a_base(const Unit& u) const { return A + (size_t)u.pm * BM * lda2; }
    DI unsigned a_off(const Unit&, int) const { return 0u; }
    DI int ktiles(const Unit&, int d) const { return d; }
    DI const char* b_base(const Unit& u) const { return Bt + (size_t)u.pn * BM * ldb2; }
};
struct SchedMerge {
    static constexpr bool GATHER = false, KEEP = true, HALFM = false;
    TileOrder o; const char* P1; const char* Wbr; unsigned lda2;
    DI bool next(int i, Unit& u) const { u.e = i % 3; u.aux = 0; return o.tile(i / 3, u.pm, u.pn); }
    DI bool keep_acc(const Unit& u) const { return u.e < 2; }
    DI const char* a_base(const Unit& u) const { return P1 + (size_t)u.e * (768 * 2) + (size_t)u.pm * BM * lda2; }
    DI unsigned a_off(const Unit&, int) const { return 0u; }
    DI int ktiles(const Unit&, int d) const { return d; }
    DI const char* b_base(const Unit& u) const { return Wbr + (size_t)u.e * (1024 * 512 * 2) + (size_t)u.pn * BM * 1024; }
};
struct SchedUp {
    static constexpr bool GATHER = true, KEEP = false, HALFM = false;
    int G, c; const char* wsb; unsigned lda2;
    DI void qunit(int i, Unit& u) const { u.e = 0; u.pm = i / 3; u.pn = i % 3; }
    DI void kvunit(int i, Unit& u) const { u.e = 1; u.pm = i >> 2; u.pn = 3 + (i & 3); }
    DI bool next(int i, Unit& u) const {
        u.aux = 0;
        if (G == 256) {
            if (c < 128) { if (i == 0) { u.e = 2; u.pm = c; u.pn = 7; return true; } if (i == 1) { qunit(c, u); return true; } if (i == 2) { kvunit(c, u); return true; } return false; }
            const int d = c - 128; if (i < 2) { qunit(128 + 2 * d + i, u); return true; } if (i < 5) { kvunit(128 + 3 * d + (i - 2), u); return true; } return false;
        }
        const int L = i * G + c; if (L >= 1024) return false;
        if (L < 128) { u.e = 2; u.pm = L; u.pn = 7; } else if (L < 512) qunit(L - 128, u); else kvunit(L - 512, u);
        return true;
    }
    DI const char* a_base(const Unit& u) const { const size_t off = u.e == 2 ? WS_XB + (size_t)u.pm * BM * 2048 : WS_P1 + (size_t)(u.e ? C_CKV * 2 : C_CQ * 2) + (size_t)u.pm * BM * (P1W * 2); return wsb + off; }
    DI unsigned a_off(const Unit& u, int r) const { return (unsigned)r * (u.e == 2 ? 2048u : (unsigned)(P1W * 2)); }
    DI int ktiles(const Unit& u, int) const { return u.e == 2 ? 16 : (u.e ? 4 : 6); }
    DI const char* b_base(const Unit& u) const { const size_t off = u.e == 2 ? WS_W + W_WIN + (size_t)5120 * 2048 : WS_W + W_WUP + (size_t)u.pn * BM * 2048; return wsb + off; }
};
template <bool GATHER_> struct SchedMoe {
    static constexpr bool GATHER = GATHER_, KEEP = false, HALFM = true;
    int total_panels, G, c; const volatile LAS int* tab; const int* list; const char* A; const char* W; unsigned lda2; size_t wstride; unsigned ldb2;
    DI bool next(int i, Unit& u) const {
        if (i >= tab[62]) return false;
        u.pm = tab[64 + 4 * i]; u.pn = tab[65 + 4 * i]; u.e = tab[66 + 4 * i]; u.aux = tab[67 + 4 * i]; return true;
    }
    DI const char* a_base(const Unit& u) const { return GATHER ? A : A + ((size_t)u.pm * BM + ((u.pn >> 4) == 2 ? HALF : 0)) * lda2; }
    DI unsigned a_off(const Unit& u, int r) const {
        int pos = u.aux + r; const int cnt = tab[32 + u.e]; pos = pos < cnt ? pos : cnt - 1; return (unsigned)list[u.e * LIST_CAP + pos] * lda2;
    }
    DI int ktiles(const Unit&, int d) const { return d; }
    DI const char* b_base(const Unit& u) const { return W + (size_t)u.e * wstride + (size_t)(u.pn & 15) * BM * ldb2; }
};

struct EpiInproj {
    static constexpr bool PERM = true;
    bf16* P1; unsigned char* G8;
    DI void operator()(const f32x4 (&acc)[2][2][4][2], const Unit& u, int wr, int wc, int fr, int fq) const {
        const int row0 = u.pm * BM + wr * 64 + fr; const bool sig = u.pn >= 9;
        if (sig) {
            const int off0 = (u.pn - 9) * BM + wc * 64 + fq * 16;
#pragma unroll
            for (int ai = 0; ai < 2; ++ai)
#pragma unroll
                for (int m = 0; m < 4; ++m) { u32x4 w; w.x = gate_q8x4(acc[ai][0][m][0]); w.y = gate_q8x4(acc[ai][0][m][1]); w.z = gate_q8x4(acc[ai][1][m][0]); w.w = gate_q8x4(acc[ai][1][m][1]);
                    *(u32x4*)(G8 + (size_t)(row0 + ai * HALF + m * 16) * GW + off0) = w; }
        } else {
            const int col0 = u.pn * BM + wc * 32 + 8 * fq;
#pragma unroll
            for (int ai = 0; ai < 2; ++ai)
#pragma unroll
                for (int m = 0; m < 4; ++m) { bf16* rowp = P1 + (size_t)(row0 + ai * HALF + m * 16) * P1W + col0;
#pragma unroll
                    for (int bj = 0; bj < 2; ++bj) { const f32x4 v0 = acc[ai][bj][m][0], v1 = acc[ai][bj][m][1];
                        u32x4 w; w.x = cvt_pk_bf16(v0[0], v0[1]); w.y = cvt_pk_bf16(v0[2], v0[3]); w.z = cvt_pk_bf16(v1[0], v1[1]); w.w = cvt_pk_bf16(v1[2], v1[3]);
                        *(u32x4*)(rowp + bj * HALF) = w; } }
        }
    }
};
struct EpiBf16 {
    static constexpr bool PERM = true;
    bf16* O; int ldc; const float* rscale;
    DI void operator()(const f32x4 (&acc)[2][2][4][2], const Unit& u, int wr, int wc, int fr, int fq) const {
        const int half = u.pn >> 4; const int row0 = u.pm * BM + (half == 2 ? HALF : 0) + wr * 64 + fr; const int col0 = (u.pn & 15) * BM + wc * 32 + 8 * fq;
#pragma unroll
        for (int ai = 0; ai < 2; ++ai) { if (ai == 1 && half != 0) break;
#pragma unroll
            for (int m = 0; m < 4; ++m) { const int row = row0 + ai * HALF + m * 16; bf16* rowp = O + (size_t)row * ldc + col0; const float s = rscale ? rscale[row] : 1.0f;
#pragma unroll
                for (int bj = 0; bj < 2; ++bj) { const f32x4 v0 = acc[ai][bj][m][0] * s, v1 = acc[ai][bj][m][1] * s;
                    u32x4 w; w.x = cvt_pk_bf16(v0[0], v0[1]); w.y = cvt_pk_bf16(v0[2], v0[3]); w.z = cvt_pk_bf16(v1[0], v1[1]); w.w = cvt_pk_bf16(v1[2], v1[3]);
                    *(u32x4*)(rowp + bj * HALF) = w; } } }
    }
};
struct EpiUp {
    static constexpr bool PERM = true;
    bf16* QC; bf16* KVC; const float* rscale; unsigned char* G8;
    DI void operator()(const f32x4 (&acc)[2][2][4][2], const Unit& u, int wr, int wc, int fr, int fq) const {
        const int row0 = u.pm * BM + wr * 64 + fr; const bool kv = u.e == 1, gt = u.e == 2;
        if (gt) {
            const int off0 = 11 * BM + wc * 64 + fq * 16;
#pragma unroll
            for (int ai = 0; ai < 2; ++ai)
#pragma unroll
                for (int m = 0; m < 4; ++m) { u32x4 w; w.x = gate_q8x4(acc[ai][0][m][0]); w.y = gate_q8x4(acc[ai][0][m][1]); w.z = gate_q8x4(acc[ai][1][m][0]); w.w = gate_q8x4(acc[ai][1][m][1]);
                    *(u32x4*)(G8 + (size_t)(row0 + ai * HALF + m * 16) * GW + off0) = w; }
            return;
        }
        const int ld = kv ? KVW : QCW; const int col0 = (kv ? (u.pn - 3) : u.pn) * BM + wc * 32 + 8 * fq;
        const unsigned long long qi_ = (unsigned long long)QC, ki_ = (unsigned long long)KVC;
        const unsigned long long bsel = qi_ + (unsigned long long)(kv ? 1 : 0) * (ki_ - qi_);
#pragma unroll
        for (int ai = 0; ai < 2; ++ai)
#pragma unroll
            for (int m = 0; m < 4; ++m) { const int row = row0 + ai * HALF + m * 16; const size_t eo = (size_t)row * ld + col0; const float s = kv ? rscale[row] : 1.0f;
#pragma unroll
                for (int bj = 0; bj < 2; ++bj) { const f32x4 v0 = acc[ai][bj][m][0] * s, v1 = acc[ai][bj][m][1] * s;
                    u32x4 w; w.x = cvt_pk_bf16(v0[0], v0[1]); w.y = cvt_pk_bf16(v0[2], v0[3]); w.z = cvt_pk_bf16(v1[0], v1[1]); w.w = cvt_pk_bf16(v1[2], v1[3]);
                    *(GAS u32x4*)(bsel + (eo + bj * HALF) * 2) = w; } }
    }
};
struct EpiMerge {
    static constexpr bool PERM = true;
    bf16* MG; const unsigned char* G8;
    DI void mid(f32x4 (&acc)[2][2][4][2], u32x4 (&carry)[4], const Unit& u, int wr, int wc, int fr, int fq) const {
        const int row0 = u.pm * BM + wr * 64 + fr; const int off0 = (u.e * 4 + u.pn) * BM + wc * 64 + fq * 16;
        u32x4 ga[2][4], gb1[4];
#pragma unroll
        for (int m = 0; m < 4; ++m) { const unsigned char* gp = G8 + (size_t)(row0 + HALF + m * 16) * GW + off0; ga[1][m] = *(const u32x4*)gp; gb1[m] = *(const u32x4*)(gp + 4 * BM); }
        if (u.e == 0) {
#pragma unroll
            for (int m = 0; m < 4; ++m) ga[0][m] = *(const u32x4*)(G8 + (size_t)(row0 + m * 16) * GW + off0);
        } else {
#pragma unroll
            for (int m = 0; m < 4; ++m) ga[0][m] = carry[m];
        }
#pragma unroll
        for (int m = 0; m < 4; ++m) carry[m] = *(const u32x4*)(G8 + (size_t)(row0 + m * 16) * GW + off0 + 4 * BM);
#pragma unroll
        for (int ai = 0; ai < 2; ++ai)
#pragma unroll
            for (int m = 0; m < 4; ++m) { const u32x4 a = ga[ai][m], b = ai ? gb1[m] : carry[m];
                acc[ai][0][m][0] *= gate_f4(a.x) * rcp4(gate_f4(b.x)); acc[ai][0][m][1] *= gate_f4(a.y) * rcp4(gate_f4(b.y));
                acc[ai][1][m][0] *= gate_f4(a.z) * rcp4(gate_f4(b.z)); acc[ai][1][m][1] *= gate_f4(a.w) * rcp4(gate_f4(b.w)); }
    }
    DI void operator()(const f32x4 (&acc)[2][2][4][2], const u32x4 (&carry)[4], const Unit& u, int wr, int wc, int fr, int fq) const {
        const int row0 = u.pm * BM + wr * 64 + fr; const int col0 = u.pn * BM + wc * 32 + 8 * fq; const int off0 = (8 + u.pn) * BM + wc * 64 + fq * 16;
        u32x4 g1[4];
#pragma unroll
        for (int m = 0; m < 4; ++m) g1[m] = *(const u32x4*)(G8 + (size_t)(row0 + HALF + m * 16) * GW + off0);
#pragma unroll
        for (int ai = 0; ai < 2; ++ai)
#pragma unroll
            for (int m = 0; m < 4; ++m) { bf16* rowp = MG + (size_t)(row0 + ai * HALF + m * 16) * DM + col0; const u32x4 g = ai ? g1[m] : carry[m];
#pragma unroll
                for (int bj = 0; bj < 2; ++bj) { const f32x4 a0 = acc[ai][bj][m][0] * (gate_f4(bj ? g.z : g.x) * (1.0f / 255.0f)), a1 = acc[ai][bj][m][1] * (gate_f4(bj ? g.w : g.y) * (1.0f / 255.0f));
                    u32x4 w; w.x = cvt_pk_bf16(a0[0], a0[1]); w.y = cvt_pk_bf16(a0[2], a0[3]); w.z = cvt_pk_bf16(a1[0], a1[1]); w.w = cvt_pk_bf16(a1[2], a1[3]);
                    *(u32x4*)(rowp + bj * HALF) = w; } }
    }
};
struct EpiWo {
    static constexpr bool PERM = true;
    bf16* Y; const bf16* XB;
    DI void operator()(const f32x4 (&acc)[2][2][4][2], const Unit& u, int wr, int wc, int fr, int fq) const {
        const int row0 = u.pm * BM + wr * 64 + fr, col0 = u.pn * BM + wc * 32 + 8 * fq;
#pragma unroll
        for (int ai = 0; ai < 2; ++ai) {
            u32x4 xq[4][2];
#pragma unroll
            for (int m = 0; m < 4; ++m) { const size_t off = (size_t)(row0 + ai * HALF + m * 16) * DM + col0;
#pragma unroll
                for (int bj = 0; bj < 2; ++bj) xq[m][bj] = *(const u32x4*)(XB + off + bj * HALF); }
#pragma unroll
            for (int m = 0; m < 4; ++m) { const size_t off = (size_t)(row0 + ai * HALF + m * 16) * DM + col0;
#pragma unroll
                for (int bj = 0; bj < 2; ++bj) { const u32x4 xb = xq[m][bj]; const f32x4 a0 = acc[ai][bj][m][0], a1 = acc[ai][bj][m][1];
                    u32x4 w; w.x = cvt_pk_bf16(a0[0] + ALPHA * bflo(xb.x), a0[1] + ALPHA * bfhi(xb.x)); w.y = cvt_pk_bf16(a0[2] + ALPHA * bflo(xb.y), a0[3] + ALPHA * bfhi(xb.y));
                    w.z = cvt_pk_bf16(a1[0] + ALPHA * bflo(xb.z), a1[1] + ALPHA * bfhi(xb.z)); w.w = cvt_pk_bf16(a1[2] + ALPHA * bflo(xb.w), a1[3] + ALPHA * bfhi(xb.w));
                    *(u32x4*)(Y + off + bj * HALF) = w; } }
        }
    }
};
struct EpiMoeUp {
    static constexpr bool PERM = true;
    bf16* H;
    DI void operator()(const f32x4 (&acc)[2][2][4][2], const Unit& u, int wr, int wc, int fr, int fq) const {
        const int half = u.pn >> 4; const int row0 = u.pm * BM + (half == 2 ? HALF : 0) + wr * 64 + fr; const int col0 = (u.pn & 15) * HALF + wc * 32 + 8 * fq;
#pragma unroll
        for (int ai = 0; ai < 2; ++ai) { if (ai == 1 && half != 0) break;
#pragma unroll
            for (int m = 0; m < 4; ++m) { bf16* rowp = H + (size_t)(row0 + ai * HALF + m * 16) * DFF + col0; float o[8];
#pragma unroll
                for (int n = 0; n < 2; ++n)
#pragma unroll
                    for (int j = 0; j < 4; ++j) { const float g = acc[ai][0][m][n][j], up = acc[ai][1][m][n][j]; o[n * 4 + j] = g * fsigmoid(g) * up; }
                u32x4 w; w.x = cvt_pk_bf16(o[0], o[1]); w.y = cvt_pk_bf16(o[2], o[3]); w.z = cvt_pk_bf16(o[4], o[5]); w.w = cvt_pk_bf16(o[6], o[7]);
                *(u32x4*)rowp = w; } }
    }
};
}

#define XB_TMO      128
#define XB_XCNT(j)  (256  + 64 * (j))
#define XB_XSUB(j)  (1280 + 64 * (j))
#define XB_XGEN(j)  (2304 + 64 * (j))
#define XB_TOP      3328
#define XB_TOPGEN   3392
#define XCD_BAR_WORDS 3456
#define XB_SPIN_CAP (1u << 18)
DI unsigned xb_ld(unsigned* p)              { return __hip_atomic_load(p, __ATOMIC_RELAXED, __HIP_MEMORY_SCOPE_AGENT); }
DI unsigned xb_add(unsigned* p, unsigned v) { return __hip_atomic_fetch_add(p, v, __ATOMIC_RELAXED, __HIP_MEMORY_SCOPE_AGENT); }
DI unsigned xb_xcc_id() { return (unsigned)__builtin_amdgcn_s_getreg((3 << 11) | 20) & 0xFu; }
#define XB_SPIN(cond, bar) do { unsigned _sp = 0; while (cond) { __builtin_amdgcn_s_sleep(1); \
    if ((++_sp & 255u) == 0u) { if (xb_ld(&(bar)[XB_TMO])) break; if (_sp > XB_SPIN_CAP) { atomicAdd(&(bar)[XB_TMO], 1u); break; } } } } while (0)
struct XcdBarrier { unsigned* bar; unsigned x; volatile LAS unsigned* st; };
DI XcdBarrier xcd_barrier_post(unsigned* bar, volatile LAS unsigned* st) {
    XcdBarrier b; b.bar = bar; b.x = xb_xcc_id(); b.st = st;
    if (threadIdx.x == 0) (void)xb_add(&bar[XB_XCNT(b.x)], 1u);
    return b;
}
DI void xcd_barrier_complete(unsigned* bar, unsigned x, unsigned& nloc, unsigned& nx) {
    const unsigned G = gridDim.x * gridDim.y * gridDim.z;
    unsigned sum, cnt, mine, sp = 0u;
    for (;;) {
        sum = 0u; cnt = 0u; mine = 0u;
#pragma unroll
        for (unsigned j = 0; j < 16; ++j) { const unsigned c = xb_ld(&bar[XB_XCNT(j)]); sum += c; cnt += (c > 0u) ? 1u : 0u; mine = (j == x) ? c : mine; }
        if (sum == G) break;
        __builtin_amdgcn_s_sleep(1);
        if ((++sp & 255u) == 0u) { if (xb_ld(&bar[XB_TMO])) break; if (sp > XB_SPIN_CAP) { atomicAdd(&bar[XB_TMO], 1u); break; } }
    }
    nloc = mine > 0u ? mine : 1u; nx = cnt > 0u ? cnt : 1u;
}
DI void xcd_barrier(const XcdBarrier& b) {
    asm volatile("s_waitcnt vmcnt(0)" ::: "memory");
    __syncthreads();
    if (threadIdx.x == 0) {
        unsigned* bar = b.bar;
        __builtin_amdgcn_s_waitcnt(0);
        unsigned nloc = b.st[0], nx = b.st[1];
        if (nloc == 0u) { xcd_barrier_complete(bar, b.x, nloc, nx); b.st[0] = nloc; b.st[1] = nx; }
        const unsigned old = xb_add(&bar[XB_XSUB(b.x)], 1u);
        const unsigned gen = old / nloc;
        if (old + 1u == (gen + 1u) * nloc) {
            __builtin_amdgcn_fence(__ATOMIC_RELEASE, "agent");
            asm volatile("s_waitcnt vmcnt(0)" ::: "memory");
            const unsigned og = xb_add(&bar[XB_TOP], 1u);
            const unsigned tg = og / nx;
            if (og + 1u == (tg + 1u) * nx) xb_add(&bar[XB_TOPGEN], 1u);
            else XB_SPIN(xb_ld(&bar[XB_TOPGEN]) == tg, bar);
            __builtin_amdgcn_fence(__ATOMIC_ACQUIRE, "agent");
            xb_add(&bar[XB_XGEN(b.x)], 1u);
            asm volatile("s_waitcnt vmcnt(0)" ::: "memory");
        } else {
            XB_SPIN(xb_ld(&bar[XB_XGEN(b.x)]) == gen, bar);
            __builtin_amdgcn_fence(__ATOMIC_ACQUIRE, "agent");
            asm volatile("s_waitcnt vmcnt(0)" ::: "memory");
        }
    }
    __syncthreads();
}

DI float inv_freq16(int i) {
    const float t = (float)i * (-13.287712379549449f / 16.0f);
    return __builtin_amdgcn_exp2f(t);
}
DI void cos_sin(double a, float& c, float& s) {
    const double kq = __builtin_rint(a * 0.63661977236758134308);
    const double r = a - kq * 1.57079632679489661923;
    const double r2 = r * r;
    const double sp = r * (1.0 + r2 * (-1.0 / 6 + r2 * (1.0 / 120 + r2 * (-1.0 / 5040 + r2 * (1.0 / 362880 + r2 * (-1.0 / 39916800))))));
    const double cp = 1.0 + r2 * (-0.5 + r2 * (1.0 / 24 + r2 * (-1.0 / 720 + r2 * (1.0 / 40320 + r2 * (-1.0 / 3628800 + r2 * (1.0 / 479001600))))));
    const int q = (int)kq & 3;
    const double cc = (q == 0) ? cp : (q == 1) ? -sp : (q == 2) ? -cp : sp;
    const double ss = (q == 0) ? sp : (q == 1) ? cp : (q == 2) ? -sp : -cp;
    c = (float)cc; s = (float)ss;
}
DI int t5_bucket_n(int n) { return n < 8 ? n : n < 12 ? 8 : n < 16 ? 9 : n < 23 ? 10 : n < 32 ? 11 : n < 46 ? 12 : n < 64 ? 13 : n < 91 ? 14 : 15; }

DI void transpose_item(const float* W, int Nsrc, int k0, int n0, bf16* WT, int Kdst, int d0, const float* kscale, LAS float* scr, int lane) {
#pragma unroll
    for (int i = 0; i < 8; ++i) { const int kk = 8 * i + (lane >> 3); f32x4 v = *(const f32x4*)(W + (size_t)(k0 + kk) * Nsrc + n0 + 4 * (lane & 7)); if (kscale) v = v * kscale[k0 + kk];
        LAS float* d = scr + kk * 33 + 4 * (lane & 7); d[0] = v.x; d[1] = v.y; d[2] = v.z; d[3] = v.w; }
    LDS_WAIT(); asm volatile("" ::: "memory");
    const int c = lane & 7;
#pragma unroll
    for (int j = 0; j < 4; ++j) { const int n = (lane >> 3) + 8 * j; const LAS float* s = scr + (8 * c) * 33 + n;
        u32x4 o; o.x = pk2(s[0 * 33], s[1 * 33]); o.y = pk2(s[2 * 33], s[3 * 33]); o.z = pk2(s[4 * 33], s[5 * 33]); o.w = pk2(s[6 * 33], s[7 * 33]);
        *(GAS u32x4*)(WT + (size_t)(d0 + n) * Kdst + k0 + 8 * c) = o; }
    LDS_WAIT(); asm volatile("" ::: "memory");
}

struct Args { const float* in[25]; float* out; unsigned char* ws; int ph_lo, ph_hi; };

template <int TYPE>
DI void naive_attn_item(const Args& args, int l, int b, int h, int t) {
    constexpr int DQ = TYPE == 2 ? 96 : 64;
    unsigned char* ws = args.ws;
    bf16* P1 = (bf16*)(ws + WS_P1); bf16* QC = (bf16*)((unsigned char*)args.out + DO_QC); const bf16* KVC = (const bf16*)((unsigned char*)args.out + DO_KVC);
    const f32x2* ROPE = (const f32x2*)(ws + WS_ROPE);
    const size_t row = (size_t)b * SEQ + t;
    float q[DQ];
    const bf16* qsrc = TYPE == 0 ? P1 + row * P1W + C_QA + 64 * h : TYPE == 1 ? P1 + row * P1W + C_QB + 64 * h : QC + row * QCW + 96 * h;
#pragma unroll
    for (int c = 0; c < DQ / 8; ++c) { const u32x4 w = *(const u32x4*)(qsrc + 8 * c);
        q[8 * c + 0] = bflo(w.x); q[8 * c + 1] = bfhi(w.x); q[8 * c + 2] = bflo(w.y); q[8 * c + 3] = bfhi(w.y); q[8 * c + 4] = bflo(w.z); q[8 * c + 5] = bfhi(w.z); q[8 * c + 6] = bflo(w.w); q[8 * c + 7] = bfhi(w.w); }
    if (TYPE == 0) {
        float ss = 0.f;
#pragma unroll
        for (int d = 0; d < 64; ++d) ss += q[d] * q[d];
        const float r = 1.0f / sqrtf(ss * (1.0f / 64.0f) + EPS); const float* gq = args.in[4] + l * 64;
#pragma unroll
        for (int d = 0; d < 64; ++d) q[d] = q[d] * r * gq[d];
        const int gr = t >> 6, gc = t & 63;
#pragma unroll
        for (int i = 0; i < 16; ++i) { const f32x2 cr = ROPE[gr * 16 + i], cc = ROPE[gc * 16 + i];
            const float a1 = q[i], a2 = q[16 + i]; q[i] = a1 * cr.x - a2 * cr.y; q[16 + i] = a2 * cr.x + a1 * cr.y;
            const float b1 = q[32 + i], b2 = q[48 + i]; q[32 + i] = b1 * cc.x - b2 * cc.y; q[48 + i] = b2 * cc.x + b1 * cc.y; }
#pragma unroll
        for (int d = 0; d < 64; ++d) q[d] *= C2_64;
    } else if (TYPE == 1) {
#pragma unroll
        for (int d = 0; d < 64; ++d) q[d] *= C2_64;
    } else {
        const float rs = ((const float*)(ws + WS_RSTDQ))[row] * C2_96;
#pragma unroll
        for (int d = 0; d < 96; ++d) q[d] *= rs;
#pragma unroll
        for (int i = 0; i < 16; ++i) { const f32x2 cs = ROPE[t * 16 + i]; const float a1 = q[64 + i], a2 = q[80 + i]; q[64 + i] = a1 * cs.x - a2 * cs.y; q[80 + i] = a2 * cs.x + a1 * cs.y; }
    }
    float o[64];
#pragma unroll
    for (int d = 0; d < 64; ++d) o[d] = 0.f;
    float mx = -1e30f, lsum = 0.f;
    const int kvh = h >> 2;
    const int s_lo = TYPE == 1 ? (t - 128 < 0 ? 0 : t - 128) : 0, s_hi = TYPE == 1 ? (t + 128 > SEQ - 1 ? SEQ - 1 : t + 128) : SEQ - 1;
    const float* TB = (const float*)(ws + WS_TB) + h * 260;
    for (int s = s_lo; s <= s_hi; ++s) {
        const size_t krow = (size_t)b * SEQ + s;
        const bf16* kp = TYPE == 0 ? P1 + krow * P1W + C_KA + 64 * kvh : TYPE == 1 ? P1 + krow * P1W + C_KB + 64 * kvh : KVC + krow * KVW + 128 * h;
        const bf16* vp = TYPE == 0 ? P1 + krow * P1W + C_VA + 64 * kvh : TYPE == 1 ? P1 + krow * P1W + C_VB + 64 * kvh : KVC + krow * KVW + 128 * h + 64;
        float dot = 0.f;
#pragma unroll
        for (int c = 0; c < 8; ++c) { const u32x4 w = *(const u32x4*)(kp + 8 * c);
            dot += q[8 * c + 0] * bflo(w.x) + q[8 * c + 1] * bfhi(w.x) + q[8 * c + 2] * bflo(w.y) + q[8 * c + 3] * bfhi(w.y) + q[8 * c + 4] * bflo(w.z) + q[8 * c + 5] * bfhi(w.z) + q[8 * c + 6] * bflo(w.w) + q[8 * c + 7] * bfhi(w.w); }
        if (TYPE == 2) { const bf16* rp = P1 + krow * P1W + C_KR;
#pragma unroll
            for (int c = 0; c < 4; ++c) { const u32x4 w = *(const u32x4*)(rp + 8 * c);
                dot += q[64 + 8 * c + 0] * bflo(w.x) + q[64 + 8 * c + 1] * bfhi(w.x) + q[64 + 8 * c + 2] * bflo(w.y) + q[64 + 8 * c + 3] * bfhi(w.y) + q[64 + 8 * c + 4] * bflo(w.z) + q[64 + 8 * c + 5] * bfhi(w.z) + q[64 + 8 * c + 6] * bflo(w.w) + q[64 + 8 * c + 7] * bfhi(w.w); } }
        if (TYPE == 1) dot += TB[s - t + 128];
        const float mn = fmaxf(mx, dot), corr = __builtin_amdgcn_exp2f(mx - mn), p = __builtin_amdgcn_exp2f(dot - mn);
        lsum = lsum * corr + p; mx = mn;
#pragma unroll
        for (int c = 0; c < 8; ++c) { const u32x4 w = *(const u32x4*)(vp + 8 * c);
            o[8 * c + 0] = o[8 * c + 0] * corr + p * bflo(w.x); o[8 * c + 1] = o[8 * c + 1] * corr + p * bfhi(w.x); o[8 * c + 2] = o[8 * c + 2] * corr + p * bflo(w.y); o[8 * c + 3] = o[8 * c + 3] * corr + p * bfhi(w.y);
            o[8 * c + 4] = o[8 * c + 4] * corr + p * bflo(w.z); o[8 * c + 5] = o[8 * c + 5] * corr + p * bfhi(w.z); o[8 * c + 6] = o[8 * c + 6] * corr + p * bflo(w.w); o[8 * c + 7] = o[8 * c + 7] * corr + p * bfhi(w.w); }
    }
    if (TYPE == 1) { const float sk = args.in[6][l * 8 + h] * LOG2E; lsum += __builtin_amdgcn_exp2f(sk - mx); }
    const float inv = 1.0f / lsum;
    bf16* od = TYPE == 2 ? P1 + row * P1W + C_CQ + 64 * h : (bf16*)qsrc;
#pragma unroll
    for (int c = 0; c < 8; ++c) { u32x4 w; w.x = pk2(o[8 * c + 0] * inv, o[8 * c + 1] * inv); w.y = pk2(o[8 * c + 2] * inv, o[8 * c + 3] * inv); w.z = pk2(o[8 * c + 4] * inv, o[8 * c + 5] * inv); w.w = pk2(o[8 * c + 6] * inv, o[8 * c + 7] * inv);
        *(u32x4*)(od + 8 * c) = w; }
}


typedef float f32x16 __attribute__((ext_vector_type(16)));
typedef short s16x4 __attribute__((ext_vector_type(4)));
typedef short v4i16_t __attribute__((ext_vector_type(4)));
constexpr int ATT_TBL_OFF = 104448;
constexpr float ATT_NEG = -1.0e30f, ATT_THR = 6.0f;
DI s16x4 vtr(const LAS unsigned char* p) { return __builtin_bit_cast(s16x4, __builtin_amdgcn_ds_read_tr16_b64_v4i16((LAS v4i16_t*)p)); }
DI float max3f(float a, float b, float c) { float r; asm("v_max3_f32 %0, %1, %2, %3" : "=v"(r) : "v"(a), "v"(b), "v"(c)); return r; }
DI float half_max(float v) { auto rr = __builtin_amdgcn_permlane32_swap(__float_as_uint(v), __float_as_uint(v), false, false); return fmaxf(__uint_as_float(rr[0]), __uint_as_float(rr[1])); }
DI float half_sum(float v) { auto rr = __builtin_amdgcn_permlane32_swap(__float_as_uint(v), __float_as_uint(v), false, false); return __uint_as_float(rr[0]) + __uint_as_float(rr[1]); }
DI bf16x8 pack8(const float (&f)[8]) { u32x4 w; w.x = cvt_pk_bf16(f[0], f[1]); w.y = cvt_pk_bf16(f[2], f[3]); w.z = cvt_pk_bf16(f[4], f[5]); w.w = cvt_pk_bf16(f[6], f[7]); return __builtin_bit_cast(bf16x8, w); }
DI void unpack8(const u32x4 w, float (&f)[8]) { f[0] = bflo(w.x); f[1] = bfhi(w.x); f[2] = bflo(w.y); f[3] = bfhi(w.y); f[4] = bflo(w.z); f[5] = bfhi(w.z); f[6] = bflo(w.w); f[7] = bfhi(w.w); }

template <int TYPE>
DI void attn_unit(LAS unsigned char* lds, const int tid, const int l, const int b, const int hg, const int qt, bf16* P1, const bf16* QC, const bf16* KVC, const f32x2* ROPE, const float* RSTDQ, const float* gq, const float* sinkp) {
    constexpr int DQ = TYPE == 2 ? 96 : 64, NS = DQ / 16, KBUF = 64 * DQ * 2, VBUF = 64 * 128;
    const int lane = tid & 63, wave = __builtin_amdgcn_readfirstlane(tid >> 6), r = lane & 31, h = lane >> 5;
    const int head = TYPE == 2 ? hg : hg * 4 + (wave & 3);
    const int q0 = TYPE == 2 ? qt * 256 + wave * 32 : qt * 64 + (wave >> 2) * 32;
    const int tq = q0 + r;
    const size_t qrow = (size_t)b * SEQ + tq;
    bf16x8 qf[NS];
    {
        float q[NS][8];
        const bf16* qsrc = TYPE == 0 ? P1 + qrow * P1W + C_QA + 64 * head : TYPE == 1 ? P1 + qrow * P1W + C_QB + 64 * head : QC + qrow * QCW + 96 * head;
#pragma unroll
        for (int s = 0; s < NS; ++s) unpack8(*(const u32x4*)(qsrc + 16 * s + 8 * h), q[s]);
        if (TYPE == 0) {
            float ss = 0.f;
#pragma unroll
            for (int s = 0; s < 4; ++s)
#pragma unroll
                for (int j = 0; j < 8; ++j) ss += q[s][j] * q[s][j];
            ss = half_sum(ss);
            const float rn = 1.0f / sqrtf(ss * (1.0f / 64.0f) + EPS) * C2_64;
#pragma unroll
            for (int s = 0; s < 4; ++s)
#pragma unroll
                for (int j = 0; j < 8; ++j) q[s][j] *= rn * gq[16 * s + 8 * h + j];
            const int gr = tq >> 6, gc = tq & 63;
#pragma unroll
            for (int j = 0; j < 8; ++j) { const f32x2 cr = ROPE[gr * 16 + 8 * h + j], cc = ROPE[gc * 16 + 8 * h + j];
                const float a1 = q[0][j], a2 = q[1][j]; q[0][j] = a1 * cr.x - a2 * cr.y; q[1][j] = a2 * cr.x + a1 * cr.y;
                const float b1 = q[2][j], b2 = q[3][j]; q[2][j] = b1 * cc.x - b2 * cc.y; q[3][j] = b2 * cc.x + b1 * cc.y; }
        } else if (TYPE == 1) {
#pragma unroll
            for (int s = 0; s < 4; ++s)
#pragma unroll
                for (int j = 0; j < 8; ++j) q[s][j] *= C2_64;
        } else {
            const float rs = RSTDQ[qrow] * C2_96;
#pragma unroll
            for (int s = 0; s < NS; ++s)
#pragma unroll
                for (int j = 0; j < 8; ++j) q[s][j] *= rs;
#pragma unroll
            for (int j = 0; j < 8; ++j) { const f32x2 cs = ROPE[tq * 16 + 8 * h + j]; const float a1 = q[NS - 2][j], a2 = q[NS - 1][j]; q[NS - 2][j] = a1 * cs.x - a2 * cs.y; q[NS - 1][j] = a2 * cs.x + a1 * cs.y; }
        }
#pragma unroll
        for (int s = 0; s < NS; ++s) qf[s] = pack8(q[s]);
    }
    const int kvh = TYPE == 2 ? 0 : hg;
    const bf16* Kg = TYPE == 0 ? P1 + C_KA + 64 * kvh : TYPE == 1 ? P1 + C_KB + 64 * kvh : KVC + 128 * head;
    const bf16* Vg = TYPE == 0 ? P1 + C_VA + 64 * kvh : TYPE == 1 ? P1 + C_VB + 64 * kvh : KVC + 128 * head + 64;
    const int kvp = TYPE == 2 ? KVW : P1W;
    const int kt_lo = TYPE == 1 ? (qt - 2 < 0 ? 0 : qt - 2) : 0, kt_hi = TYPE == 1 ? (qt + 2 > 31 ? 31 : qt + 2) : 31, nt = kt_hi - kt_lo + 1;
    const size_t brow = (size_t)b * SEQ;
    constexpr int SLOT = KBUF + VBUF;
    const unsigned kvo_k = (unsigned)lane * (unsigned)(kvp * 2), kvo_v = ((unsigned)(lane >> 2) * (unsigned)kvp + (unsigned)(lane & 3) * 8u) * 2u, kvo_r = (unsigned)lane * (unsigned)(P1W * 2);
    const char* const gK = (const char*)(Kg + brow * kvp + wave * 8);
    const char* const gV = (const char*)(Vg + (brow + 16 * (wave & 3)) * kvp + (wave >> 2) * 32);
    const char* const gR = (const char*)(P1 + brow * P1W + C_KR + (wave & 3) * 8);
#define ATT_PIECE(gp, la) asm volatile("s_mov_b32 m0, %1\n\ts_nop 0\n\tglobal_load_lds_dwordx4 %0, off" :: "v"(gp), "s"(la) : "memory", "m0")
#define ATT_DMA(so, kt) do { const size_t to_ = (size_t)(kt) * 64 * (size_t)(kvp * 2); const unsigned la_ = ldsb + (unsigned)(so); \
        ATT_PIECE(gK + to_ + kvo_k, la_ + (unsigned)wave * 1024u); \
        ATT_PIECE(gV + to_ + kvo_v, la_ + (unsigned)(KBUF + (wave >> 2) * 4096 + (wave & 3) * 1024)); \
        if (TYPE == 2 && wave < 4) ATT_PIECE(gR + (size_t)(kt) * 64 * (size_t)(P1W * 2) + kvo_r, la_ + (unsigned)((8 + wave) * 1024)); } while (0)
    const unsigned ldsb = (unsigned)(size_t)lds;
    const int koff = h * 1024 + r * 16;
    const int voff = KBUF + (4 * h + ((lane & 15) >> 2)) * 64 + ((lane >> 4) & 1) * 32 + (lane & 3) * 8;
    const int tboff = ATT_TBL_OFF + head * 1536 + (192 + 4 * h - tq) * 4;
    constexpr bool REL = (NS == 4);
    f32x16 o0, o1, negm, zero16;
#pragma unroll
    for (int i = 0; i < 16; ++i) { o0[i] = 0.f; o1[i] = 0.f; negm[i] = 0.f; zero16[i] = 0.f; }
    float m_run = 0.f, l_run = 0.f;
    int s_cur = 0, s_nxt = SLOT, s_nn = 2 * SLOT, s_n3 = 3 * SLOT, s_n4 = 4 * SLOT;
    bf16x8 kfr[2 * NS]; s16x4 vlo[8], vhi[8]; bf16x8 pf[4];
#define ATT_KREAD(so, S0, S1) do { const LAS unsigned char* Kb_ = lds + (so) + koff; \
        _Pragma("unroll") for (int s = S0; s < S1; ++s) { kfr[2 * s] = *(const LAS bf16x8*)(Kb_ + s * 2048); kfr[2 * s + 1] = *(const LAS bf16x8*)(Kb_ + 512 + s * 2048); } } while (0)
#define ATT_VREAD(so, K0, K1) do { const LAS unsigned char* Vb_ = lds + (so) + voff; \
        _Pragma("unroll") for (int kk = K0; kk < K1; ++kk) { vlo[2 * kk] = vtr(Vb_ + kk * 1024); vhi[2 * kk] = vtr(Vb_ + kk * 1024 + 512); vlo[2 * kk + 1] = vtr(Vb_ + kk * 1024 + 4096); vhi[2 * kk + 1] = vtr(Vb_ + kk * 1024 + 512 + 4096); } } while (0)
#define ATT_VF(i) (bf16x8){vlo[i][0], vlo[i][1], vlo[i][2], vlo[i][3], vhi[i][0], vhi[i][1], vhi[i][2], vhi[i][3]}
#define ATT_QKM(N0, N1, j) do { if (((j) & 1) == 0) N0 = __builtin_amdgcn_mfma_f32_32x32x16_bf16(kfr[j], qf[(j) >> 1], ((j) >> 1) == 0 ? (REL ? negm : zero16) : N0, 0, 0, 0); \
        else N1 = __builtin_amdgcn_mfma_f32_32x32x16_bf16(kfr[j], qf[(j) >> 1], ((j) >> 1) == 0 ? (REL ? negm : zero16) : N1, 0, 0, 0); } while (0)
#define ATT_EXP4(C, c, PFW, wlo) do { const float sh_ = REL ? 0.f : m_run; const float e0 = __builtin_amdgcn_exp2f(C[4 * (c)] - sh_), e1 = __builtin_amdgcn_exp2f(C[4 * (c) + 1] - sh_), e2 = __builtin_amdgcn_exp2f(C[4 * (c) + 2] - sh_), e3 = __builtin_amdgcn_exp2f(C[4 * (c) + 3] - sh_); \
        lsa += e0; lsb += e1; lsa += e2; lsb += e3; if (wlo) { PFW.x = cvtpk(e0, e1); PFW.y = cvtpk(e2, e3); } else { PFW.z = cvtpk(e0, e1); PFW.w = cvtpk(e2, e3); } } while (0)
#define ATT_BIAS(N0, N1, tt) do { if (TYPE == 1) { const LAS float* tb = (const LAS float*)(lds + tboff + (kt_lo + (tt)) * 256); \
        _Pragma("unroll") for (int i = 0; i < 16; ++i) { N0[i] += tb[(i & 3) + 8 * (i >> 2)]; N1[i] += tb[32 + (i & 3) + 8 * (i >> 2)]; } } } while (0)
#define ATT_BIAS4(N0, N1, tt, c) do { if (TYPE == 1) { const volatile LAS float* tb = (const volatile LAS float*)(lds + tboff + (kt_lo + (tt)) * 256 + 32 * (c)); \
        _Pragma("unroll") for (int i = 0; i < 4; ++i) { N0[4 * (c) + i] += tb[i]; N1[4 * (c) + i] += tb[32 + i]; } } } while (0)
#define PIN2(a_, b_) asm volatile("" : "+v"(a_), "+v"(b_))
#define PIN3(a_, b_, c_) asm volatile("" : "+v"(a_), "+v"(b_), "+v"(c_))
#define PIN4(a_, b_, c_, d_) asm volatile("" : "+v"(a_), "+v"(b_), "+v"(c_), "+v"(d_))
#define ATT_MAX4(N0, N1, c, acc) do { if (TYPE == 1) { acc = fmaxf(acc, fmaxf(fmaxf(N0[4 * (c)], N0[4 * (c) + 1]), fmaxf(N0[4 * (c) + 2], N0[4 * (c) + 3]))); acc = fmaxf(acc, fmaxf(fmaxf(N1[4 * (c)], N1[4 * (c) + 1]), fmaxf(N1[4 * (c) + 2], N1[4 * (c) + 3]))); } \
        else { acc = max3f(acc, N0[4 * (c)], N0[4 * (c) + 1]); acc = max3f(acc, N0[4 * (c) + 2], N0[4 * (c) + 3]); acc = max3f(acc, N1[4 * (c)], N1[4 * (c) + 1]); acc = max3f(acc, N1[4 * (c) + 2], N1[4 * (c) + 3]); } } while (0)
    ATT_DMA(0, kt_lo); ATT_DMA(SLOT, kt_lo + 1); ATT_DMA(2 * SLOT, kt_lo + 2); ATT_DMA(3 * SLOT, kt_lo + (nt > 3 ? 3 : 2));
    asm volatile("s_waitcnt vmcnt(0)" ::: "memory");
    __syncthreads();
    f32x16 sa0, sa1, sb0, sb1; float tmx;
    ATT_KREAD(0, 0, NS);
#pragma unroll
    for (int j = 0; j < 2 * NS; ++j) ATT_QKM(sa0, sa1, j);
    ATT_BIAS(sa0, sa1, 0);
    tmx = ATT_NEG;
#pragma unroll
    for (int c = 0; c < 4; ++c) tmx = fmaxf(tmx, fmaxf(fmaxf(fmaxf(sa0[4 * c], sa0[4 * c + 1]), fmaxf(sa0[4 * c + 2], sa0[4 * c + 3])), fmaxf(fmaxf(sa1[4 * c], sa1[4 * c + 1]), fmaxf(sa1[4 * c + 2], sa1[4 * c + 3]))));
    tmx = half_max(tmx);
    m_run = tmx;
    if (REL) {
#pragma unroll
        for (int i = 0; i < 16; ++i) { sa0[i] -= m_run; sa1[i] -= m_run; negm[i] = -m_run; }
        tmx = 0.f; }
#ifndef ATT_KP
#define ATT_KP 4
#endif
    constexpr int KP = ATT_KP;
    if (KP > 0 && nt > 1) ATT_KREAD(SLOT, 0, KP);
#define ATT_STEP(C0, C1, N0, N1, t, FULL, PRE) do { \
        if (FULL) ATT_KREAD(s_nxt, KP, 4); \
        if (__any(tmx > (REL ? 0.f : m_run) + ATT_THR)) { const float dl = fmaxf(tmx - (REL ? 0.f : m_run), 0.f), al = __builtin_amdgcn_exp2f(-dl); m_run += dl; l_run *= al; \
            _Pragma("unroll") for (int i = 0; i < 16; ++i) { o0[i] *= al; o1[i] *= al; } \
            if (REL) { _Pragma("unroll") for (int i = 0; i < 16; ++i) { C0[i] -= dl; C1[i] -= dl; negm[i] = -m_run; } } } \
        float lsa = 0.f, lsb = 0.f; u32x4 w0_ = (u32x4){0u, 0u, 0u, 0u}, w1_ = w0_, w2_ = w0_, w3_ = w0_; \
        if (FULL) ATT_QKM(N0, N1, 0); ATT_EXP4(C0, 0, w0_, true);  if (FULL) { PIN4(N0, lsa, lsb, w0_); } else { PIN3(lsa, lsb, w0_); } \
        if (FULL) ATT_QKM(N0, N1, 1); ATT_EXP4(C0, 1, w0_, false); if (FULL) { PIN4(N1, lsa, lsb, w0_); } else { PIN3(lsa, lsb, w0_); } \
        if (FULL) ATT_QKM(N0, N1, 2); ATT_EXP4(C0, 2, w1_, true);  if (FULL) { PIN4(N0, lsa, lsb, w1_); } else { PIN3(lsa, lsb, w1_); } \
        if (FULL) ATT_QKM(N0, N1, 3); ATT_EXP4(C0, 3, w1_, false); if (FULL && NS > 4) ATT_KREAD(s_nxt, 4, NS); ATT_VREAD(s_cur, 0, 2); if (FULL) { PIN4(N1, lsa, lsb, w1_); } else { PIN3(lsa, lsb, w1_); } \
        if (FULL) ATT_QKM(N0, N1, 4); ATT_EXP4(C1, 0, w2_, true);  if (FULL) { PIN4(N0, lsa, lsb, w2_); } else { PIN3(lsa, lsb, w2_); } \
        if (FULL) ATT_QKM(N0, N1, 5); ATT_EXP4(C1, 1, w2_, false); if (FULL) { PIN4(N1, lsa, lsb, w2_); } else { PIN3(lsa, lsb, w2_); } \
        if (FULL) ATT_QKM(N0, N1, 6); ATT_EXP4(C1, 2, w3_, true);  if (FULL) { PIN4(N0, lsa, lsb, w3_); } else { PIN3(lsa, lsb, w3_); } \
        if (FULL) ATT_QKM(N0, N1, 7); ATT_EXP4(C1, 3, w3_, false); if (FULL) { PIN4(N1, lsa, lsb, w3_); } else { PIN3(lsa, lsb, w3_); } \
        if (FULL && NS > 4) { ATT_QKM(N0, N1, 8); ATT_QKM(N0, N1, 9); ATT_QKM(N0, N1, 10); ATT_QKM(N0, N1, 11); } \
        ATT_VREAD(s_cur, 2, 4); \
        { const int kn_ = (t) + 4 < nt ? (t) + 4 : nt - 1; ATT_DMA(s_n4, kt_lo + kn_); }     \
        l_run += lsa + lsb; \
        pf[0] = __builtin_bit_cast(bf16x8, w0_); pf[1] = __builtin_bit_cast(bf16x8, w1_); pf[2] = __builtin_bit_cast(bf16x8, w2_); pf[3] = __builtin_bit_cast(bf16x8, w3_); \
        tmx = ATT_NEG; \
        o0 = __builtin_amdgcn_mfma_f32_32x32x16_bf16(ATT_VF(0), pf[0], o0, 0, 0, 0); if (KP > 0 && PRE) ATT_KREAD(s_nn, 0, KP); PIN2(o0, tmx); \
        o1 = __builtin_amdgcn_mfma_f32_32x32x16_bf16(ATT_VF(1), pf[0], o1, 0, 0, 0); PIN2(o1, tmx); \
        o0 = __builtin_amdgcn_mfma_f32_32x32x16_bf16(ATT_VF(2), pf[1], o0, 0, 0, 0); PIN2(o0, tmx); \
        o1 = __builtin_amdgcn_mfma_f32_32x32x16_bf16(ATT_VF(3), pf[1], o1, 0, 0, 0); if (FULL) { ATT_BIAS4(N0, N1, (t) + 1, 0); ATT_MAX4(N0, N1, 0, tmx); } PIN2(o1, tmx); \
        o0 = __builtin_amdgcn_mfma_f32_32x32x16_bf16(ATT_VF(4), pf[2], o0, 0, 0, 0); if (FULL) { ATT_BIAS4(N0, N1, (t) + 1, 1); ATT_MAX4(N0, N1, 1, tmx); } PIN2(o0, tmx); \
        o1 = __builtin_amdgcn_mfma_f32_32x32x16_bf16(ATT_VF(5), pf[2], o1, 0, 0, 0); if (FULL) { ATT_BIAS4(N0, N1, (t) + 1, 2); ATT_MAX4(N0, N1, 2, tmx); } PIN2(o1, tmx); \
        o0 = __builtin_amdgcn_mfma_f32_32x32x16_bf16(ATT_VF(6), pf[3], o0, 0, 0, 0); if (FULL) { ATT_BIAS4(N0, N1, (t) + 1, 3); ATT_MAX4(N0, N1, 3, tmx); } PIN2(o0, tmx); \
        o1 = __builtin_amdgcn_mfma_f32_32x32x16_bf16(ATT_VF(7), pf[3], o1, 0, 0, 0); PIN2(o1, tmx); \
        if (FULL) tmx = half_max(tmx); \
        if (TYPE == 2 && wave < 4) asm volatile("s_waitcnt vmcnt(3) lgkmcnt(0)\n\ts_barrier" ::: "memory"); else asm volatile("s_waitcnt vmcnt(2) lgkmcnt(0)\n\ts_barrier" ::: "memory");     \
        { const int tmp_ = s_cur; s_cur = s_nxt; s_nxt = s_nn; s_nn = s_n3; s_n3 = s_n4; s_n4 = tmp_; } \
    } while (0)
    int t = 0;
    if (TYPE != 1) {
        for (; t + 2 < nt; t += 2) { ATT_STEP(sa0, sa1, sb0, sb1, t, true, true); ATT_STEP(sb0, sb1, sa0, sa1, t + 1, true, true); }
        ATT_STEP(sa0, sa1, sb0, sb1, t, true, false); ATT_STEP(sb0, sb1, sa0, sa1, t + 1, false, false);
    } else {
        for (; t + 1 < nt; t += 2) { ATT_STEP(sa0, sa1, sb0, sb1, t, true, true); ATT_STEP(sb0, sb1, sa0, sa1, t + 1, true, true); }
        if (t < nt) { ATT_STEP(sa0, sa1, sb0, sb1, t, true, true); }
    }
#undef ATT_STEP
#undef ATT_MAX4
#undef PIN2
#undef PIN3
#undef PIN4
#undef ATT_BIAS
#undef ATT_BIAS4
#undef ATT_EXP4
#undef ATT_QKM
#undef ATT_VF
#undef ATT_VREAD
#undef ATT_KREAD
#undef ATT_DMA
    float lt = half_sum(l_run);
    if (TYPE == 1) lt += __builtin_amdgcn_exp2f(sinkp[head] * LOG2E - m_run);
    const float inv = 1.0f / lt;
    unsigned char* ob = (unsigned char*)(P1 + qrow * P1W + (TYPE == 0 ? C_QA : TYPE == 1 ? C_QB : C_CQ) + 64 * head) + (h ? 16 : 0);
#pragma unroll
    for (int p = 0; p < 4; ++p) {
        const int g0 = (2 * p) & 3, g1 = g0 + 1;
        unsigned ax, ay, bx2, by2;
        if (p < 2) { ax = cvt_pk_bf16(o0[4 * g0] * inv, o0[4 * g0 + 1] * inv); ay = cvt_pk_bf16(o0[4 * g0 + 2] * inv, o0[4 * g0 + 3] * inv); bx2 = cvt_pk_bf16(o0[4 * g1] * inv, o0[4 * g1 + 1] * inv); by2 = cvt_pk_bf16(o0[4 * g1 + 2] * inv, o0[4 * g1 + 3] * inv); }
        else       { ax = cvt_pk_bf16(o1[4 * g0] * inv, o1[4 * g0 + 1] * inv); ay = cvt_pk_bf16(o1[4 * g0 + 2] * inv, o1[4 * g0 + 3] * inv); bx2 = cvt_pk_bf16(o1[4 * g1] * inv, o1[4 * g1 + 1] * inv); by2 = cvt_pk_bf16(o1[4 * g1 + 2] * inv, o1[4 * g1 + 3] * inv); }
        { auto r_ = __builtin_amdgcn_permlane32_swap(ax, bx2, false, false); ax = r_[0]; bx2 = r_[1]; }
        { auto r_ = __builtin_amdgcn_permlane32_swap(ay, by2, false, false); ay = r_[0]; by2 = r_[1]; }
        *(u32x4*)(ob + 32 * p) = (u32x4){ax, ay, bx2, by2};
    }
}

constexpr int NPH = 1 + 11 * DEPTH;
__global__ void __launch_bounds__(512, 2) fwd_kernel(Args args) {
    extern __shared__ __attribute__((aligned(16))) unsigned char lds_raw[];
    LAS unsigned char* lds = (LAS unsigned char*)lds_raw;
    volatile LAS unsigned* MISC = (volatile LAS unsigned*)(lds + LDSCTL_OFF);
    const int tid0 = threadIdx.x, wave = __builtin_amdgcn_readfirstlane(tid0 >> 6);
    const int G = gridDim.x, bx = blockIdx.x;
    const int gw = bx * 8 + wave, NGW = G * 8;
    unsigned char* const ws0 = args.ws; unsigned char* const out0 = (unsigned char*)args.out;
    for (int u = tid0; u < (LDS_BYTES - LDSCTL_OFF) / 4; u += 512) MISC[u] = 0u;
    __syncthreads();
    XcdBarrier bar; bar.bar = (unsigned*)(ws0 + WS_CTL) + CW_BAR; bar.x = 0; bar.st = nullptr;
#if ONE_LAUNCH
    bar = xcd_barrier_post((unsigned*)(ws0 + WS_CTL) + CW_BAR, MISC + 8);
#endif
    const int lo = args.ph_lo, hi = args.ph_hi;
#define IN(k) (lo <= (k) && (k) < hi)
#define SEAM(k) do { if (IN(k) && IN((k) + 1)) { if (ONE_LAUNCH) xcd_barrier(bar); } } while (0)

#define PHASE_BEGIN \
    unsigned ones_ = ~0u; asm volatile("" : "+s"(ones_)); \
    int tid = wave * 64 + (int)__builtin_amdgcn_mbcnt_hi(ones_, __builtin_amdgcn_mbcnt_lo(ones_, 0u)); asm volatile("" : "+v"(tid)); const int lane = tid & 63; \
    size_t zoff = 0; asm volatile("" : "+s"(zoff)); unsigned char* ws = ws0 + zoff; unsigned char* outb = out0 + zoff; \
    unsigned* ctl = (unsigned*)(ws + WS_CTL); (void)ctl; (void)lane; \
    bf16* XB = (bf16*)(ws + WS_XB); bf16* P1 = (bf16*)(ws + WS_P1); bf16* GB = (bf16*)(ws + WS_G); (void)XB; (void)P1; (void)GB; \
    bf16* QC = (bf16*)(outb + DO_QC); bf16* KVC = (bf16*)(outb + DO_KVC); bf16* MG = KVC; (void)QC; (void)KVC; (void)MG; \
    bf16* Y = (bf16*)(ws + WS_G); bf16* HID = (bf16*)(ws + WS_P1); bf16* PAIR = (bf16*)(ws + WS_G); (void)Y; (void)HID; (void)PAIR; \
    unsigned char* Wb = ws + WS_W; (void)Wb; \
    f32x2* ROPE = (f32x2*)(ws + WS_ROPE); float* TB = (float*)(ws + WS_TB); (void)ROPE; (void)TB; \
    float* RSTDQ = (float*)(ws + WS_RSTDQ); float* RSTDKV = (float*)(ws + WS_RSTDKV); (void)RSTDQ; (void)RSTDKV; \
    int* LIST = (int*)(ws + WS_LIST); unsigned* ROUTE = (unsigned*)(ws + WS_ROUTE); (void)LIST; (void)ROUTE;

    if (EN(11) && IN(0)) { PHASE_BEGIN
        for (int idx = bx * 512 + tid; idx < 2048 * 16; idx += G * 512) { const int pos = idx >> 4, i = idx & 15; float c, s; cos_sin((double)pos * (double)inv_freq16(i), c, s); ROPE[idx] = (f32x2){c, s}; }
        for (int idx = bx * 512 + tid; idx < 8 * 257; idx += G * 512) { const int h = idx / 257, r = idx % 257, rel = r - 128; const int n = rel < 0 ? -rel : rel;
            const int bk = t5_bucket_n(n) + (rel > 0 ? 16 : 0); TB[h * 260 + r] = args.in[7][bk * 8 + h] * LOG2E; }
        const float* g = args.in[1]; const float* bb = args.in[2];
        f32x4 gv[4], bv[4];
#pragma unroll
        for (int j = 0; j < 4; ++j) { gv[j] = *(const f32x4*)(g + 256 * j + 4 * lane); bv[j] = *(const f32x4*)(bb + 256 * j + 4 * lane); }
        f32x4 xnx[4];
#pragma unroll
        for (int j = 0; j < 4; ++j) xnx[j] = *(const f32x4*)(args.in[0] + (size_t)(gw < NTOK ? gw : 0) * DM + 256 * j + 4 * lane);
        for (int m = gw; m < NTOK; m += NGW) {
            f32x4 v[4]; float s = 0.f;
#pragma unroll
            for (int j = 0; j < 4; ++j) { v[j] = xnx[j]; s += (v[j].x + v[j].y) + (v[j].z + v[j].w); }
            if (m + NGW < NTOK) {
#pragma unroll
                for (int j = 0; j < 4; ++j) xnx[j] = *(const f32x4*)(args.in[0] + (size_t)(m + NGW) * DM + 256 * j + 4 * lane); }
            const float mean = wave_sum(s) * (1.f / DM); float s2 = 0.f;
#pragma unroll
            for (int j = 0; j < 4; ++j) { v[j] = v[j] - mean; s2 += (v[j].x * v[j].x + v[j].y * v[j].y) + (v[j].z * v[j].z + v[j].w * v[j].w); }
            const float rstd = 1.f / sqrtf(wave_sum(s2) * (1.f / DM) + EPS);
#pragma unroll
            for (int j = 0; j < 4; ++j) { const f32x4 o = v[j] * rstd * gv[j] + bv[j]; *(u32x2*)(XB + (size_t)m * DM + 256 * j + 4 * lane) = (u32x2){pk2(o.x, o.y), pk2(o.z, o.w)}; }
        }
    }

    for (int l = 0; l < DEPTH; ++l) {
        const int pb = 1 + 11 * l;
        if (EN(0) && IN(pb + 0)) for (int rep_ = 0; rep_ < REPS_0; ++rep_) { PHASE_BEGIN
            LAS float* scr = (LAS float*)(lds + wave * 16384);
            const float* w_in = args.in[3] + (size_t)l * DM * INCOLS;
            const float* w_uq = args.in[10] + (size_t)l * 384 * 768; const float* w_ukv = args.in[11] + (size_t)l * 256 * 1024;
            const float* w_o = args.in[15] + (size_t)l * 1024 * 1024;
            const float* w_gate = args.in[20] + (size_t)l * 16 * 1024 * 512; const float* w_up = args.in[21] + (size_t)l * 16 * 1024 * 512; const float* w_down = args.in[22] + (size_t)l * 16 * 512 * 1024;
            const float* g_cq = args.in[8] + l * 384; const float* g_ckv = args.in[9] + l * 256;
            constexpr int I0 = 16 * 165, I1 = 6 * 24, I2 = 4 * 32, I3 = 8 * 32, I6 = 16 * 32, I7 = 16 * 16 * 16, I9 = 16 * 8 * 32;
            constexpr int NIT = I0 + I1 + I2 + 3 * I3 + I6 + 2 * I7 + I9;
            for (int it = gw; it < NIT; it += NGW) {
                int r = it;
                if (r < I0) { const int kb = r / 165, nb = r % 165; transpose_item(w_in, INCOLS, 64 * kb, 32 * nb, (bf16*)(Wb + W_WIN), 1024, 32 * (nb < 69 ? nb : nb + 3), nullptr, scr, lane); continue; } r -= I0;
                if (r < I1) { const int kb = r / 24, nb = r % 24; transpose_item(w_uq, 768, 64 * kb, 32 * nb, (bf16*)(Wb + W_WUP), 1024, 32 * nb, g_cq, scr, lane); continue; } r -= I1;
                if (r < I2) { const int kb = r / 32, nb = r % 32; transpose_item(w_ukv, 1024, 64 * kb, 32 * nb, (bf16*)(Wb + W_WUP), 1024, 768 + 32 * nb, g_ckv, scr, lane); continue; } r -= I2;
                if (r < 3 * I3) { const int j = r / I3, q = r % I3, kb = q / 32, nb = q % 32; transpose_item((j == 0 ? args.in[12] : j == 1 ? args.in[13] : args.in[14]) + (size_t)l * 512 * 1024, 1024, 64 * kb, 32 * nb, (bf16*)(Wb + W_WBR) + (size_t)j * 1024 * 512, 512, 32 * nb, nullptr, scr, lane); continue; } r -= 3 * I3;
                if (r < I6) { const int kb = r / 32, nb = r % 32; transpose_item(w_o, 1024, 64 * kb, 32 * nb, (bf16*)(Wb + W_WO), 1024, 32 * nb, nullptr, scr, lane); continue; } r -= I6;
                if (r < 2 * I7) { const int up = r / I7, q = r % I7, e = q / 256, kb = (q % 256) / 16, nb = q % 16;
                    transpose_item((up ? w_up : w_gate) + (size_t)e * 1024 * 512, 512, 64 * kb, 32 * nb, (bf16*)(Wb + W_WGU) + (size_t)e * 1024 * 1024, 1024, 32 * ((nb >> 2) * 8 + up * 4 + (nb & 3)), nullptr, scr, lane); continue; } r -= 2 * I7;
                { const int e = r / 256, kb = (r % 256) / 32, nb = r % 32; transpose_item(w_down + (size_t)e * 512 * 1024, 1024, 64 * kb, 32 * nb, (bf16*)(Wb + W_WD) + (size_t)e * 1024 * 512, 512, 32 * nb, nullptr, scr, lane); }
            }
            { unsigned zu = 0u; asm volatile("" : "+v"(zu));
              for (int idx = bx * 512 + tid; idx < 96 * 1024 / 8; idx += G * 512) *(u32x4*)((bf16*)(Wb + W_WIN) + (size_t)2208 * 1024 + (size_t)idx * 8) = (u32x4){zu, zu, zu, zu}; }
        }
        SEAM(pb + 0);

        if (EN(1) && IN(pb + 1)) for (int rep_ = 0; rep_ < REPS_1; ++rep_) { PHASE_BEGIN
            pg8::SchedPlain S; S.o.init(NTOK / 256, INW / 256 - 1, G, bx); S.A = (const char*)XB; S.Bt = (const char*)(Wb + W_WIN);
            S.lda2 = 2048; S.ldb2 = 2048;
            pg8::EpiInproj E{P1, (unsigned char*)GB};
            pg8::gemm_phase<pg8::EpiInproj, pg8::SchedPlain, true>(lds, tid, 1024, 2048, S, E);
        }
        SEAM(pb + 1);

        if (EN(2) && IN(pb + 2)) { PHASE_BEGIN
            const float* gk = args.in[5] + l * 64;
            const float gk0 = gk[2 * (lane & 31)], gk1 = gk[2 * (lane & 31) + 1];
            constexpr int RF = 8;
            for (int m0 = gw; m0 < NTOK; m0 += RF * NGW) {
                unsigned wka[RF], wq[RF][3], wk[RF][2]; float vkr[RF]; f32x2 rc0[RF], rc1[RF], rcs[RF];
#pragma unroll
                for (int q = 0; q < RF; ++q) { const int m = m0 + q * NGW < NTOK ? m0 + q * NGW : m0; const bf16* pr = P1 + (size_t)m * P1W;
                    wka[q] = *(const unsigned*)(pr + C_KA + 2 * lane); vkr[q] = lane < 32 ? bf2f(pr[C_KR + lane]) : 0.f;
#pragma unroll
                    for (int j = 0; j < 3; ++j) wq[q][j] = *(const unsigned*)(pr + C_CQ + 128 * j + 2 * lane);
#pragma unroll
                    for (int j = 0; j < 2; ++j) wk[q][j] = *(const unsigned*)(pr + C_CKV + 128 * j + 2 * lane);
                    const int t = m & (SEQ - 1), gr = t >> 6, gc = t & 63, ll = lane & 31, pos = ll < 16 ? gr : gc, i0 = (2 * ll) & 15;
                    rc0[q] = ROPE[pos * 16 + i0]; rc1[q] = ROPE[pos * 16 + i0 + 1]; rcs[q] = ROPE[t * 16 + (lane & 15)]; }
#pragma unroll
                for (int q = 0; q < RF; ++q) { const int m = m0 + q * NGW; if (m < NTOK) {
                    bf16* pr = P1 + (size_t)m * P1W;
                    {
                        const int ll = lane & 31; float a = bflo(wka[q]), b = bfhi(wka[q]);
                        float ss = sum32(a * a + b * b);
                        const float r = 1.0f / sqrtf(ss * (1.0f / 64.0f) + EPS); a = a * r * gk0; b = b * r * gk1;
                        const float pa = swz_xor<8>(a), pbv = swz_xor<8>(b);
                        const f32x2 c0 = rc0[q], c1 = rc1[q];
                        const bool first = (ll & 8) == 0;
                        const float oa = first ? a * c0.x - pa * c0.y : a * c0.x + pa * c0.y, ob = first ? b * c1.x - pbv * c1.y : b * c1.x + pbv * c1.y;
                        *(unsigned*)(pr + C_KA + 2 * lane) = pk2(oa, ob);
                    }
                    {
                        const float v = vkr[q]; const float p = swz_xor<16>(v);
                        const f32x2 cs = rcs[q]; const float o = (lane < 16) ? v * cs.x - p * cs.y : v * cs.x + p * cs.y;
                        if (lane < 32) pr[C_KR + lane] = (bf16)f2bf(o);
                    }
                    {
                        float sq = 0.f, sk = 0.f;
#pragma unroll
                        for (int j = 0; j < 3; ++j) sq += bflo(wq[q][j]) * bflo(wq[q][j]) + bfhi(wq[q][j]) * bfhi(wq[q][j]);
#pragma unroll
                        for (int j = 0; j < 2; ++j) sk += bflo(wk[q][j]) * bflo(wk[q][j]) + bfhi(wk[q][j]) * bfhi(wk[q][j]);
                        sq = wave_sum(sq); sk = wave_sum(sk);
                        if (lane == 0) { RSTDQ[m] = 1.0f / sqrtf(sq * (1.0f / 384.0f) + EPS); RSTDKV[m] = 1.0f / sqrtf(sk * (1.0f / 256.0f) + EPS); }
                    } } }
            }
        }
        SEAM(pb + 2);

        if (EN(3) && IN(pb + 3)) for (int rep_ = 0; rep_ < REPS_3; ++rep_) { PHASE_BEGIN
            pg8::SchedUp S; S.G = G; S.c = bx; S.wsb = (const char*)ws; S.lda2 = P1W * 2;
            pg8::EpiUp E{QC, KVC, RSTDKV, (unsigned char*)GB};
            pg8::gemm_phase<pg8::EpiUp, pg8::SchedUp, true>(lds, tid, 384, 2048, S, E);
        }
        SEAM(pb + 3);

        if (EN(4) && IN(pb + 4)) { PHASE_BEGIN
#if ((ATTN_FAST & 7) != 7) && !defined(ATT_NO_NAIVE)
            for (int it = bx * 512 + tid; it < 3 * NBATCH * 8 * SEQ; it += G * 512) {
                const int t = it & (SEQ - 1), h = (it >> 11) & 7, b = (it >> 14) & 15, ty = it >> 18;
                if (ty == 0) { if (!(ATTN_FAST & 1)) naive_attn_item<0>(args, l, b, h, t); } else if (ty == 1) { if (!(ATTN_FAST & 2)) naive_attn_item<1>(args, l, b, h, t); } else { if (!(ATTN_FAST & 4)) naive_attn_item<2>(args, l, b, h, t); }
            }
            __syncthreads();
#endif
            const int xcd = bx & 7, idx = bx >> 3;
            const float* gq = args.in[4] + l * 64; const float* sinkp = args.in[6] + l * 8;
#if ATTN_FAST & 2
            for (int j = tid; j < 8 * 384; j += 512) { const int hh = j / 384, rel = j % 384 - 192; ((LAS float*)(lds + ATT_TBL_OFF))[j] = (rel >= -128 && rel <= 128) ? TB[hh * 260 + rel + 128] : ATT_NEG; }
            __syncthreads();
#endif
#if ATTN_FAST & 4
            for (int i = 0; ; ++i) { const int L = i * G + bx; if (L >= 1024 * REPS_4C) break;
                int u = L & 1023; if (G == 256) { const int rd = (L >> 8) & 3; u = (rd * 32 + xcd * 4 + (idx >> 3)) * 8 + (idx & 7); }
                attn_unit<2>(lds, tid, l, u >> 6, (u >> 3) & 7, u & 7, P1, QC, KVC, ROPE, RSTDQ, gq, sinkp); }
#endif
#if ATTN_FAST & 1
            for (int i = 0; ; ++i) { const int L = i * G + bx; if (L >= 1024) break;
                int u = L; if (G == 256) { const int rd = L >> 8; u = (rd * 8 + xcd) * 32 + idx; }
                attn_unit<0>(lds, tid, l, u >> 6, (u >> 5) & 1, u & 31, P1, QC, KVC, ROPE, RSTDQ, gq, sinkp); }
#endif
#if ATTN_FAST & 2
            for (int i = 0; ; ++i) { const int L = i * G + bx; if (L >= 1024) break;
                int u = L; if (G == 256) { const int rd = L >> 8; u = (rd * 8 + xcd) * 32 + idx; }
                attn_unit<1>(lds, tid, l, u >> 6, (u >> 5) & 1, u & 31, P1, QC, KVC, ROPE, RSTDQ, gq, sinkp); }
#endif
        }
        SEAM(pb + 4);

        if (EN(5) && IN(pb + 5)) for (int rep_ = 0; rep_ < REPS_5; ++rep_) { PHASE_BEGIN
            pg8::SchedMerge S; S.o.init(NTOK / 256, DM / 256, G, bx); S.P1 = (const char*)P1; S.Wbr = (const char*)(Wb + W_WBR); S.lda2 = P1W * 2;
            pg8::EpiMerge E{MG, (const unsigned char*)GB};
            pg8::gemm_phase<pg8::EpiMerge, pg8::SchedMerge, true>(lds, tid, 512, 1024, S, E);
        }
        SEAM(pb + 5);

        if (EN(6) && IN(pb + 6)) for (int rep_ = 0; rep_ < REPS_6; ++rep_) { PHASE_BEGIN
            pg8::SchedPlain S; S.o.init(NTOK / 256, DM / 256, G, bx); S.A = (const char*)MG; S.Bt = (const char*)(Wb + W_WO); S.lda2 = 2048; S.ldb2 = 2048;
            pg8::EpiWo E{Y, XB};
            pg8::gemm_phase<pg8::EpiWo, pg8::SchedPlain, true>(lds, tid, 1024, 2048, S, E);
        }
        SEAM(pb + 6);

        if (EN(7) && IN(pb + 7)) { PHASE_BEGIN
            constexpr int WSTR = 1032;
            LAS bf16* WH = (LAS bf16*)lds; LAS bf16* WL = (LAS bf16*)(lds + 33280);
            LAS float* LG = (LAS float*)(lds + 69632);
            for (int idx = tid; idx < 16384; idx += 512) { const int k = idx >> 4, e = idx & 15; const float w = args.in[18][idx]; const unsigned hb = f2bf(w); const float rem = w - bf2f((bf16)hb);
                WH[e * WSTR + k] = (bf16)hb; WL[e * WSTR + k] = (bf16)f2bf(rem); }
            if (tid < 16) MISC[16 + tid] = 0u;
            LAS float* GL = (LAS float*)(lds + 81920); LAS float* BL = GL + DM;
            { const float* g_ = args.in[16] + l * DM; const float* b_ = args.in[17] + l * DM; for (int idx = tid; idx < DM; idx += 512) { GL[idx] = g_[idx]; BL[idx] = b_[idx]; } }
            __syncthreads();
            const float* rb = args.in[19];
            const int rpb = (NTOK + G - 1) / G;
            const int r_lo = bx * rpb, r_hi = (r_lo + rpb < NTOK) ? r_lo + rpb : NTOK;
            const int fi = lane & 15, quad = lane >> 4;
            for (int g0 = r_lo + 16 * wave; g0 < r_hi; g0 += 128) {
                const int mrow = g0 + fi < r_hi ? g0 + fi : r_hi - 1;
                const bf16* yrow = Y + (size_t)mrow * DM + 8 * quad;
                float sm = 0.f, sq = 0.f;
#pragma unroll
                for (int sI = 0; sI < 32; ++sI) { const u32x4 w = *(const u32x4*)(yrow + 32 * sI);
                    const float e0 = bflo(w.x), e1 = bfhi(w.x), e2 = bflo(w.y), e3 = bfhi(w.y), e4 = bflo(w.z), e5 = bfhi(w.z), e6 = bflo(w.w), e7 = bfhi(w.w);
                    sm += ((e0 + e1) + (e2 + e3)) + ((e4 + e5) + (e6 + e7)); sq += ((e0 * e0 + e1 * e1) + (e2 * e2 + e3 * e3)) + ((e4 * e4 + e5 * e5) + (e6 * e6 + e7 * e7)); }
                sm += swz_xor<16>(sm); sm = xhalf_sum(sm); sq += swz_xor<16>(sq); sq = xhalf_sum(sq);
                const float mean = sm * (1.f / DM); const float var = fmaxf(sq * (1.f / DM) - mean * mean, 0.f);
                const float rstd = 1.f / sqrtf(var + EPS);
                f32x4 acc0 = (f32x4){0.f, 0.f, 0.f, 0.f}, acc1 = acc0;
                bf16* xrow = XB + (size_t)mrow * DM + 8 * quad; const bool wr_ok = (g0 + fi) < r_hi;
#pragma unroll 4
                for (int sI = 0; sI < 32; ++sI) {
                    const u32x4 w = *(const u32x4*)(yrow + 32 * sI); const int k0 = 32 * sI + 8 * quad;
                    const f32x4 ga = *(const LAS f32x4*)(GL + k0), gb = *(const LAS f32x4*)(GL + k0 + 4), ba = *(const LAS f32x4*)(BL + k0), bc = *(const LAS f32x4*)(BL + k0 + 4);
                    float x[8];
                    x[0] = (bflo(w.x) - mean) * rstd * ga.x + ba.x; x[1] = (bfhi(w.x) - mean) * rstd * ga.y + ba.y; x[2] = (bflo(w.y) - mean) * rstd * ga.z + ba.z; x[3] = (bfhi(w.y) - mean) * rstd * ga.w + ba.w;
                    x[4] = (bflo(w.z) - mean) * rstd * gb.x + bc.x; x[5] = (bfhi(w.z) - mean) * rstd * gb.y + bc.y; x[6] = (bflo(w.w) - mean) * rstd * gb.z + bc.z; x[7] = (bfhi(w.w) - mean) * rstd * gb.w + bc.w;
                    u32x4 hh; hh.x = pk2(x[0], x[1]); hh.y = pk2(x[2], x[3]); hh.z = pk2(x[4], x[5]); hh.w = pk2(x[6], x[7]);
                    if (wr_ok) *(u32x4*)(xrow + 32 * sI) = hh;
                    u32x4 ll; ll.x = pk2(x[0] - bflo(hh.x), x[1] - bfhi(hh.x)); ll.y = pk2(x[2] - bflo(hh.y), x[3] - bfhi(hh.y)); ll.z = pk2(x[4] - bflo(hh.z), x[5] - bfhi(hh.z)); ll.w = pk2(x[6] - bflo(hh.w), x[7] - bfhi(hh.w));
                    const bf16x8 wh = *(const LAS bf16x8*)(WH + fi * WSTR + k0), wl = *(const LAS bf16x8*)(WL + fi * WSTR + k0);
                    const bf16x8 xh = __builtin_bit_cast(bf16x8, hh), xl = __builtin_bit_cast(bf16x8, ll);
                    acc0 = __builtin_amdgcn_mfma_f32_16x16x32_bf16(xh, wh, acc0, 0, 0, 0);
                    acc1 = __builtin_amdgcn_mfma_f32_16x16x32_bf16(xh, wl, acc1, 0, 0, 0);
                    acc1 = __builtin_amdgcn_mfma_f32_16x16x32_bf16(xl, wh, acc1, 0, 0, 0);
                }
#pragma unroll
                for (int j = 0; j < 4; ++j) { const int mq = g0 + 4 * quad + j; if (mq < r_hi) LG[(mq - r_lo) * 16 + fi] = acc0[j] + acc1[j]; }
            }
            __syncthreads();
            if (tid < r_hi - r_lo) {
                float lg[16];
#pragma unroll
                for (int q = 0; q < 4; ++q) { const f32x4 t4 = *(const LAS f32x4*)(LG + tid * 16 + 4 * q); lg[4 * q] = t4.x; lg[4 * q + 1] = t4.y; lg[4 * q + 2] = t4.z; lg[4 * q + 3] = t4.w; }
                float sc[16], bi[16];
#pragma unroll
                for (int e = 0; e < 16; ++e) { sc[e] = 1.0f / (1.0f + expf(-lg[e])); bi[e] = sc[e] + rb[e]; }
                float gs[4]; int i1g[4], i2g[4];
#pragma unroll
                for (int q = 0; q < 4; ++q) { const float a = bi[4 * q], b = bi[4 * q + 1], c = bi[4 * q + 2], d = bi[4 * q + 3];
                    float best = a; int i1 = 0; if (b > best) { best = b; i1 = 1; } if (c > best) { best = c; i1 = 2; } if (d > best) { best = d; i1 = 3; }
                    float b2 = -1e30f; int i2 = 0;
                    if (i1 != 0 && a > b2) { b2 = a; i2 = 0; } if (i1 != 1 && b > b2) { b2 = b; i2 = 1; } if (i1 != 2 && c > b2) { b2 = c; i2 = 2; } if (i1 != 3 && d > b2) { b2 = d; i2 = 3; }
                    gs[q] = best + b2; i1g[q] = i1; i2g[q] = i2; }
                int sel = 0; float bg = gs[0];
#pragma unroll
                for (int q = 1; q < 4; ++q) if (gs[q] > bg) { bg = gs[q]; sel = q; }
                int i1 = i1g[0], i2 = i2g[0];
#pragma unroll
                for (int q = 1; q < 4; ++q) if (sel == q) { i1 = i1g[q]; i2 = i2g[q]; }
                const int e0 = sel * 4 + i1, e1 = sel * 4 + i2; float s0 = 0.f, s1 = 0.f;
#pragma unroll
                for (int e = 0; e < 16; ++e) { s0 = (e == e0) ? sc[e] : s0; s1 = (e == e1) ? sc[e] : s1; }
                const float w0 = s0 / (s0 + s1), w1 = s1 / (s0 + s1);
                const unsigned lp0 = atomicAdd((unsigned*)(MISC + 16 + e0), 1u), lp1 = atomicAdd((unsigned*)(MISC + 16 + e1), 1u);
                volatile LAS unsigned* ri = MISC + 128 + tid * 8; ri[0] = (unsigned)e0; ri[1] = lp0; ri[2] = (unsigned)e1; ri[3] = lp1; ri[4] = __float_as_uint(w0); ri[5] = __float_as_uint(w1);
            }
            __syncthreads();
            if (tid < 16) MISC[32 + tid] = __hip_atomic_fetch_add(ctl + CW_GCNT + (l * 16 + tid) * 64, MISC[16 + tid], __ATOMIC_RELAXED, __HIP_MEMORY_SCOPE_AGENT);
            __syncthreads();
            if (tid < r_hi - r_lo) { volatile LAS unsigned* ri = MISC + 128 + tid * 8; const int m = r_lo + tid;
                const unsigned e0 = ri[0], e1 = ri[2]; const unsigned p0 = MISC[32 + e0] + ri[1], p1 = MISC[32 + e1] + ri[3];
                LIST[e0 * LIST_CAP + p0] = m; LIST[e1 * LIST_CAP + p1] = m;
                *(u32x4*)(ROUTE + (size_t)m * 8) = (u32x4){e0, p0, e1, p1}; *(u32x2*)(ROUTE + (size_t)m * 8 + 4) = (u32x2){ri[4], ri[5]}; }
            __syncthreads();
        }
        SEAM(pb + 7);

        if (IN(pb + 8) || IN(pb + 9) || IN(pb + 10)) { PHASE_BEGIN
            if (tid == 0) { int ps = 0;
                for (int e = 0; e < 16; ++e) { const int c = (int)__hip_atomic_load(ctl + CW_GCNT + (l * 16 + e) * 64, __ATOMIC_RELAXED, __HIP_MEMORY_SCOPE_AGENT); MISC[64 + e] = (unsigned)ps; MISC[96 + e] = (unsigned)c; ps += (c + 255) >> 8; }
                MISC[80] = (unsigned)ps;
                int nu_ = 0;
                if ((G & 7) == 0) {
                    const int x_ = bx & 7, per_ = G >> 3, p0_ = (x_ * ps) >> 3, p1_ = ((x_ + 1) * ps) >> 3; int nq_ = 0, qp_[4] = {0, 0, 0, 0}, qh_[4] = {0, 0, 0, 0};
                    for (int e = 0; e < 16; ++e) { const int c = (int)MISC[96 + e], rem = c & 255, lp = (int)MISC[64 + e] + ((c + 255) >> 8) - 1;
                        if (c > 0 && rem != 0 && lp >= p0_ && lp < p1_ && nq_ < 4) { for (int j = 0; j < 4; ++j) if (j == nq_) { qp_[j] = lp; qh_[j] = rem <= 128 ? 1 : 2; } ++nq_; } }
                    const int nfull_ = p1_ - p0_ - nq_;
                    for (int i = 0; i < 8; ++i) { const int uu = i * per_ + (bx >> 3); int panel = -1, pn = 0, half = 0;
                        if (uu < nfull_ * 4) { int p = p0_ + (uu >> 2); pn = uu & 3; for (int j = 0; j < 4; ++j) p += (j < nq_ && p >= qp_[j]) ? 1 : 0; panel = p; }
                        else { int v = uu - nfull_ * 4; for (int j = 0; j < 4; ++j) { const int uj = j < nq_ ? qh_[j] * 4 : 0; if (panel < 0) { if (v < uj) { panel = qp_[j]; half = 1 + (v >> 2); pn = v & 3; } else v -= uj; } } }
                        if (panel < 0) break;
                        int e = 0; for (int j = 1; j < 16; ++j) e += (panel >= (int)MISC[64 + j]) ? 1 : 0;
                        MISC[128 + 4 * nu_] = (unsigned)panel; MISC[129 + 4 * nu_] = (unsigned)(pn | (half << 4)); MISC[130 + 4 * nu_] = (unsigned)e; MISC[131 + 4 * nu_] = (unsigned)((panel - (int)MISC[64 + e]) * 256 + (half == 2 ? 128 : 0)); ++nu_; }
                } else {
                    for (int i = 0; i < 24; ++i) { const int L = i * G + bx; if (L >= ps * 4) break; const int panel = L >> 2; int e = 0; for (int j = 1; j < 16; ++j) e += (panel >= (int)MISC[64 + j]) ? 1 : 0;
                        MISC[128 + 4 * nu_] = (unsigned)panel; MISC[129 + 4 * nu_] = (unsigned)(L & 3); MISC[130 + 4 * nu_] = (unsigned)e; MISC[131 + 4 * nu_] = (unsigned)((panel - (int)MISC[64 + e]) * 256); ++nu_; }
                }
                MISC[126] = (unsigned)nu_; }
            __syncthreads();
        }
        if (EN(8) && IN(pb + 8)) for (int rep_ = 0; rep_ < REPS_8; ++rep_) { PHASE_BEGIN
            pg8::SchedMoe<true> S; S.total_panels = (int)MISC[80]; S.G = G; S.c = bx; S.tab = (const volatile LAS int*)(MISC + 64); S.list = LIST; S.A = (const char*)XB; S.W = (const char*)(Wb + W_WGU);
            S.lda2 = 2048; S.wstride = (size_t)1024 * 1024 * 2; S.ldb2 = 2048;
            pg8::EpiMoeUp E{HID};
            pg8::gemm_phase<pg8::EpiMoeUp, pg8::SchedMoe<true>, true>(lds, tid, 1024, 2048, S, E);
        }
        SEAM(pb + 8);

        if (EN(9) && IN(pb + 9)) for (int rep_ = 0; rep_ < REPS_9; ++rep_) { PHASE_BEGIN
            pg8::SchedMoe<false> S; S.total_panels = (int)MISC[80]; S.G = G; S.c = bx; S.tab = (const volatile LAS int*)(MISC + 64); S.list = LIST; S.A = (const char*)HID; S.W = (const char*)(Wb + W_WD);
            S.lda2 = 1024; S.wstride = (size_t)1024 * 512 * 2; S.ldb2 = 1024;
            pg8::EpiBf16 E{PAIR, DM, nullptr};
            pg8::gemm_phase<pg8::EpiBf16, pg8::SchedMoe<false>, true>(lds, tid, 512, 1024, S, E);
        }
        SEAM(pb + 9);

        if (EN(10) && IN(pb + 10)) { PHASE_BEGIN
            const float* g = args.in[23] + l * DM; const float* bb = args.in[24] + l * DM;
            f32x4 gv[4], bv[4];
#pragma unroll
            for (int j = 0; j < 4; ++j) { gv[j] = *(const f32x4*)(g + 256 * j + 4 * lane); bv[j] = *(const f32x4*)(bb + 256 * j + 4 * lane); }
            for (int m0 = gw; m0 < NTOK; m0 += 4 * NGW) {
                u32x4 r4[4]; u32x2 w2[4];
#pragma unroll
                for (int q = 0; q < 4; ++q) { const int m = m0 + q * NGW < NTOK ? m0 + q * NGW : m0; r4[q] = *(const u32x4*)(ROUTE + (size_t)m * 8); w2[q] = *(const u32x2*)(ROUTE + (size_t)m * 8 + 4); }
                u32x2 xw[4][4], pa[4][4], pq[4][4];
#pragma unroll
                for (int q = 0; q < 4; ++q) { const int m = m0 + q * NGW < NTOK ? m0 + q * NGW : m0;
                    const size_t s0 = (size_t)MISC[64 + r4[q].x] * 256 + r4[q].y, s1 = (size_t)MISC[64 + r4[q].z] * 256 + r4[q].w;
#pragma unroll
                    for (int j = 0; j < 4; ++j) { xw[q][j] = *(const u32x2*)(XB + (size_t)m * DM + 256 * j + 4 * lane); pa[q][j] = *(const u32x2*)(PAIR + s0 * DM + 256 * j + 4 * lane); pq[q][j] = *(const u32x2*)(PAIR + s1 * DM + 256 * j + 4 * lane); } }
#pragma unroll
                for (int q = 0; q < 4; ++q) { const int m = m0 + q * NGW; if (m < NTOK) {
                    const float w0 = __uint_as_float(w2[q].x), w1 = __uint_as_float(w2[q].y);
                    f32x4 v[4]; float s = 0.f;
#pragma unroll
                    for (int j = 0; j < 4; ++j) {
                        v[j].x = ALPHA * bflo(xw[q][j].x) + w0 * bflo(pa[q][j].x) + w1 * bflo(pq[q][j].x); v[j].y = ALPHA * bfhi(xw[q][j].x) + w0 * bfhi(pa[q][j].x) + w1 * bfhi(pq[q][j].x);
                        v[j].z = ALPHA * bflo(xw[q][j].y) + w0 * bflo(pa[q][j].y) + w1 * bflo(pq[q][j].y); v[j].w = ALPHA * bfhi(xw[q][j].y) + w0 * bfhi(pa[q][j].y) + w1 * bfhi(pq[q][j].y);
                        s += (v[j].x + v[j].y) + (v[j].z + v[j].w); }
                    const float mean = wave_sum(s) * (1.f / DM); float s2 = 0.f;
#pragma unroll
                    for (int j = 0; j < 4; ++j) { v[j] = v[j] - mean; s2 += (v[j].x * v[j].x + v[j].y * v[j].y) + (v[j].z * v[j].z + v[j].w * v[j].w); }
                    const float rstd = 1.f / sqrtf(wave_sum(s2) * (1.f / DM) + EPS);
#pragma unroll
                    for (int j = 0; j < 4; ++j) { const f32x4 o = v[j] * rstd * gv[j] + bv[j];
                        if (l == DEPTH - 1) *(f32x4*)((float*)outb + (size_t)m * DM + 256 * j + 4 * lane) = o;
                        else *(u32x2*)(XB + (size_t)m * DM + 256 * j + 4 * lane) = (u32x2){pk2(o.x, o.y), pk2(o.z, o.w)}; } } }
            }
        }
        SEAM(pb + 10);
    }
#undef IN
#undef SEAM
}

extern "C" void kernel_launch(void* const* d_in, const int* in_sizes, int n_in, void* d_out, int out_size, void* d_ws, size_t ws_size, hipStream_t stream) {
    static int grid = 0;
    if (grid == 0) {
        if (n_in != 25 || out_size != NTOK * DM || ws_size < WS_END) { fprintf(stderr, "kernel_launch: unexpected shapes (n_in %d, out %d, ws %zu)\n", n_in, out_size, ws_size); grid = -1; return; }
        int dev = 0, cus = 0, per_cu = 0;
        if (hipGetDevice(&dev) != hipSuccess || hipDeviceGetAttribute(&cus, hipDeviceAttributeMultiprocessorCount, dev) != hipSuccess) { grid = -1; return; }
        if (hipFuncSetAttribute((const void*)fwd_kernel, hipFuncAttributeMaxDynamicSharedMemorySize, LDS_BYTES) != hipSuccess) { fprintf(stderr, "kernel_launch: hipFuncSetAttribute failed\n"); grid = -1; return; }
        if (hipOccupancyMaxActiveBlocksPerMultiprocessor(&per_cu, (const void*)fwd_kernel, 512, LDS_BYTES) != hipSuccess || per_cu < 1) fprintf(stderr, "kernel_launch: occupancy query reports %d\n", per_cu);
        (void)hipGetLastError();
        grid = cus;
    }
    if (grid < 0) return;
    (void)hipMemsetAsync((char*)d_ws + WS_CTL, 0, CTL_ZERO_BYTES, stream);
    Args a{};
    for (int i = 0; i < 25; ++i) a.in[i] = (const float*)d_in[i];
    a.out = (float*)d_out; a.ws = (unsigned char*)d_ws;
#if ONE_LAUNCH
    a.ph_lo = 0; a.ph_hi = NPH;
    hipLaunchKernelGGL(fwd_kernel, dim3(grid), dim3(512), LDS_BYTES, stream, a);
#else
    for (int p = 0; p < NPH; ++p) { a.ph_lo = p; a.ph_hi = p + 1; hipLaunchKernelGGL(fwd_kernel, dim3(grid), dim3(512), LDS_BYTES, stream, a); }
#endif
}
```
